# Optimizing an MI355X kernel written in HIP

```python
import math
import jax, jax.numpy as jnp
from jax import lax
import numpy as np

D_MODEL = 1024
BATCH = 16
SEQ = 4096
DEPTH = 1

CHUNK = 64
Q_BLOCK = 128
ATT_HEADS = 8
ATT_HEAD_DIM = 64
ATT_V_DIM = 2 * ATT_HEAD_DIM
ATT_QK_WIDTH = 2 * ATT_HEADS * ATT_HEAD_DIM
ATT_V_WIDTH = ATT_HEADS * ATT_V_DIM
SSM_GROUP = 16
SSM_WIDTH = D_MODEL
SSM_GROUPS = SSM_WIDTH // SSM_GROUP
SSM_STATE = 64
DT_MIN = 1e-3
DT_MAX = 1e-1
D_FF = 2816
CONV_W = 3
IN_WIDTH = SSM_WIDTH + 2 * ATT_QK_WIDTH + ATT_V_WIDTH + 2 * D_MODEL
DEEPNORM_ALPHA = (2.0 * DEPTH) ** 0.25
DEEPNORM_BETA = (8.0 * DEPTH) ** -0.25
LN_EPS = 1e-5
RMS_EPS = 1e-5

kernel_name = "hybrid_s5_diffattn_convglu_deepnorm_adaln"


def _layernorm(x):
    xf = x.astype(jnp.float32)
    mu = jnp.mean(xf, axis=-1, keepdims=True)
    var = jnp.mean(jnp.square(xf - mu), axis=-1, keepdims=True)
    return ((xf - mu) * lax.rsqrt(var + LN_EPS)).astype(x.dtype)


def _cmul(ar, ai, br, bi):
    return ar * br - ai * bi, ar * bi + ai * br


def _s5_branch(u, lam_re, lam_im, log_dt, b_re, b_im, c_re, c_im, d_skip, w_glu, b_glu):
    bsz, seq, _ = u.shape
    ug = u.reshape(bsz, seq, SSM_GROUPS, SSM_GROUP)
    dt = jnp.exp(log_dt)[:, None]
    mag = jnp.exp(lam_re * dt)
    ab_re = mag * jnp.cos(lam_im * dt)
    ab_im = mag * jnp.sin(lam_im * dt)
    den = lam_re * lam_re + lam_im * lam_im
    nr = ab_re - 1.0
    ni = ab_im
    coef_re = (nr * lam_re + ni * lam_im) / den
    coef_im = (ni * lam_re - nr * lam_im) / den
    bb_re, bb_im = _cmul(coef_re[..., None], coef_im[..., None], b_re, b_im)
    bu_re = jnp.einsum('bsgc,gpc->bsgp', ug, bb_re)
    bu_im = jnp.einsum('bsgc,gpc->bsgp', ug, bb_im)
    a_re = jnp.broadcast_to(ab_re, (1, seq) + ab_re.shape)
    a_im = jnp.broadcast_to(ab_im, (1, seq) + ab_im.shape)

    def combine(left, right):
        a1r, a1i, b1r, b1i = left
        a2r, a2i, b2r, b2i = right
        ar, ai = _cmul(a2r, a2i, a1r, a1i)
        br, bi = _cmul(a2r, a2i, b1r, b1i)
        return ar, ai, br + b2r, bi + b2i

    _, _, s_re, s_im = lax.associative_scan(combine, (a_re, a_im, bu_re, bu_im), axis=1)
    y = jnp.einsum('bsgp,gcp->bsgc', s_re, c_re) - jnp.einsum('bsgp,gcp->bsgc', s_im, c_im)
    y = y.reshape(bsz, seq, SSM_WIDTH) + d_skip * u
    z = jax.nn.gelu(y)
    return z * jax.nn.sigmoid(z @ w_glu + b_glu)


def _diff_attention(q, k, v, lam, subln_g, lambda_init):
    bsz, seq = q.shape[0], q.shape[1]
    nb = seq // Q_BLOCK
    k1 = k[:, :, :, 0, :]
    k2 = k[:, :, :, 1, :]
    qb = q.reshape(bsz, nb, Q_BLOCK, ATT_HEADS, 2, ATT_HEAD_DIM).transpose(1, 0, 2, 3, 4, 5)
    key_chunk = jnp.arange(seq) // CHUNK
    scale = ATT_HEAD_DIM ** -0.5

    def block(args):
        qi, i = args
        q_chunk = (i * Q_BLOCK + jnp.arange(Q_BLOCK)) // CHUNK
        mask = key_chunk[None, :] <= q_chunk[:, None]
        s1 = jnp.einsum('bqhd,bkhd->bhqk', qi[:, :, :, 0, :], k1).astype(jnp.float32) * scale
        s2 = jnp.einsum('bqhd,bkhd->bhqk', qi[:, :, :, 1, :], k2).astype(jnp.float32) * scale
        p1 = jax.nn.softmax(jnp.where(mask, s1, -jnp.inf), axis=-1)
        p2 = jax.nn.softmax(jnp.where(mask, s2, -jnp.inf), axis=-1)
        w = (p1 - lam * p2).astype(v.dtype)
        return jnp.einsum('bhqk,bkhe->bqhe', w, v)

    o = lax.map(block, (qb, jnp.arange(nb)))
    o = o.transpose(1, 0, 2, 3, 4).reshape(bsz, seq, ATT_HEADS, ATT_V_DIM)
    of = o.astype(jnp.float32)
    of = of * lax.rsqrt(jnp.mean(of * of, axis=-1, keepdims=True) + RMS_EPS)
    o = (of.astype(o.dtype) * subln_g) * (1.0 - lambda_init)
    return o.reshape(bsz, seq, ATT_V_WIDTH)


def setup_inputs(seed: int = 0) -> dict:
    key = jax.random.key(seed)
    ks = jax.random.split(key, 40)
    f32 = jnp.float32
    L, D, G, P = DEPTH, D_MODEL, SSM_GROUPS, SSM_STATE

    def nrm(k, shape, std):
        return std * jax.random.normal(k, shape, f32)

    n = jnp.arange(P, dtype=f32)
    return {
        "x": nrm(ks[0], (BATCH, SEQ, D), 1.0),
        "c": nrm(ks[1], (BATCH, D), 1.0),
        "w_mod": nrm(ks[2], (L, D, 6 * D), 0.5 * D ** -0.5),
        "b_mod": nrm(ks[3], (L, 6 * D), 0.02),
        "w_in": nrm(ks[4], (L, D, IN_WIDTH), D ** -0.5),
        "ssm_lambda_re": -0.5 + nrm(ks[5], (L, G, P), 0.01),
        "ssm_lambda_im": math.pi * n + nrm(ks[6], (L, G, P), 0.01),
        "ssm_log_dt": jax.random.uniform(ks[7], (L, G), f32, math.log(DT_MIN), math.log(DT_MAX)),
        "ssm_b_re": nrm(ks[8], (L, G, P, SSM_GROUP), (2.0 * SSM_GROUP) ** -0.5),
        "ssm_b_im": nrm(ks[9], (L, G, P, SSM_GROUP), (2.0 * SSM_GROUP) ** -0.5),
        "ssm_c_re": nrm(ks[10], (L, G, SSM_GROUP, P), (2.0 * P) ** -0.5),
        "ssm_c_im": nrm(ks[11], (L, G, SSM_GROUP, P), (2.0 * P) ** -0.5),
        "ssm_d": nrm(ks[12], (L, SSM_WIDTH), 1.0),
        "ssm_w_glu": nrm(ks[13], (L, SSM_WIDTH, SSM_WIDTH), SSM_WIDTH ** -0.5),
        "ssm_b_glu": nrm(ks[14], (L, SSM_WIDTH), 0.02),
        "att_lambda_q1": nrm(ks[15], (L, ATT_HEAD_DIM), 0.1),
        "att_lambda_k1": nrm(ks[16], (L, ATT_HEAD_DIM), 0.1),
        "att_lambda_q2": nrm(ks[17], (L, ATT_HEAD_DIM), 0.1),
        "att_lambda_k2": nrm(ks[18], (L, ATT_HEAD_DIM), 0.1),
        "att_subln_g": 1.0 + nrm(ks[19], (L, ATT_V_DIM), 0.02),
        "w_branch_ssm": nrm(ks[20], (L, SSM_WIDTH, D), SSM_WIDTH ** -0.5),
        "w_branch_att": nrm(ks[21], (L, ATT_V_WIDTH, D), ATT_V_WIDTH ** -0.5),
        "w_out": nrm(ks[22], (L, D, D), DEEPNORM_BETA * D ** -0.5),
        "ln1_g": 1.0 + nrm(ks[23], (L, D), 0.02),
        "ln1_b": nrm(ks[24], (L, D), 0.02),
        "w_up": nrm(ks[25], (L, D, 2 * D_FF), D ** -0.5),
        "conv_w": nrm(ks[26], (L, CONV_W, 1, D_FF), CONV_W ** -0.5),
        "conv_b": nrm(ks[27], (L, D_FF), 0.02),
        "w_down": nrm(ks[28], (L, D_FF, D), DEEPNORM_BETA * D_FF ** -0.5),
        "ln2_g": 1.0 + nrm(ks[29], (L, D), 0.02),
        "ln2_b": nrm(ks[30], (L, D), 0.02),
    }


def reference(x, c, w_mod, b_mod, w_in, ssm_lambda_re, ssm_lambda_im, ssm_log_dt, ssm_b_re, ssm_b_im,
              ssm_c_re, ssm_c_im, ssm_d, ssm_w_glu, ssm_b_glu, att_lambda_q1, att_lambda_k1,
              att_lambda_q2, att_lambda_k2, att_subln_g, w_branch_ssm, w_branch_att, w_out,
              ln1_g, ln1_b, w_up, conv_w, conv_b, w_down, ln2_g, ln2_b):
    bsz, seq, _ = x.shape
    cond = jax.nn.silu(c)
    splits = [SSM_WIDTH, SSM_WIDTH + ATT_QK_WIDTH, SSM_WIDTH + 2 * ATT_QK_WIDTH,
              SSM_WIDTH + 2 * ATT_QK_WIDTH + ATT_V_WIDTH,
              SSM_WIDTH + 2 * ATT_QK_WIDTH + ATT_V_WIDTH + D_MODEL]
    for l in range(DEPTH):
        lambda_init = 0.8 - 0.6 * math.exp(-0.3 * l)
        mod = (cond @ w_mod[l] + b_mod[l])[:, None, :]
        sh1, sc1, g1, sh2, sc2, g2 = jnp.split(mod, 6, axis=-1)

        h = _layernorm(x) * (1.0 + sc1) + sh1
        proj = h @ w_in[l]
        u, q, k, v, gs, ga = jnp.split(proj, splits, axis=-1)
        y_ssm = _s5_branch(u, ssm_lambda_re[l], ssm_lambda_im[l], ssm_log_dt[l], ssm_b_re[l],
                           ssm_b_im[l], ssm_c_re[l], ssm_c_im[l], ssm_d[l], ssm_w_glu[l], ssm_b_glu[l])
        lq1 = att_lambda_q1[l].astype(jnp.float32)
        lk1 = att_lambda_k1[l].astype(jnp.float32)
        lq2 = att_lambda_q2[l].astype(jnp.float32)
        lk2 = att_lambda_k2[l].astype(jnp.float32)
        lam = jnp.exp(jnp.sum(lq1 * lk1)) - jnp.exp(jnp.sum(lq2 * lk2)) + lambda_init
        y_att = _diff_attention(q.reshape(bsz, seq, ATT_HEADS, 2, ATT_HEAD_DIM),
                                k.reshape(bsz, seq, ATT_HEADS, 2, ATT_HEAD_DIM),
                                v.reshape(bsz, seq, ATT_HEADS, ATT_V_DIM),
                                lam, att_subln_g[l], lambda_init)
        merged = (jax.nn.sigmoid(gs) * (y_ssm @ w_branch_ssm[l])
                  + jax.nn.sigmoid(ga) * (y_att @ w_branch_att[l]))
        out = merged @ w_out[l]
        x = _layernorm(DEEPNORM_ALPHA * x + g1 * out) * ln1_g[l] + ln1_b[l]

        h2 = _layernorm(x) * (1.0 + sc2) + sh2
        a, val = jnp.split(h2 @ w_up[l], 2, axis=-1)
        a = lax.conv_general_dilated(a, conv_w[l], window_strides=(1,), padding=[(CONV_W - 1, 0)],
                                     dimension_numbers=('NWC', 'WIO', 'NWC'),
                                     feature_group_count=D_FF) + conv_b[l]
        f = (jax.nn.silu(a) * val) @ w_down[l]
        x = _layernorm(DEEPNORM_ALPHA * x + g2 * f) * ln2_g[l] + ln2_b[l]
    return x
```

```cpp
#include <hip/hip_runtime.h>
#include <hip/hip_cooperative_groups.h>
#include <cstdio>
#include <cstdint>
namespace cg = cooperative_groups;
namespace pg8 {
#define PG8_LAS __attribute__((address_space(3)))
typedef unsigned short bf16_t;
typedef short bf16x8 __attribute__((ext_vector_type(8)));
typedef float f32x4 __attribute__((ext_vector_type(4)));
typedef unsigned u32x4 __attribute__((ext_vector_type(4)));
constexpr int BM = 256, BK = 64, HALF = 128, HTB = HALF * BK * 2  , STAGE_BYTES = 8 * HTB, NXCD = 8, WGM = 8;

__host__ __device__ __forceinline__ int lds_byte(int r, int c) { const int st = (r >> 4) * 2 + (c >> 5), rr = r & 15, cc = c & 31, ob = rr * 64 + cc * 2; return st * 1024 + (ob ^ (((ob >> 9) & 1) << 5)); }
__host__ __device__ __forceinline__ void stage_rc(int b, int& R, int& C) { const int st = b / 1024, sb = b % 1024, swz = sb ^ (((sb >> 9) & 1) << 5); R = (st >> 1) * 16 + swz / 64; C = (st & 1) * 32 + (swz % 64) / 2; }
__host__ __device__ __forceinline__ int perm32(int rho) { const int n = rho >> 4, i = rho & 15; return 8 * (i >> 2) + 4 * n + (i & 3); }

struct Unit { int pm, pn; };
struct Gemm { const bf16_t* A; const bf16_t* Bt; int lda, ldb, K; };

struct StaticOrder {
    int nM, nN, nwg, G, c;
    __host__ __device__ void init(int M, int N, int G_, int c_) { nM = M / BM; nN = N / BM; nwg = nM * nN; G = G_; c = c_; }
    __host__ __device__ bool next(int i, Unit& u) const {
        const long L = (long)i * G + c; if (L >= nwg) return false;
        int wgid = (int)L; { const int q = nwg / NXCD, r = nwg % NXCD, xcd = wgid % NXCD, off = wgid / NXCD; wgid = (xcd < r ? xcd * (q + 1) : r * (q + 1) + (xcd - r) * q) + off; }
        const int nig = WGM * nN, gid = wgid / nig, fm = gid * WGM, gsz = (nM - fm) < WGM ? (nM - fm) : WGM;
        u.pm = fm + ((wgid % nig) % gsz); u.pn = (wgid % nig) / gsz; return true;
    }
    __device__ __forceinline__ void a_ready(const Unit&) const {}
    __device__ __forceinline__ void done(const Unit&) const {}
};

__device__ __forceinline__ unsigned cvt_pk_bf16(float lo, float hi) { unsigned r; asm volatile("v_cvt_pk_bf16_f32 %0, %1, %2" : "=v"(r) : "v"(lo), "v"(hi)); return r; }

__device__ __forceinline__ float bf_lo(unsigned u) { return __uint_as_float(u << 16); }
__device__ __forceinline__ float bf_hi(unsigned u) { return __uint_as_float(u & 0xffff0000u); }
__device__ __forceinline__ float sigmoidf_fast(float x) { return __builtin_amdgcn_rcpf(1.0f + __expf(-x)); }
__device__ __forceinline__ void unpack8(const u32x4 w, float (&f)[8]) { f[0] = bf_lo(w.x); f[1] = bf_hi(w.x); f[2] = bf_lo(w.y); f[3] = bf_hi(w.y); f[4] = bf_lo(w.z); f[5] = bf_hi(w.z); f[6] = bf_lo(w.w); f[7] = bf_hi(w.w); }
enum { EP_PROJ = 0, EP_GLU = 1, EP_BS = 2, EP_BA = 3, EP_OUT = 4, EP_UP = 5, EP_DOWN = 6 };
template <int MODE> struct Epi {
    static constexpr bool PERM = (MODE != EP_OUT && MODE != EP_DOWN), AFTER_DRAIN = false;
    bf16_t* O; int ldo;
    const bf16_t* X1; int ldx1;
    const bf16_t* X2; int ldx2;
    const float* bias;
    float* F; const float* R; const float* gate; float alpha;
    float qscale;
    __device__ __forceinline__ void operator()(const f32x4 (&acc)[2][2][4][2], const Unit& u, int wr, int wc, int fr, int fq) const {
        if constexpr (PERM) {
            const int row0 = u.pm * BM + wr * 64 + fr, col0 = u.pn * BM + wc * 32 + 8 * fq;
            float sc = 1.f; if (MODE == EP_PROJ) { const int colt = u.pn * BM; if (colt >= 1024 && colt < 2048) sc = qscale; }
            float bv[2][8];
            if (MODE == EP_GLU) {
#pragma unroll
                for (int bj = 0; bj < 2; ++bj) { const f32x4 b0 = *(const f32x4*)(bias + col0 + bj * HALF), b1 = *(const f32x4*)(bias + col0 + bj * HALF + 4);
                    bv[bj][0] = b0[0]; bv[bj][1] = b0[1]; bv[bj][2] = b0[2]; bv[bj][3] = b0[3]; bv[bj][4] = b1[0]; bv[bj][5] = b1[1]; bv[bj][6] = b1[2]; bv[bj][7] = b1[3]; }
            }
#pragma unroll
            for (int ai = 0; ai < 2; ++ai)
#pragma unroll
                for (int m = 0; m < 4; ++m) {
                    const size_t row = (size_t)(row0 + ai * HALF + m * 16);
#pragma unroll
                    for (int bj = 0; bj < 2; ++bj) {
                        const int col = col0 + bj * HALF;
                        float v[8];
#pragma unroll
                        for (int j = 0; j < 4; ++j) { v[j] = acc[ai][bj][m][0][j]; v[4 + j] = acc[ai][bj][m][1][j]; }
                        if (MODE == EP_PROJ) {
#pragma unroll
                            for (int j = 0; j < 8; ++j) v[j] *= sc;
                        }
                        if (MODE == EP_GLU) {
                            float z[8]; unpack8(*(const u32x4*)(X1 + row * ldx1 + col), z);
#pragma unroll
                            for (int j = 0; j < 8; ++j) v[j] = z[j] * sigmoidf_fast(v[j] + bv[bj][j]);
                        }
                        if (MODE == EP_BS) {
                            float gt[8]; unpack8(*(const u32x4*)(X1 + row * ldx1 + col), gt);
#pragma unroll
                            for (int j = 0; j < 8; ++j) v[j] = sigmoidf_fast(gt[j]) * v[j];
                        }
                        if (MODE == EP_BA) {
                            float gt[8], m1[8]; unpack8(*(const u32x4*)(X1 + row * ldx1 + col), gt); unpack8(*(const u32x4*)(X2 + row * ldx2 + col), m1);
#pragma unroll
                            for (int j = 0; j < 8; ++j) v[j] = m1[j] + sigmoidf_fast(gt[j]) * v[j];
                        }
                        u32x4 w; w.x = cvt_pk_bf16(v[0], v[1]); w.y = cvt_pk_bf16(v[2], v[3]); w.z = cvt_pk_bf16(v[4], v[5]); w.w = cvt_pk_bf16(v[6], v[7]);
                        *(u32x4*)(O + row * ldo + col) = w;
                    }
                    asm volatile("" ::: "memory");
                }
        } else {
            const int row0 = u.pm * BM + wr * 64 + fr, col0 = u.pn * BM + wc * 32 + 4 * fq;
            const float* gp = gate + (size_t)((u.pm * BM) >> 12) * 6144;
            f32x4 gv[2][2];
#pragma unroll
            for (int bj = 0; bj < 2; ++bj)
#pragma unroll
                for (int n = 0; n < 2; ++n) gv[bj][n] = *(const f32x4*)(gp + col0 + bj * HALF + n * 16);
#pragma unroll
            for (int ai = 0; ai < 2; ++ai)
#pragma unroll
                for (int m = 0; m < 4; ++m) {
                    const size_t off = (size_t)(row0 + ai * HALF + m * 16) * 1024 + col0;
#pragma unroll
                    for (int bj = 0; bj < 2; ++bj)
#pragma unroll
                        for (int n = 0; n < 2; ++n) { const f32x4 rs = *(const f32x4*)(R + off + bj * HALF + n * 16);
                            *(f32x4*)(F + off + bj * HALF + n * 16) = rs * alpha + gv[bj][n] * acc[ai][bj][m][n]; }
                    asm volatile("" ::: "memory");
                }
        }
    }
};

template <class Epi, class Sched, bool ALIGN_EPI = false, bool SP2 = false>
__device__ __forceinline__ void gemm_phase(PG8_LAS unsigned char* lds, const Gemm g, const Sched& S, const Epi& E) {
    int tid_ = threadIdx.x; asm volatile("" : "+v"(tid_)); const int tid = tid_, wid = __builtin_amdgcn_readfirstlane(tid >> 6), lane = tid & 63, wr = wid >> 2, wc = wid & 3, fr = lane & 15, fq = lane >> 4;
    const int K = g.K, nt = K / BK;
    unsigned voffA[2], voffB[2];
#pragma unroll
    for (int i = 0; i < 2; ++i) { int R, C; stage_rc(tid * 16 + i * 8192, R, C); const int Rb = Epi::PERM ? ((R & ~31) + perm32(R & 31)) : R;
        voffA[i] = (unsigned)(R * g.lda + C) * 2u; voffB[i] = (unsigned)(Rb * g.ldb + C) * 2u; }
    const size_t kstep = (size_t)(BK * 2);
    const size_t hstepA = (size_t)HALF * g.lda * 2, hstepB = (size_t)HALF * g.ldb * 2;
    const size_t tstepA = 2 * hstepA, tstepB = 2 * hstepB;
    const unsigned ldsw = (unsigned)wid * 1024u;
    const int aoff = lds_byte(wr * 64 + fr, fq * 8), boff = lds_byte(wc * 32 + fr, fq * 8);
#define PG8_SA(b, h) (((b) * 2 + (h)) * HTB)
#define PG8_SB(b, h) ((4 + (b) * 2 + (h)) * HTB)
#define PG8_STAGE(bufoff, gbase, voff) do { _Pragma("unroll") for (int _i = 0; _i < 2; ++_i) \
        __builtin_amdgcn_global_load_lds((const unsigned*)((const char*)(gbase) + (voff)[_i]), (PG8_LAS unsigned*)(lds + (bufoff) + ldsw + _i * 8192), 16, 0, 0); } while (0)
#define PG8_LDA(dst, b, h) do { _Pragma("unroll") for (int m = 0; m < 4; ++m) _Pragma("unroll") for (int k = 0; k < 2; ++k) dst[m][k] = *(const PG8_LAS bf16x8*)(lds + PG8_SA(b, h) + aoff + m * 2048 + k * 1024); } while (0)
#define PG8_LDB(dst, b, h) do { _Pragma("unroll") for (int n = 0; n < 2; ++n) _Pragma("unroll") for (int k = 0; k < 2; ++k) dst[n][k] = *(const PG8_LAS bf16x8*)(lds + PG8_SB(b, h) + boff + n * 2048 + k * 1024); } while (0)
#define PG8_MMA(ai, bj, At, Bt) do { __builtin_amdgcn_s_setprio(1); _Pragma("unroll") for (int m = 0; m < 4; ++m) _Pragma("unroll") for (int n = 0; n < 2; ++n) _Pragma("unroll") for (int k = 0; k < 2; ++k) \
        acc[ai][bj][m][n] = __builtin_amdgcn_mfma_f32_16x16x32_bf16(Bt[n][k], At[m][k], acc[ai][bj][m][n], 0, 0, 0); __builtin_amdgcn_s_setprio(0); } while (0)
#define PG8_WAIT_V(n) asm volatile("s_waitcnt vmcnt(" #n ")" ::: "memory")
#define PG8_WAIT_L(n) asm volatile("s_waitcnt lgkmcnt(" #n ")" ::: "memory")
#define PG8_BAR __builtin_amdgcn_s_barrier()
#define PG8_SCHED __builtin_amdgcn_sched_barrier(0)
    Unit cur, nxt; int ui = 0;
    if (!S.next(0, cur)) return;
    f32x4 acc[2][2][4][2];
#pragma unroll
    for (int a = 0; a < 2; ++a)
#pragma unroll
        for (int b = 0; b < 2; ++b)
#pragma unroll
            for (int m = 0; m < 4; ++m)
#pragma unroll
                for (int n = 0; n < 2; ++n) acc[a][b][m][n] = (f32x4){0.f, 0.f, 0.f, 0.f};
    bf16x8 At[4][2], B0[2][2], B1[2][2];
    const char* cA = (const char*)g.A + (size_t)cur.pm * tstepA; const char* cB = (const char*)g.Bt + (size_t)cur.pn * tstepB;
    S.a_ready(cur);
    if constexpr (SP2) {
        PG8_STAGE(PG8_SB(0, 0), cB, voffB); PG8_STAGE(PG8_SB(0, 1), cB + hstepB, voffB); PG8_STAGE(PG8_SA(0, 0), cA, voffA); PG8_STAGE(PG8_SA(0, 1), cA + hstepA, voffA);
        if (wr == 1) PG8_BAR;
        PG8_WAIT_V(2); PG8_BAR;
        PG8_STAGE(PG8_SB(1, 0), cB + kstep, voffB); PG8_STAGE(PG8_SA(1, 0), cA + kstep, voffA); PG8_STAGE(PG8_SB(1, 1), cB + hstepB + kstep, voffB);
        PG8_WAIT_V(6); PG8_BAR;
    } else {
        PG8_STAGE(PG8_SB(0, 0), cB, voffB); PG8_STAGE(PG8_SA(0, 0), cA, voffA); PG8_STAGE(PG8_SB(0, 1), cB + hstepB, voffB); PG8_STAGE(PG8_SA(0, 1), cA + hstepA, voffA);
        if (wr == 1) PG8_BAR;
        PG8_WAIT_V(4); PG8_BAR;
        PG8_STAGE(PG8_SB(1, 0), cB + kstep, voffB); PG8_STAGE(PG8_SA(1, 0), cA + kstep, voffA); PG8_STAGE(PG8_SB(1, 1), cB + hstepB + kstep, voffB);
        PG8_WAIT_V(6); PG8_BAR;
    }
    for (;;) {
        const bool has_next = S.next(ui + 1, nxt);
        const char* nA = has_next ? (const char*)g.A + (size_t)nxt.pm * tstepA : cA; const char* nB = has_next ? (const char*)g.Bt + (size_t)nxt.pn * tstepB : cB;
        for (int t = 0; t < nt; t += 2) {
            const bool last = (t == nt - 2);
            const char* a1 = cA + (size_t)(t + 1) * kstep;
            const char* a2 = last ? nA : cA + (size_t)(t + 2) * kstep; const char* b2 = last ? nB : cB + (size_t)(t + 2) * kstep;
            const char* a3 = a2 + kstep; const char* b3 = b2 + kstep;
            if (last && has_next) S.a_ready(nxt);
            if constexpr (SP2) {
            PG8_LDB(B0, 0, 0); PG8_LDB(B1, 0, 1); PG8_SCHED; PG8_LDA(At, 0, 0); PG8_STAGE(PG8_SA(1, 1), a1 + hstepA, voffA);
            PG8_WAIT_V(8); PG8_WAIT_L(0); PG8_BAR; PG8_MMA(0, 0, At, B0); PG8_MMA(0, 1, At, B1); PG8_BAR; PG8_SCHED;
            PG8_LDA(At, 0, 1); PG8_STAGE(PG8_SB(0, 0), b2, voffB); PG8_STAGE(PG8_SB(0, 1), b2 + hstepB, voffB); PG8_STAGE(PG8_SA(0, 0), a2, voffA);
            PG8_WAIT_V(8); PG8_WAIT_L(0); PG8_BAR; PG8_MMA(1, 0, At, B0); PG8_MMA(1, 1, At, B1); PG8_BAR; PG8_SCHED;
            PG8_LDB(B0, 1, 0); PG8_LDB(B1, 1, 1); PG8_SCHED; PG8_LDA(At, 1, 0); PG8_STAGE(PG8_SA(0, 1), a2 + hstepA, voffA);
            PG8_WAIT_V(8); PG8_WAIT_L(0); PG8_BAR; PG8_MMA(0, 0, At, B0); PG8_MMA(0, 1, At, B1); PG8_BAR; PG8_SCHED;
            PG8_LDA(At, 1, 1); PG8_STAGE(PG8_SB(1, 0), b3, voffB); PG8_STAGE(PG8_SB(1, 1), b3 + hstepB, voffB); PG8_STAGE(PG8_SA(1, 0), a3, voffA);
            PG8_WAIT_V(8); PG8_WAIT_L(0); PG8_BAR; PG8_MMA(1, 0, At, B0); PG8_MMA(1, 1, At, B1); PG8_BAR; PG8_SCHED;
            } else {
            PG8_LDB(B0, 0, 0); PG8_SCHED; PG8_LDA(At, 0, 0); PG8_STAGE(PG8_SA(1, 1), a1 + hstepA, voffA);
            PG8_WAIT_L(8); PG8_BAR; PG8_WAIT_L(0); PG8_MMA(0, 0, At, B0); PG8_BAR; PG8_SCHED;
            PG8_LDB(B1, 0, 1); PG8_STAGE(PG8_SB(0, 0), b2, voffB);
            PG8_BAR; PG8_WAIT_L(0); PG8_MMA(0, 1, At, B1); PG8_BAR;
            PG8_LDA(At, 0, 1); PG8_STAGE(PG8_SA(0, 0), a2, voffA);
            PG8_BAR; PG8_WAIT_L(0); PG8_MMA(1, 0, At, B0); PG8_BAR; PG8_SCHED;
            PG8_STAGE(PG8_SB(0, 1), b2 + hstepB, voffB);
            PG8_WAIT_V(6); PG8_BAR; PG8_MMA(1, 1, At, B1); PG8_BAR;
            PG8_LDB(B0, 1, 0); PG8_SCHED; PG8_LDA(At, 1, 0); PG8_STAGE(PG8_SA(0, 1), a2 + hstepA, voffA);
            PG8_WAIT_L(8); PG8_BAR; PG8_WAIT_L(0); PG8_MMA(0, 0, At, B0); PG8_BAR; PG8_SCHED;
            PG8_LDB(B1, 1, 1); PG8_STAGE(PG8_SB(1, 0), b3, voffB);
            PG8_BAR; PG8_WAIT_L(0); PG8_MMA(0, 1, At, B1); PG8_BAR;
            PG8_LDA(At, 1, 1); PG8_STAGE(PG8_SA(1, 0), a3, voffA);
            PG8_BAR; PG8_WAIT_L(0); PG8_MMA(1, 0, At, B0); PG8_BAR; PG8_SCHED;
            PG8_STAGE(PG8_SB(1, 1), b3 + hstepB, voffB);
            PG8_WAIT_V(6); PG8_BAR; PG8_MMA(1, 1, At, B1); PG8_BAR;
            }
        }
        if constexpr (ALIGN_EPI) { if (wr == 0) PG8_BAR; }
        if constexpr (!Epi::AFTER_DRAIN) { E(acc, cur, wr, wc, fr, fq); S.done(cur); }
        if (!has_next) break;
#pragma unroll
        for (int a = 0; a < 2; ++a)
#pragma unroll
            for (int b = 0; b < 2; ++b)
#pragma unroll
                for (int m = 0; m < 4; ++m)
#pragma unroll
                    for (int n = 0; n < 2; ++n) acc[a][b][m][n] = (f32x4){0.f, 0.f, 0.f, 0.f};
        cur = nxt; cA = nA; cB = nB; ++ui;
        if constexpr (ALIGN_EPI) { if (wr == 1) PG8_BAR; }
    }
    PG8_WAIT_V(0);
    if constexpr (!ALIGN_EPI) { if (wr == 0) PG8_BAR; }
    PG8_BAR;
    if constexpr (Epi::AFTER_DRAIN) { E.fused(acc, cur, wr, wc, fr, fq, lds, wid, lane); S.done(cur); }
#undef PG8_SA
#undef PG8_SB
#undef PG8_STAGE
#undef PG8_LDA
#undef PG8_LDB
#undef PG8_MMA
#undef PG8_WAIT_V
#undef PG8_WAIT_L
#undef PG8_BAR
#undef PG8_SCHED
}
}

#include <hip/hip_bf16.h>
#include <cmath>
namespace attn_body {
using bf16=__hip_bfloat16;
using bf16x8=__attribute__((ext_vector_type(8)))short;
using s16x4=__attribute__((ext_vector_type(4)))short;
using f32x16=__attribute__((ext_vector_type(16)))float;
using u32x4=__attribute__((ext_vector_type(4)))unsigned;
constexpr int SEQ=4096,D=64,DM=6144,OP=2048;
constexpr int NW=8,QBLK=32,QB=QBLK*NW,KVBLK=64,NQB=SEQ/QB;
constexpr int ATTN_PITCH=DM, ATTN_UNIT_ROWS=QB;
__device__ __forceinline__ int crow(int r,int hi){return (r&3)+8*(r>>2)+4*hi;}
#define SBAR() __builtin_amdgcn_sched_barrier(0)
__device__ __forceinline__ void cmask(f32x16&p0,f32x16&p1,int jb,int qrel,int hi){
  const float NEG=-INFINITY;
  if(jb>(qrel>>6)){
  #pragma unroll
  for(int r=0;r<16;++r){p0[r]=NEG;p1[r]=NEG;}}
}

constexpr int NSLOT=3, SLOTB=8192;
constexpr int LDS_K=0, LDS_V=NSLOT*SLOTB, LDS_WS=2*NSLOT*SLOTB, LDS_OST=LDS_WS+NW*64*4, LDS_BYTES=LDS_OST+NW*4096;
constexpr float C2=0.125f*1.4426950408889634f;
__device__ __forceinline__ void glds16(const void*gsrc,unsigned lds_dst){unsigned keep;
  asm volatile("s_mov_b32 %0, m0\n\ts_mov_b32 m0, %2\n\ts_nop 0\n\tglobal_load_lds_dwordx4 %1, off\n\ts_mov_b32 m0, %0":"=&s"(keep):"v"(gsrc),"s"(lds_dst):"memory");}
__device__ __forceinline__ float max3f(float a,float b,float c){float r;asm("v_max3_f32 %0, %1, %2, %3":"=v"(r):"v"(a),"v"(b),"v"(c));return r;}
__device__ __forceinline__ float max2f(float a,float b){float r;asm("v_max_f32_e32 %0, %1, %2":"=v"(r):"v"(a),"v"(b));return r;}
__device__ __forceinline__ float fadd_s(float a,float b){float r;asm("v_add_f32_e32 %0, %1, %2":"=v"(r):"v"(a),"v"(b));return r;}
__device__ __forceinline__ float fsub_s(float a,float b){float r;asm("v_sub_f32_e32 %0, %1, %2":"=v"(r):"v"(a),"v"(b));return r;}
typedef float f32x2_t __attribute__((ext_vector_type(2))); typedef __bf16 bf16x2_t __attribute__((ext_vector_type(2)));
__device__ __forceinline__ unsigned cvtpk_s(float lo,float hi){f32x2_t v={lo,hi};bf16x2_t b=__builtin_convertvector(v,bf16x2_t);return __builtin_bit_cast(unsigned,b);}
#define WAIT_BAR(N) asm volatile("s_waitcnt vmcnt(" #N ") lgkmcnt(0)\n\ts_barrier":::"memory")

__device__ __forceinline__ void qkt(f32x16&p0,f32x16&p1,const char*Kslot,const bf16x8*qr,const f32x16&negm,int r32,int hi){
  const char*kb=Kslot+hi*1024+r32*16;
  #pragma unroll
  for(int d0=0;d0<4;++d0){
    const bf16x8 b0=*reinterpret_cast<const bf16x8*>(kb+d0*2048);
    const bf16x8 b1=*reinterpret_cast<const bf16x8*>(kb+d0*2048+512);
    if(d0==0){p0=__builtin_amdgcn_mfma_f32_32x32x16_bf16(b0,qr[0],negm,0,0,0);p1=__builtin_amdgcn_mfma_f32_32x32x16_bf16(b1,qr[0],negm,0,0,0);}
    else{p0=__builtin_amdgcn_mfma_f32_32x32x16_bf16(b0,qr[d0],p0,0,0,0);p1=__builtin_amdgcn_mfma_f32_32x32x16_bf16(b1,qr[d0],p1,0,0,0);}}
}
typedef __attribute__((address_space(3))) const char* lds_cptr;
typedef short v4i16_t __attribute__((ext_vector_type(4)));
__device__ __forceinline__ void kload8(bf16x8*kf,lds_cptr kp){
  kf[0]=*(const __attribute__((address_space(3))) bf16x8*)(kp);      kf[1]=*(const __attribute__((address_space(3))) bf16x8*)(kp+512);
  kf[2]=*(const __attribute__((address_space(3))) bf16x8*)(kp+2048); kf[3]=*(const __attribute__((address_space(3))) bf16x8*)(kp+2560);
  kf[4]=*(const __attribute__((address_space(3))) bf16x8*)(kp+4096); kf[5]=*(const __attribute__((address_space(3))) bf16x8*)(kp+4608);
  kf[6]=*(const __attribute__((address_space(3))) bf16x8*)(kp+6144); kf[7]=*(const __attribute__((address_space(3))) bf16x8*)(kp+6656);
}
__device__ __forceinline__ void kload2(bf16x8*kf,lds_cptr kp,int j){ kf[2*j]=*(const __attribute__((address_space(3))) bf16x8*)(kp+j*2048); kf[2*j+1]=*(const __attribute__((address_space(3))) bf16x8*)(kp+j*2048+512); }
__device__ __forceinline__ s16x4 vtr(lds_cptr p){ return __builtin_bit_cast(s16x4,__builtin_amdgcn_ds_read_tr16_b64_v4i16((__attribute__((address_space(3))) v4i16_t*)p)); }
__device__ __forceinline__ float rowmax(const f32x16&p0,const f32x16&p1){
  float a=max3f(p0[0],p0[1],p1[0]),b=max3f(p0[2],p0[3],p1[1]);a=max3f(a,p1[2],p1[3]);
  #pragma unroll
  for(int r=4;r<16;r+=4){a=max3f(a,p0[r],p0[r+1]);b=max3f(b,p0[r+2],p0[r+3]);a=max3f(a,p1[r],p1[r+1]);b=max3f(b,p1[r+2],p1[r+3]);}
  const float m=max2f(a,b);
  auto rr=__builtin_amdgcn_permlane32_swap(__float_as_uint(m),__float_as_uint(m),false,false);
  return max2f(__uint_as_float(rr[0]),__uint_as_float(rr[1]));
}
__device__ __forceinline__ void pv(f32x16*o,int vb,bf16x8 pa0,bf16x8 pa1,bf16x8 pa2,bf16x8 pa3){
  #pragma unroll
  for(int d0=0;d0<2;++d0){s16x4 lo[4],hi[4];
    #pragma unroll
    for(int ks=0;ks<4;++ks){
      asm volatile("ds_read_b64_tr_b16 %0,%1 offset:%c2":"=&v"(lo[ks]):"v"(vb),"i"(d0*4096+ks*1024):"memory");
      asm volatile("ds_read_b64_tr_b16 %0,%1 offset:%c2":"=&v"(hi[ks]):"v"(vb),"i"(d0*4096+ks*1024+512):"memory");}
    asm volatile("s_waitcnt lgkmcnt(0)":::"memory");SBAR();
    #define PK(k) (bf16x8){lo[k][0],lo[k][1],lo[k][2],lo[k][3],hi[k][0],hi[k][1],hi[k][2],hi[k][3]}
    o[d0]=__builtin_amdgcn_mfma_f32_32x32x16_bf16(pa0,PK(0),o[d0],0,0,0);
    o[d0]=__builtin_amdgcn_mfma_f32_32x32x16_bf16(pa1,PK(1),o[d0],0,0,0);
    o[d0]=__builtin_amdgcn_mfma_f32_32x32x16_bf16(pa2,PK(2),o[d0],0,0,0);
    o[d0]=__builtin_amdgcn_mfma_f32_32x32x16_bf16(pa3,PK(3),o[d0],0,0,0);
    #undef PK
  }
}

#ifndef ATTN_STORE16
#define ATTN_STORE16(p,v) (*(u32x4*)(p)=(v))
#endif
template<int THRL> __device__ __forceinline__ void attn_unit(int b,int h,int hv,int os,int qb,const bf16*Q,const bf16*__restrict__ K,const bf16*__restrict__ V,bf16*O,char*shm){
  int tid_=threadIdx.x; asm volatile("":"+v"(tid_)); const int tid=tid_,lane=tid&63,r32=lane&31,hi=lane>>5; const int wid=__builtin_amdgcn_readfirstlane(tid>>6);
  const long rowbase=(long)b*SEQ; const int q0=qb*QB;
  const bf16*Qw=Q+(rowbase+q0+wid*QBLK)*DM+h*D;
  const bf16*Kh=K+rowbase*DM+h*D,*Vh=V+rowbase*DM+hv*D;
  const unsigned lds0=(unsigned)(uintptr_t)shm;
  float*wsf=(float*)(shm+LDS_WS)+wid*64;
  const bf16*ksrc=Kh+(long)lane*DM+wid*8;
  const bf16*vsrc=Vh+(long)(16*(wid&3)+(lane>>2))*DM+(wid>>2)*32+(lane&3)*8;
  const unsigned kdst=lds0+LDS_K+wid*1024, vdst=lds0+LDS_V+wid*1024;
  #define DMA_K(t,slot) glds16(ksrc+(long)(t)*KVBLK*DM,(unsigned)__builtin_amdgcn_readfirstlane(kdst+(slot)))
  #define DMA_V(t,slot) glds16(vsrc+(long)(t)*KVBLK*DM,(unsigned)__builtin_amdgcn_readfirstlane(vdst+(slot)))
  const int vb0=(int)(lds0+LDS_V)+((lane>>4)&1)*32+(lane&3)*8+(4*hi+((lane&15)>>2))*64;
  const char*Kbase=shm+LDS_K; bf16x8 kf[8];
  const lds_cptr shm3=(lds_cptr)shm; const lds_cptr kp0=shm3+LDS_K+hi*1024+r32*16; const lds_cptr vp0=shm3+LDS_V+((lane>>4)&1)*32+(lane&3)*8+(4*hi+((lane&15)>>2))*64;
  const int NT=(q0+QB)/KVBLK;
  DMA_K(0,0);DMA_V(0,0);DMA_K(1,SLOTB);
  bf16x8 qr[4];
  #pragma unroll
  for(int d0=0;d0<4;++d0)qr[d0]=*reinterpret_cast<const bf16x8*>(&Qw[(long)r32*DM+d0*16+hi*8]);
  float mhat=0.f,l_reg=0.f;f32x16 o[2];o[0]=f32x16{};o[1]=f32x16{};f32x16 negm=f32x16{};asm volatile("":"+v"(negm));
  const int qrel=wid*QBLK+r32;
  #define CMASK(P0,P1,t) do{int jb_=(t)-(NT-4); if(jb_>=0)cmask(P0,P1,jb_,qrel,hi);}while(0)
  bool resc=false;
  #define START(P0,P1) do{ const float rm=rowmax(P0,P1); resc=false; \
    { const float dl=rm; mhat=fadd_s(mhat,dl); \
      _Pragma("unroll") for(int r=0;r<16;++r){P0[r]=fsub_s(P0[r],dl);P1[r]=fsub_s(P1[r],dl);} \
      _Pragma("unroll") for(int r=0;r<16;++r)negm[r]=-mhat; asm volatile("":"+v"(negm)); } \
    _Pragma("unroll") for(int r=0;r<16;++r)P0[r]=__builtin_amdgcn_exp2f(P0[r]); }while(0)
  #define RESC() do{ if(resc){ asm volatile("s_waitcnt lgkmcnt(0)":::"memory"); \
      _Pragma("unroll") for(int d_=0;d_<2;++d_) _Pragma("unroll") for(int r=0;r<16;++r)o[d_][r]*=wsf[crow(r,hi)]; } }while(0)
  f32x16 pA0,pA1,pB0,pB1;
  int sl_prev=0,sl_cur=0,sl_next=SLOTB;
  #define ROT() do{sl_prev=sl_cur;sl_cur=sl_next;sl_next=(sl_next==(NSLOT-1)*SLOTB)?0:sl_next+SLOTB;}while(0)
  DMA_K(2,2*SLOTB);
  WAIT_BAR(3);
  qkt(pA0,pA1,Kbase,qr,negm,r32,hi);asm volatile("s_nop 15\n\ts_nop 7":"+v"(pA0),"+v"(pA1));CMASK(pA0,pA1,0);
  START(pA0,pA1);
  _Pragma("unroll") for(int r=0;r<16;++r)pA1[r]=__builtin_amdgcn_exp2f(pA1[r]);
  WAIT_BAR(0);
  DMA_K(3,0);DMA_V(1,SLOTB);
  ROT();
  kload8(kf,kp0+sl_cur);
  WAIT_BAR(2);
  s16x4 vlo[8],vhi[8]; u32x4 pw0,pw1,pw2,pw3;
  #define PKW(P,B) cvtpk_s(P[B],P[B+1])
  #define PAF(k) __builtin_bit_cast(bf16x8,pw##k)
  #define VFR(i) (bf16x8){vlo[i][0],vlo[i][1],vlo[i][2],vlo[i][3],vhi[i][0],vhi[i][1],vhi[i][2],vhi[i][3]}
  #define PIN(x) asm volatile("":"+v"(x))
  #define MX3(a,b,c) __builtin_fmaxf(__builtin_fmaxf((a),(b)),(c))
  #define GAPA(MF,A0,A1,A2,A3,W0,W1,PW) do{ MF; sacc+=A0; sacc+=A1; sacc+=A2; sacc+=A3; PIN(sacc); W0; W1; PIN(PW); SBAR(); }while(0)
  #define EX(v) __builtin_amdgcn_exp2f(v)
  #define GAPB(MF,X,B) do{ MF; X[B]=EX(X[B]); X[B+1]=EX(X[B+1]); X[B+2]=EX(X[B+2]); X[B+3]=EX(X[B+3]); PIN(X); SBAR(); }while(0)
  #define VRD(i) do{ vlo[i]=vtr(vp_+(((i)>>2)*4096+((i)&3)*1024)); vhi[i]=vtr(vp_+(((i)>>2)*4096+((i)&3)*1024+512)); }while(0)
  #define KRD(G,j) do{ if(G){ kload2(kf,kp0+sl_next,j); SBAR(); } }while(0)
  #define STEP(C0,C1,P0,P1,t,GK,GV,GL) do{ SBAR(); \
    const lds_cptr vp_=vp0+sl_prev; \
    VRD(0); SBAR(); float sacc=(P0[0]+P0[1]); \
    GAPA(C0=__builtin_amdgcn_mfma_f32_32x32x16_bf16(kf[0],qr[0],negm,0,0,0), P0[2],P0[3],P0[4],P0[5],     pw0[0]=PKW(P0,0), pw0[1]=PKW(P0,2), pw0); \
    VRD(4); SBAR(); GAPA(C1=__builtin_amdgcn_mfma_f32_32x32x16_bf16(kf[1],qr[0],negm,0,0,0), P0[6],P0[7],P0[8],P0[9],     pw0[2]=PKW(P0,4), pw0[3]=PKW(P0,6), pw0); \
    VRD(1); SBAR(); GAPA(C0=__builtin_amdgcn_mfma_f32_32x32x16_bf16(kf[2],qr[1],C0,0,0,0),   P0[10],P0[11],P0[12],P0[13], pw1[0]=PKW(P0,8), pw1[1]=PKW(P0,10), pw1); \
    VRD(5); SBAR(); GAPA(C1=__builtin_amdgcn_mfma_f32_32x32x16_bf16(kf[3],qr[1],C1,0,0,0),   P0[14],P0[15],P1[0],P1[1],   pw1[2]=PKW(P0,12),pw1[3]=PKW(P0,14), pw1); \
    VRD(2); SBAR(); GAPA(C0=__builtin_amdgcn_mfma_f32_32x32x16_bf16(kf[4],qr[2],C0,0,0,0),   P1[2],P1[3],P1[4],P1[5],     pw2[0]=PKW(P1,0), pw2[1]=PKW(P1,2), pw2); \
    VRD(6); SBAR(); GAPA(C1=__builtin_amdgcn_mfma_f32_32x32x16_bf16(kf[5],qr[2],C1,0,0,0),   P1[6],P1[7],P1[8],P1[9],     pw2[2]=PKW(P1,4), pw2[3]=PKW(P1,6), pw2); \
    VRD(3); SBAR(); GAPA(C0=__builtin_amdgcn_mfma_f32_32x32x16_bf16(kf[6],qr[3],C0,0,0,0),   P1[10],P1[11],P1[12],P1[13], pw3[0]=PKW(P1,8), pw3[1]=PKW(P1,10), pw3); \
    VRD(7); SBAR(); GAPA(C1=__builtin_amdgcn_mfma_f32_32x32x16_bf16(kf[7],qr[3],C1,0,0,0),   P1[14],P1[15],0.f,0.f,       pw3[2]=PKW(P1,12),pw3[3]=PKW(P1,14), pw3); \
    l_reg+=sacc; \
    if(GK){DMA_K((t)+3,sl_cur);} if(GV){DMA_V((t)+1,sl_next);} \
    CMASK(C0,C1,t); \
    { float a=MX3(C0[0],C0[1],C1[0]),b=MX3(C0[2],C0[3],C1[1]); a=MX3(a,C1[2],C1[3]); \
      _Pragma("unroll") for(int r=4;r<16;r+=4){a=MX3(a,C0[r],C0[r+1]);b=MX3(b,C0[r+2],C0[r+3]);a=MX3(a,C1[r],C1[r+1]);b=MX3(b,C1[r+2],C1[r+3]);} \
      float rm=__builtin_fmaxf(a,b); { auto rr=__builtin_amdgcn_permlane32_swap(__float_as_uint(rm),__float_as_uint(rm),false,false); rm=__builtin_fmaxf(__uint_as_float(rr[0]),__uint_as_float(rr[1])); } \
      resc=false; \
      if(__builtin_expect(__any(rm>(float)THRL),0)){ const float dl=__builtin_fmaxf(rm,0.f); mhat+=dl; \
        _Pragma("unroll") for(int r=0;r<16;++r){C0[r]-=dl;C1[r]-=dl;} \
        _Pragma("unroll") for(int r=0;r<16;++r)negm[r]=-mhat; asm volatile("":"+v"(negm)); \
        const float f=__builtin_amdgcn_exp2f(-dl); l_reg*=f; if(hi==0)wsf[r32]=f; resc=true; } } \
    SBAR(); \
    GAPB(o[0]=__builtin_amdgcn_mfma_f32_32x32x16_bf16(PAF(0),VFR(0),o[0],0,0,0), C0,0); \
    GAPB(o[1]=__builtin_amdgcn_mfma_f32_32x32x16_bf16(PAF(0),VFR(4),o[1],0,0,0), C0,4); \
    KRD(GL,0); GAPB(o[0]=__builtin_amdgcn_mfma_f32_32x32x16_bf16(PAF(1),VFR(1),o[0],0,0,0), C0,8); \
    KRD(GL,1); GAPB(o[1]=__builtin_amdgcn_mfma_f32_32x32x16_bf16(PAF(1),VFR(5),o[1],0,0,0), C0,12); \
    KRD(GL,2); GAPB(o[0]=__builtin_amdgcn_mfma_f32_32x32x16_bf16(PAF(2),VFR(2),o[0],0,0,0), C1,0); \
    KRD(GL,3); GAPB(o[1]=__builtin_amdgcn_mfma_f32_32x32x16_bf16(PAF(2),VFR(6),o[1],0,0,0), C1,4); \
    GAPB(o[0]=__builtin_amdgcn_mfma_f32_32x32x16_bf16(PAF(3),VFR(3),o[0],0,0,0), C1,8); \
    GAPB(o[1]=__builtin_amdgcn_mfma_f32_32x32x16_bf16(PAF(3),VFR(7),o[1],0,0,0), C1,12); \
    }while(0)
  int t=1;
  #undef CMASK
  #define CMASK(P0,P1,t) do{}while(0)
  for(;t+5<NT;t+=2){
    STEP(pB0,pB1,pA0,pA1,t,true,true,true);     WAIT_BAR(2); RESC(); ROT();
    STEP(pA0,pA1,pB0,pB1,t+1,true,true,true);   WAIT_BAR(2); RESC(); ROT();
  }
  #undef CMASK
  #define CMASK(P0,P1,t) do{int jb_=(t)-(NT-4); if(jb_>=0)cmask(P0,P1,jb_,qrel,hi);}while(0)
  #define ENDW(tt) do{ if((tt)+3<NT){WAIT_BAR(2);} else if((tt)+2<NT){WAIT_BAR(1);} else {WAIT_BAR(0);} }while(0)
  for(;t+1<NT;t+=2){
    STEP(pB0,pB1,pA0,pA1,t,(t+3<NT),(t+1<NT),(t+1<NT));       ENDW(t);   RESC(); ROT();
    STEP(pA0,pA1,pB0,pB1,t+1,(t+4<NT),(t+2<NT),(t+2<NT));     ENDW(t+1); RESC(); ROT();
  }
  STEP(pB0,pB1,pA0,pA1,NT-1,false,false,false); RESC();
  { float sacc=pB0[0]+pB0[1]; _Pragma("unroll") for(int r=2;r<16;++r)sacc+=pB0[r]; _Pragma("unroll") for(int r=0;r<16;++r)sacc+=pB1[r]; l_reg+=sacc;
    pw0=(u32x4){PKW(pB0,0),PKW(pB0,2),PKW(pB0,4),PKW(pB0,6)};pw1=(u32x4){PKW(pB0,8),PKW(pB0,10),PKW(pB0,12),PKW(pB0,14)};pw2=(u32x4){PKW(pB1,0),PKW(pB1,2),PKW(pB1,4),PKW(pB1,6)};pw3=(u32x4){PKW(pB1,8),PKW(pB1,10),PKW(pB1,12),PKW(pB1,14)};
    SBAR(); pv(o,vb0+sl_cur,PAF(0),PAF(1),PAF(2),PAF(3)); }
  #undef PKW
  #undef PAF
  #undef VFR
  #undef PIN
  #undef MX3
  #undef GAPA
  #undef GAPB
  #undef EX
  #undef VRD
  #undef KRD
  #undef STEP
  #undef ENDW
  {auto rr=__builtin_amdgcn_permlane32_swap(__float_as_uint(l_reg),__float_as_uint(l_reg),false,false);l_reg=__uint_as_float(rr[0])+__uint_as_float(rr[1]);}
  if(hi==0)wsf[32+r32]=l_reg;asm volatile("s_waitcnt lgkmcnt(0)":::"memory");
  float rli[16];
  #pragma unroll
  for(int r=0;r<16;++r)rli[r]=__builtin_amdgcn_rcpf(wsf[32+crow(r,hi)]);
  bf16*Ow=O+(rowbase+q0+wid*QBLK)*OP+os*D;
  { bf16*stg=(bf16*)(shm+LDS_OST)+wid*2048;
    #pragma unroll
    for(int r=0;r<16;++r){const int orow=crow(r,hi);
      #pragma unroll
      for(int d0=0;d0<2;++d0)stg[orow*64+d0*32+r32]=__float2bfloat16(o[d0][r]*rli[r]);}
    asm volatile("s_waitcnt lgkmcnt(0)":::"memory");
    #pragma unroll
    for(int i=0;i<4;++i){const int row=i*8+(lane>>3),ch=lane&7; const u32x4 v=*(const u32x4*)(stg+row*64+ch*8); ATTN_STORE16(Ow+(long)row*OP+ch*8,v);} }
  asm volatile("s_waitcnt lgkmcnt(0)\n\ts_barrier":::"memory");
  #undef DMA_K
  #undef DMA_V
  #undef CMASK
  #undef START
  #undef RESC
  #undef ROT
}
constexpr int ATTN_LDS_BYTES=LDS_BYTES;
#undef SBAR
#undef WAIT_BAR
}


constexpr int NB = 16, T = 4096, D = 1024, M = NB * T, INW = 6144, FF = 2816, NG = 64, NP = 64;
constexpr float LN_EPS = 1e-5f, RMS_EPS = 1e-5f;
constexpr float DN_ALPHA = 1.189207115002721f;
constexpr float LAMBDA_INIT = 0.2f;
constexpr int NWAVES = 8, NTHREADS = 512;
constexpr size_t MiB = 1u << 20;
constexpr size_t WS_MODP = 0;
constexpr size_t WS_MOD = 6 * MiB;
constexpr size_t WS_WIN = 8 * MiB, WS_WGLU = 20 * MiB, WS_WBS = 22 * MiB, WS_WBA = 24 * MiB, WS_WOUT = 26 * MiB, WS_WUP = 28 * MiB, WS_WDOWN = 40 * MiB;
constexpr size_t WS_PROJ = 64 * MiB;
constexpr size_t WS_HB = 832 * MiB;
constexpr size_t WS_END = 960 * MiB;
constexpr int LDS_BYTES = 147456;
constexpr size_t WS_CTL = 7 * MiB, CTL_ZERO_BYTES = 64 * 1024;
constexpr int CW_BAR = 1024, CW_QUEUE = 8192;
constexpr int LDSCTL_OFF = 131072, MISC_OFF = LDSCTL_OFF + 320;

#define GAS __attribute__((address_space(1)))
#define LAS __attribute__((address_space(3)))
typedef unsigned short bf16;
typedef unsigned v4u __attribute__((ext_vector_type(4)));
typedef unsigned v2u __attribute__((ext_vector_type(2)));
typedef float f32x4 __attribute__((ext_vector_type(4)));
typedef float f32x16 __attribute__((ext_vector_type(16)));
typedef short bf16x8 __attribute__((ext_vector_type(8)));
#define LDS_WAIT() asm volatile("s_waitcnt lgkmcnt(0)" ::: "memory")
__device__ __forceinline__ unsigned f2bf(float f) { unsigned u = __builtin_bit_cast(unsigned, f); return (u + 0x7fffu + ((u >> 16) & 1u)) >> 16; }
typedef float f32x2_t __attribute__((ext_vector_type(2))); typedef __bf16 bf16x2_t __attribute__((ext_vector_type(2)));
__device__ __forceinline__ unsigned pk2(float lo, float hi) { f32x2_t v = {lo, hi}; bf16x2_t b = __builtin_convertvector(v, bf16x2_t); return __builtin_bit_cast(unsigned, b); }
__device__ __forceinline__ float bfl(unsigned u) { return __uint_as_float(u << 16); }
__device__ __forceinline__ float bfh(unsigned u) { return __uint_as_float(u & 0xffff0000u); }
__device__ __forceinline__ float wave_sum(float v) {
#pragma unroll
    for (int o = 1; o < 64; o <<= 1) v += __shfl_xor(v, o);
    return v;
}
__device__ __forceinline__ float sigm(float x) { return 1.0f / (1.0f + __expf(-x)); }

struct Args { const float* in[31]; float* out; unsigned char* ws; };
typedef const Args __attribute__((address_space(4)))* KArgs;
__device__ __forceinline__ KArgs kargs() { unsigned long long p = (unsigned long long)__builtin_amdgcn_kernarg_segment_ptr(); asm volatile("" : "+s"(p)); return (KArgs)p; }

typedef GAS unsigned gu32;
#define XB_TMO      128
#define XB_XCNT(j)  (256  + 64 * (j))
#define XB_XSUB(j)  (1280 + 64 * (j))
#define XB_XGEN(j)  (2304 + 64 * (j))
#define XB_TOP      3328
#define XB_TOPGEN   3392
#define XCD_BAR_WORDS 3456
#define XB_SPIN_CAP (1u << 18)

__device__ __forceinline__ unsigned xb_ld(unsigned* p)              { return __hip_atomic_load(p, __ATOMIC_RELAXED, __HIP_MEMORY_SCOPE_AGENT); }
__device__ __forceinline__ unsigned xb_add(unsigned* p, unsigned v) { return __hip_atomic_fetch_add(p, v, __ATOMIC_RELAXED, __HIP_MEMORY_SCOPE_AGENT); }
__device__ __forceinline__ unsigned xb_xcc_id() { return (unsigned)__builtin_amdgcn_s_getreg((3 << 11) | 20) & 0xFu; }
#define XB_SPIN(cond, bar) do { unsigned _sp = 0; while (cond) { __builtin_amdgcn_s_sleep(1); \
    if ((++_sp & 255u) == 0u) { if (xb_ld(&(bar)[XB_TMO])) break; if (_sp > XB_SPIN_CAP) { atomicAdd(&(bar)[XB_TMO], 1u); break; } } } } while (0)

struct XcdBarrier {
    unsigned* bar; unsigned x;
    volatile LAS unsigned* st;
};

__device__ __forceinline__ XcdBarrier xcd_barrier_post(unsigned* bar, volatile LAS unsigned* st) {
    XcdBarrier b; b.bar = bar; b.x = xb_xcc_id(); b.st = st;
    if (threadIdx.x == 0) (void)xb_add(&bar[XB_XCNT(b.x)], 1u);
    return b;
}
__device__ __forceinline__ void xcd_barrier_complete(unsigned* bar, unsigned x, unsigned& nloc, unsigned& nx) {
    const unsigned G = gridDim.x * gridDim.y * gridDim.z;
    unsigned sum, cnt, mine, sp = 0u;
    for (;;) {
        sum = 0u; cnt = 0u; mine = 0u;
#pragma unroll
        for (unsigned j = 0; j < 16; ++j) { const unsigned c = xb_ld(&bar[XB_XCNT(j)]); sum += c; cnt += (c > 0u) ? 1u : 0u; mine = (j == x) ? c : mine; }
        if (sum == G) break;
        __builtin_amdgcn_s_sleep(1);
        if ((++sp & 255u) == 0u) { if (xb_ld(&bar[XB_TMO])) break; if (sp > XB_SPIN_CAP) { atomicAdd(&bar[XB_TMO], 1u); break; } }
    }
    nloc = mine > 0u ? mine : 1u; nx = cnt > 0u ? cnt : 1u;
}

__device__ __forceinline__ void xcd_barrier(const XcdBarrier& b) {
    asm volatile("s_waitcnt vmcnt(0)" ::: "memory");
    __syncthreads();
    if (threadIdx.x == 0) {
        unsigned* bar = b.bar;
        __builtin_amdgcn_s_waitcnt(0);
        unsigned nloc = b.st[0], nx = b.st[1];
        if (nloc == 0u) { xcd_barrier_complete(bar, b.x, nloc, nx); b.st[0] = nloc; b.st[1] = nx; }
        const unsigned old = xb_add(&bar[XB_XSUB(b.x)], 1u);
        const unsigned gen = old / nloc;
        if (old + 1u == (gen + 1u) * nloc) {
            __builtin_amdgcn_fence(__ATOMIC_RELEASE, "agent");
            asm volatile("s_waitcnt vmcnt(0)" ::: "memory");
            const unsigned og = xb_add(&bar[XB_TOP], 1u);
            const unsigned tg = og / nx;
            if (og + 1u == (tg + 1u) * nx) xb_add(&bar[XB_TOPGEN], 1u);
            else XB_SPIN(xb_ld(&bar[XB_TOPGEN]) == tg, bar);
            __builtin_amdgcn_fence(__ATOMIC_ACQUIRE, "agent");
            xb_add(&bar[XB_XGEN(b.x)], 1u);
            asm volatile("s_waitcnt vmcnt(0)" ::: "memory");
        } else {
            XB_SPIN(xb_ld(&bar[XB_XGEN(b.x)]) == gen, bar);
            __builtin_amdgcn_fence(__ATOMIC_ACQUIRE, "agent");
            asm volatile("s_waitcnt vmcnt(0)" ::: "memory");
        }
    }
    __syncthreads();
}


__device__ __forceinline__ void p0_transpose_item(const float* W, int K, int N, bf16* WT, LAS float* scr, int item, int lane) {
    const int nblk = N / 32, kb = item / nblk, nb = item % nblk, k0 = 64 * kb, n0 = 32 * nb;
#pragma unroll 8
    for (int i = 0; i < 32; ++i) { const int kk = 2 * i + (lane >> 5); scr[kk * 33 + (lane & 31)] = W[(size_t)(k0 + kk) * N + n0 + (lane & 31)]; }
    LDS_WAIT(); asm volatile("" ::: "memory");
    const int c = lane & 7;
#pragma unroll
    for (int j = 0; j < 4; ++j) { const int n = (lane >> 3) + 8 * j; const LAS float* s = scr + (8 * c) * 33 + n;
        v4u o; o.x = pk2(s[0 * 33], s[1 * 33]); o.y = pk2(s[2 * 33], s[3 * 33]); o.z = pk2(s[4 * 33], s[5 * 33]); o.w = pk2(s[6 * 33], s[7 * 33]);
        *(v4u*)(WT + (size_t)(n0 + n) * K + k0 + 8 * c) = o; }
    LDS_WAIT(); asm volatile("" ::: "memory");
}

__device__ __forceinline__ void p0_mod_item(const float* c, const float* w_mod, const float* b_mod, float* part, int item, int lane) {
    const int cgp = item % 96, ks = item / 96, col = cgp * 64 + lane;
    float acc[16];
#pragma unroll
    for (int b = 0; b < 16; ++b) acc[b] = 0.f;
    for (int kk = 0; kk < 64; ++kk) {
        const int k = ks * 64 + kk;
        const float w = w_mod[(size_t)k * INW + col];
#pragma unroll
        for (int b = 0; b < 16; ++b) { const float cv = c[b * D + k]; acc[b] += (cv * sigm(cv)) * w; }
    }
    const float bm = (ks == 0) ? b_mod[col] : 0.f;
#pragma unroll
    for (int b = 0; b < 16; ++b) part[((size_t)ks * 16 + b) * INW + col] = acc[b] + bm;
}


__device__ __forceinline__ void ldrow(const float* p, int lane, f32x4 (&v)[4]) { const f32x4* xr = (const f32x4*)p + lane;
#pragma unroll
    for (int j = 0; j < 4; ++j) v[j] = xr[64 * j]; }
__device__ __forceinline__ void row_stats2(const f32x4 (&a)[4], const f32x4 (&b)[4], float& ma, float& ra, float& mb, float& rb) {
    float sa = 0.f, qa = 0.f, sb = 0.f, qb = 0.f;
#pragma unroll
    for (int j = 0; j < 4; ++j) { sa += (a[j].x + a[j].y) + (a[j].z + a[j].w); qa += (a[j].x * a[j].x + a[j].y * a[j].y) + (a[j].z * a[j].z + a[j].w * a[j].w);
                                  sb += (b[j].x + b[j].y) + (b[j].z + b[j].w); qb += (b[j].x * b[j].x + b[j].y * b[j].y) + (b[j].z * b[j].z + b[j].w * b[j].w); }
#pragma unroll
    for (int o = 1; o < 64; o <<= 1) { sa += __shfl_xor(sa, o); qa += __shfl_xor(qa, o); sb += __shfl_xor(sb, o); qb += __shfl_xor(qb, o); }
    ma = sa * (1.f / D); mb = sb * (1.f / D);
    ra = 1.f / sqrtf(fmaxf(qa * (1.f / D) - ma * ma, 0.f) + LN_EPS); rb = 1.f / sqrtf(fmaxf(qb * (1.f / D) - mb * mb, 0.f) + LN_EPS);
}
__device__ __forceinline__ void st_bf16row(bf16* orow, int lane, const f32x4 (&y)[4]) { v2u* o8 = (v2u*)orow + lane;
#pragma unroll
    for (int j = 0; j < 4; ++j) { v2u w; w.x = pk2(y[j].x, y[j].y); w.y = pk2(y[j].z, y[j].w); o8[64 * j] = w; } }
template <int MODE> __device__ __forceinline__ void ln_pass(const float* src, float* dstf, bf16* dsth, const float* g, const float* bta, const float* mod, int sh_off, int sc_off, int gw, int NGW, int lane) {
    f32x4 ca[4], cb[4], na[4], nb[4];
    int m = gw;
    if (m < M) { ldrow(src + (size_t)m * D, lane, ca); ldrow(src + (size_t)(m + NGW) * D, lane, cb); }
    for (; m < M; m += 2 * NGW) {
        const int mn = m + 2 * NGW;
        if (mn < M) { ldrow(src + (size_t)mn * D, lane, na); ldrow(src + (size_t)(mn + NGW) * D, lane, nb); }
        float ma, ra, mb, rb; row_stats2(ca, cb, ma, ra, mb, rb);
        if (MODE == 0) {
            const float* moda = mod + (size_t)(m >> 12) * INW; const float* modb = mod + (size_t)((m + NGW) >> 12) * INW;
#pragma unroll
            for (int j = 0; j < 4; ++j) { const f32x4 sca = ((const f32x4*)(moda + sc_off))[lane + 64 * j], sha = ((const f32x4*)(moda + sh_off))[lane + 64 * j];
                                          const f32x4 scb = ((const f32x4*)(modb + sc_off))[lane + 64 * j], shb = ((const f32x4*)(modb + sh_off))[lane + 64 * j];
                ca[j] = (ca[j] - ma) * ra * (sca + 1.0f) + sha; cb[j] = (cb[j] - mb) * rb * (scb + 1.0f) + shb; }
            st_bf16row(dsth + (size_t)m * D, lane, ca); st_bf16row(dsth + (size_t)(m + NGW) * D, lane, cb);
        } else {
#pragma unroll
            for (int j = 0; j < 4; ++j) { const f32x4 gg = ((const f32x4*)g)[lane + 64 * j], bb = ((const f32x4*)bta)[lane + 64 * j];
                ca[j] = (ca[j] - ma) * ra * gg + bb; cb[j] = (cb[j] - mb) * rb * gg + bb;
                ((f32x4*)(dstf + (size_t)m * D))[lane + 64 * j] = ca[j]; ((f32x4*)(dstf + (size_t)(m + NGW) * D))[lane + 64 * j] = cb[j]; }
            if (MODE == 1) {
                row_stats2(ca, cb, ma, ra, mb, rb);
                const float* moda = mod + (size_t)(m >> 12) * INW; const float* modb = mod + (size_t)((m + NGW) >> 12) * INW;
#pragma unroll
                for (int j = 0; j < 4; ++j) { const f32x4 sca = ((const f32x4*)(moda + sc_off))[lane + 64 * j], sha = ((const f32x4*)(moda + sh_off))[lane + 64 * j];
                                              const f32x4 scb = ((const f32x4*)(modb + sc_off))[lane + 64 * j], shb = ((const f32x4*)(modb + sh_off))[lane + 64 * j];
                    ca[j] = (ca[j] - ma) * ra * (sca + 1.0f) + sha; cb[j] = (cb[j] - mb) * rb * (scb + 1.0f) + shb; }
                st_bf16row(dsth + (size_t)m * D, lane, ca); st_bf16row(dsth + (size_t)(m + NGW) * D, lane, cb);
            }
        }
#pragma unroll
        for (int j = 0; j < 4; ++j) { ca[j] = na[j]; cb[j] = nb[j]; }
    }
}

__device__ __forceinline__ float gelu_tanh(float x) {
    const float u = 0.7978845608028654f * (x + 0.044715f * x * x * x);
    return x * __builtin_amdgcn_rcpf(1.0f + __expf(-2.0f * u));
}
__device__ __forceinline__ bf16x8 pack8(const float (&f)[8]) {
    v4u w; w.x = pk2(f[0], f[1]); w.y = pk2(f[2], f[3]); w.z = pk2(f[4], f[5]); w.w = pk2(f[6], f[7]); return __builtin_bit_cast(bf16x8, w);
}

__device__ __forceinline__ void ssm_item(KArgs a, int g, int bp, LAS unsigned char* wl, int lane) {
    const float* lam_re = a->in[5]; const float* lam_im = a->in[6]; const float* log_dt = a->in[7];
    const float* b_re = a->in[8]; const float* b_im = a->in[9]; const float* c_re = a->in[10]; const float* c_im = a->in[11]; const float* dsk = a->in[12];
    const bf16* proj = (const bf16*)(a->ws + WS_PROJ); bf16* zb = (bf16*)(a->ws + WS_HB);
    const int r = lane & 31, h = lane >> 5;
    const float dt = expf(log_dt[g]);
    float are[2], aim[2];
    bf16x8 bfr[4];
#pragma unroll
    for (int i = 0; i < 2; ++i) {
        const int p = r + 32 * i; const float lr = lam_re[g * NP + p], li = lam_im[g * NP + p];
        const float mag = expf(lr * dt), ar = mag * cosf(li * dt), ai = mag * sinf(li * dt);
        const float den = lr * lr + li * li, nr = ar - 1.0f, ni = ai;
        const float cr = (nr * lr + ni * li) / den, ci = (ni * lr - nr * li) / den;
        are[i] = ar; aim[i] = ai;
        const float* br = b_re + ((size_t)(g * NP + p)) * 16 + 8 * h; const float* bi = b_im + ((size_t)(g * NP + p)) * 16 + 8 * h;
        float fre[8], fim[8];
#pragma unroll
        for (int j = 0; j < 8; ++j) { fre[j] = cr * br[j] - ci * bi[j]; fim[j] = cr * bi[j] + ci * br[j]; }
        bfr[i] = pack8(fre); bfr[2 + i] = pack8(fim);
    }
    const int cch = lane & 15, kg = lane >> 4;
    bf16x8 cfr[4], dfr;
#pragma unroll
    for (int s = 0; s < 4; ++s) {
        const int p0 = 8 * s + 2 * kg; const float* cr = c_re + ((size_t)(g * 16 + cch)) * NP; const float* ci = c_im + ((size_t)(g * 16 + cch)) * NP;
        float f[8] = {cr[p0], -ci[p0], cr[p0 + 32], -ci[p0 + 32], cr[p0 + 1], -ci[p0 + 1], cr[p0 + 33], -ci[p0 + 33]};
        cfr[s] = pack8(f);
    }
    { float f[8];
#pragma unroll
      for (int j = 0; j < 8; ++j) f[j] = (kg < 2 && (8 * kg + j) == cch) ? dsk[g * 16 + cch] : 0.f;
      dfr = pack8(f); }
    const int b0 = 2 * bp;
    const int beta_r = (r >> 2) & 1, tok_r = 4 * (r >> 3) + (r & 3);
    const bf16* ua = proj + ((size_t)(b0 + beta_r) * T + tok_r) * INW + g * 16 + 8 * h;
    const bf16* ud = proj + ((size_t)b0 * T + cch) * INW + g * 16 + 8 * (kg & 1);
    bf16* zo = zb + ((size_t)b0 * T + 4 * kg) * D + g * 16 + cch;
    float sr[2] = {0.f, 0.f}, si[2] = {0.f, 0.f};
    LAS unsigned char* wrow = wl + (16 * h) * 272 + 8 * r;
    const LAS unsigned char* rrow = wl + cch * 272 + 16 * kg;
    bf16x8 af = *(const bf16x8*)(ua);
    for (int t0 = 0; t0 < T; t0 += 16) {
        const bf16x8 afc = af;
        if (t0 + 16 < T) af = *(const bf16x8*)(ua + (size_t)(t0 + 16) * INW);
        bf16x8 u0 = {0, 0, 0, 0, 0, 0, 0, 0}, u1 = {0, 0, 0, 0, 0, 0, 0, 0};
        if (kg < 2) { u0 = *(const bf16x8*)(ud + (size_t)t0 * INW); u1 = *(const bf16x8*)(ud + (size_t)(T + t0) * INW); }
        const f32x16 zz = {0.f, 0.f, 0.f, 0.f, 0.f, 0.f, 0.f, 0.f, 0.f, 0.f, 0.f, 0.f, 0.f, 0.f, 0.f, 0.f};
        const f32x16 bre0 = __builtin_amdgcn_mfma_f32_32x32x16_bf16(afc, bfr[0], zz, 0, 0, 0);
        const f32x16 bre1 = __builtin_amdgcn_mfma_f32_32x32x16_bf16(afc, bfr[1], zz, 0, 0, 0);
        const f32x16 bim0 = __builtin_amdgcn_mfma_f32_32x32x16_bf16(afc, bfr[2], zz, 0, 0, 0);
        const f32x16 bim1 = __builtin_amdgcn_mfma_f32_32x32x16_bf16(afc, bfr[3], zz, 0, 0, 0);
#pragma unroll
        for (int t = 0; t < 16; ++t) {
            const float nr0 = are[0] * sr[0] - aim[0] * si[0] + bre0[t], ni0 = are[0] * si[0] + aim[0] * sr[0] + bim0[t];
            const float nr1 = are[1] * sr[1] - aim[1] * si[1] + bre1[t], ni1 = are[1] * si[1] + aim[1] * sr[1] + bim1[t];
            sr[0] = nr0; si[0] = ni0; sr[1] = nr1; si[1] = ni1;
            v2u w; w.x = pk2(nr0, ni0); w.y = pk2(nr1, ni1);
            *(LAS v2u*)(wrow + t * 272) = w;
        }
        LDS_WAIT(); asm volatile("" ::: "memory");
#pragma unroll
        for (int be = 0; be < 2; ++be) {
            f32x4 y = {0.f, 0.f, 0.f, 0.f};
#pragma unroll
            for (int s = 0; s < 4; ++s) { const bf16x8 sa = *(const LAS bf16x8*)(rrow + be * 16 * 272 + 64 * s); y = __builtin_amdgcn_mfma_f32_16x16x32_bf16(sa, cfr[s], y, 0, 0, 0); }
            y = __builtin_amdgcn_mfma_f32_16x16x32_bf16(be ? u1 : u0, dfr, y, 0, 0, 0);
#pragma unroll
            for (int q = 0; q < 4; ++q) zo[((size_t)be * T + t0 + q) * D] = (bf16)pk2(gelu_tanh(y[q]), 0.f);
        }
        LDS_WAIT(); asm volatile("" ::: "memory");
    }
}

struct YRow { v4u a0, a1, b0, b1; };
__device__ __forceinline__ void yatt_load(const bf16* orow, int lane, YRow& r) {
    const int hh = lane >> 3, e0 = (lane & 7) * 16;
    const bf16* p1 = orow + (4 * hh + (e0 >> 6)) * 64 + (e0 & 63);
    r.a0 = *(const v4u*)(p1); r.a1 = *(const v4u*)(p1 + 8); r.b0 = *(const v4u*)(p1 + 128); r.b1 = *(const v4u*)(p1 + 136);
}
__device__ __forceinline__ void yatt_fin(const YRow& r, bf16* yrow, const float (&sg)[16], float lam, int lane) {
    const int hh = lane >> 3, e0 = (lane & 7) * 16;
    float o[16];
#pragma unroll
    for (int i = 0; i < 2; ++i) { const v4u a = i ? r.a1 : r.a0, b = i ? r.b1 : r.b0;
        o[8 * i + 0] = bfl(a.x) - lam * bfl(b.x); o[8 * i + 1] = bfh(a.x) - lam * bfh(b.x); o[8 * i + 2] = bfl(a.y) - lam * bfl(b.y); o[8 * i + 3] = bfh(a.y) - lam * bfh(b.y);
        o[8 * i + 4] = bfl(a.z) - lam * bfl(b.z); o[8 * i + 5] = bfh(a.z) - lam * bfh(b.z); o[8 * i + 6] = bfl(a.w) - lam * bfl(b.w); o[8 * i + 7] = bfh(a.w) - lam * bfh(b.w); }
    float ss = 0.f;
#pragma unroll
    for (int j = 0; j < 16; ++j) ss += o[j] * o[j];
    ss += __shfl_xor(ss, 1); ss += __shfl_xor(ss, 2); ss += __shfl_xor(ss, 4);
    const float rs = 1.f / sqrtf(ss * (1.f / 128.f) + RMS_EPS) * (1.0f - LAMBDA_INIT);
    float y[16];
#pragma unroll
    for (int j = 0; j < 16; ++j) y[j] = o[j] * rs * sg[j];
    v4u w0, w1; w0.x = pk2(y[0], y[1]); w0.y = pk2(y[2], y[3]); w0.z = pk2(y[4], y[5]); w0.w = pk2(y[6], y[7]); w1.x = pk2(y[8], y[9]); w1.y = pk2(y[10], y[11]); w1.z = pk2(y[12], y[13]); w1.w = pk2(y[14], y[15]);
    *(v4u*)(yrow + hh * 128 + e0) = w0; *(v4u*)(yrow + hh * 128 + e0 + 8) = w1;
}
__device__ __forceinline__ void yatt_pass(const bf16* OBp, bf16* PROJp, const float* subg, float lam, int gw, int NGW, int lane) {
    float sg[16];
#pragma unroll
    for (int j = 0; j < 16; ++j) sg[j] = subg[(lane & 7) * 16 + j];
    YRow c0, c1, c2, c3, n0, n1, n2, n3;
    int m = gw;
    if (m < M) { yatt_load(OBp + (size_t)m * 2048, lane, c0); yatt_load(OBp + (size_t)(m + NGW) * 2048, lane, c1); yatt_load(OBp + (size_t)(m + 2 * NGW) * 2048, lane, c2); yatt_load(OBp + (size_t)(m + 3 * NGW) * 2048, lane, c3); }
    for (; m < M; m += 4 * NGW) {
        const int mn = m + 4 * NGW;
        if (mn < M) { yatt_load(OBp + (size_t)mn * 2048, lane, n0); yatt_load(OBp + (size_t)(mn + NGW) * 2048, lane, n1); yatt_load(OBp + (size_t)(mn + 2 * NGW) * 2048, lane, n2); yatt_load(OBp + (size_t)(mn + 3 * NGW) * 2048, lane, n3); }
        yatt_fin(c0, PROJp + (size_t)m * INW + 1024, sg, lam, lane); yatt_fin(c1, PROJp + (size_t)(m + NGW) * INW + 1024, sg, lam, lane);
        yatt_fin(c2, PROJp + (size_t)(m + 2 * NGW) * INW + 1024, sg, lam, lane); yatt_fin(c3, PROJp + (size_t)(m + 3 * NGW) * INW + 1024, sg, lam, lane);
        c0 = n0; c1 = n1; c2 = n2; c3 = n3;
    }
}

__device__ __forceinline__ void up8(const v4u p, float (&f)[8]) { f[0] = bfl(p.x); f[1] = bfh(p.x); f[2] = bfl(p.y); f[3] = bfh(p.y); f[4] = bfl(p.z); f[5] = bfh(p.z); f[6] = bfl(p.w); f[7] = bfh(p.w); }
__device__ __forceinline__ void conv_item(bf16* proj, const float* cw, const float* cb, int item) {
    const int cc = item % (FF / 8), rr = item / (FF / 8), f0 = cc * 8, t0 = rr * 8;
    bf16* base = proj + (size_t)t0 * INW + f0;
    v4u pa[10], pv[8];
    const bool first = (t0 & (T - 1)) == 0;
    const v4u zero4 = {0u, 0u, 0u, 0u};
    pa[0] = first ? zero4 : *(const v4u*)(base - 2 * (size_t)INW); pa[1] = first ? zero4 : *(const v4u*)(base - (size_t)INW);
#pragma unroll
    for (int i = 0; i < 8; ++i) { pa[2 + i] = *(const v4u*)(base + (size_t)i * INW); pv[i] = *(const v4u*)(base + (size_t)i * INW + FF); }
    float w0[8], w1[8], w2[8], bb[8];
#pragma unroll
    for (int j = 0; j < 8; ++j) { w0[j] = cw[f0 + j]; w1[j] = cw[FF + f0 + j]; w2[j] = cw[2 * FF + f0 + j]; bb[j] = cb[f0 + j]; }
    float am2[8], am1[8];
    up8(pa[0], am2); up8(pa[1], am1);
#pragma unroll
    for (int i = 0; i < 8; ++i) {
        float a0[8], vv[8], o[8]; up8(pa[2 + i], a0); up8(pv[i], vv);
#pragma unroll
        for (int j = 0; j < 8; ++j) { const float cv = w0[j] * am2[j] + w1[j] * am1[j] + w2[j] * a0[j] + bb[j]; o[j] = cv * __builtin_amdgcn_rcpf(1.0f + __expf(-cv)) * vv[j]; am2[j] = am1[j]; am1[j] = a0[j]; }
        v4u w; w.x = pk2(o[0], o[1]); w.y = pk2(o[2], o[3]); w.z = pk2(o[4], o[5]); w.w = pk2(o[6], o[7]);
        *(v4u*)(base + (size_t)i * INW + FF) = w;
    }
}

__global__ void __launch_bounds__(NTHREADS, 2) mk_fwd(Args args) {
    extern __shared__ __attribute__((aligned(16))) unsigned char lds[];
    cg::grid_group grid = cg::this_grid();
    LAS unsigned char* L = (LAS unsigned char*)lds;
    const int tid = threadIdx.x, lane = tid & 63, wave = __builtin_amdgcn_readfirstlane(tid >> 6);
    const int G = gridDim.x, bx = blockIdx.x;
    const int vcu = (G % 8 == 0) ? (bx % 8) * (G / 8) + bx / 8 : bx;
    const int gw = vcu * NWAVES + wave, NGW = G * NWAVES;
    unsigned char* ws = kargs()->ws;
    bf16* WinT = (bf16*)(ws + WS_WIN); bf16* WgluT = (bf16*)(ws + WS_WGLU); bf16* WbsT = (bf16*)(ws + WS_WBS); bf16* WbaT = (bf16*)(ws + WS_WBA);
    bf16* WoutT = (bf16*)(ws + WS_WOUT); bf16* WupT = (bf16*)(ws + WS_WUP); bf16* WdownT = (bf16*)(ws + WS_WDOWN);
    bf16* PROJ = (bf16*)(ws + WS_PROJ); bf16* HB = (bf16*)(ws + WS_HB);
    float* MODP = (float*)(ws + WS_MODP); float* MOD = (float*)(ws + WS_MOD);
    float* OUT = kargs()->out; bf16* OB = (bf16*)kargs()->out;
#define GSYNC_CG() do { __builtin_amdgcn_fence(__ATOMIC_RELEASE, "agent"); grid.sync(); __builtin_amdgcn_fence(__ATOMIC_ACQUIRE, "agent"); } while (0)
#define GSYNC() xcd_barrier(bar)
    for (int u = tid; u < (LDS_BYTES - LDSCTL_OFF) / 4; u += NTHREADS) ((LAS unsigned*)(L + LDSCTL_OFF))[u] = 0u;
    __syncthreads();
    const XcdBarrier bar = xcd_barrier_post((unsigned*)(ws + WS_CTL) + CW_BAR, (volatile LAS unsigned*)(L + MISC_OFF) + 8);

    {
        LAS float* scr = (LAS float*)(L + wave * 16384);
        constexpr int I_IN = (D / 64) * (INW / 32), I_SQ = (D / 64) * (D / 32), I_UP = (D / 64) * (2 * FF / 32), I_DN = (FF / 64) * (D / 32);
        constexpr int NITEMS = I_IN + 4 * I_SQ + I_UP + I_DN;
        for (int it = gw; it < NITEMS; it += NGW) {
            int r = it;
            if (r < I_IN) { p0_transpose_item(kargs()->in[4], D, INW, WinT, scr, r, lane); continue; } r -= I_IN;
            if (r < I_SQ) { p0_transpose_item(kargs()->in[13], D, D, WgluT, scr, r, lane); continue; } r -= I_SQ;
            if (r < I_SQ) { p0_transpose_item(kargs()->in[20], D, D, WbsT, scr, r, lane); continue; } r -= I_SQ;
            if (r < I_SQ) { p0_transpose_item(kargs()->in[21], D, D, WbaT, scr, r, lane); continue; } r -= I_SQ;
            if (r < I_SQ) { p0_transpose_item(kargs()->in[22], D, D, WoutT, scr, r, lane); continue; } r -= I_SQ;
            if (r < I_UP) { p0_transpose_item(kargs()->in[25], D, 2 * FF, WupT, scr, r, lane); continue; } r -= I_UP;
            p0_transpose_item(kargs()->in[28], FF, D, WdownT, scr, r, lane);
        }
        for (int it = gw; it < 96 * 16; it += NGW) p0_mod_item(kargs()->in[1], kargs()->in[2], kargs()->in[3], MODP, it, lane);
    }
    GSYNC_CG();
    for (int i = bx * NTHREADS + tid; i < 16 * INW; i += G * NTHREADS) { float s = 0.f;
#pragma unroll
        for (int ks = 0; ks < 16; ++ks) s += MODP[(size_t)ks * 16 * INW + i];
        MOD[i] = s; }
    GSYNC();
    ln_pass<0>(kargs()->in[0], nullptr, HB, nullptr, nullptr, MOD, 0, D, gw, NGW, lane);
    GSYNC();
    {
        pg8::Gemm g{HB, WinT, D, D, D}; pg8::StaticOrder S; S.init(M, INW, G, bx);
        pg8::Epi<pg8::EP_PROJ> E{}; E.O = PROJ; E.ldo = INW; E.qscale = attn_body::C2;
        pg8::gemm_phase<pg8::Epi<pg8::EP_PROJ>, pg8::StaticOrder, true, true>(L, g, S, E);
    }
    GSYNC();
    {
        if (bx < 64) {
            ssm_item(kargs(), (bx * 8 + wave) >> 3, (bx * 8 + wave) & 7, L + wave * 16384, lane);
            __syncthreads();
        }
        unsigned* qctr = (unsigned*)(ws + WS_CTL) + CW_QUEUE;
        volatile LAS unsigned* qw = (volatile LAS unsigned*)(L + MISC_OFF) + 16;
        for (;;) {
            if (tid == 0) qw[0] = __hip_atomic_fetch_add(qctr, 1u, __ATOMIC_RELAXED, __HIP_MEMORY_SCOPE_AGENT);
            __syncthreads();
            const int idx = __builtin_amdgcn_readfirstlane((int)qw[0]);
            __syncthreads();
            if (idx >= 8192) break;
            const int qb = 15 - (idx >> 9), combo = idx & 511;
            const int b = combo >> 5, hm = (combo >> 1) & 15, vh = combo & 1;
            attn_body::attn_unit<8>(b, hm, 2 * (hm >> 1) + vh, 2 * hm + vh, qb, (const attn_body::bf16*)(PROJ + 1024), (const attn_body::bf16*)(PROJ + 2048), (const attn_body::bf16*)(PROJ + 3072), (attn_body::bf16*)OB, (char*)lds);
        }
    }
    GSYNC();
    {
        float lam;
        { const float v1 = kargs()->in[15][lane] * kargs()->in[16][lane], v2 = kargs()->in[17][lane] * kargs()->in[18][lane];
          lam = expf(wave_sum(v1)) - expf(wave_sum(v2)) + LAMBDA_INIT; }
        yatt_pass(OB, PROJ, kargs()->in[19], lam, gw, NGW, lane);
        pg8::Gemm g{HB, WgluT, D, D, D}; pg8::StaticOrder S; S.init(M, D, G, bx);
        pg8::Epi<pg8::EP_GLU> E{}; E.O = PROJ; E.ldo = INW; E.X1 = HB; E.ldx1 = D; E.bias = kargs()->in[14];
        pg8::gemm_phase<pg8::Epi<pg8::EP_GLU>, pg8::StaticOrder, true, true>(L, g, S, E);
    }
    GSYNC();
    {
        pg8::Gemm g{PROJ, WbsT, INW, D, D}; pg8::StaticOrder S; S.init(M, D, G, bx);
        pg8::Epi<pg8::EP_BS> E{}; E.O = PROJ + 2048; E.ldo = INW; E.X1 = PROJ + 4096; E.ldx1 = INW;
        pg8::gemm_phase<pg8::Epi<pg8::EP_BS>, pg8::StaticOrder, true, true>(L, g, S, E);
    }
    {
        pg8::Gemm g{PROJ + 1024, WbaT, INW, D, D}; pg8::StaticOrder S; S.init(M, D, G, bx);
        pg8::Epi<pg8::EP_BA> E{}; E.O = PROJ + 3072; E.ldo = INW; E.X1 = PROJ + 5120; E.ldx1 = INW; E.X2 = PROJ + 2048; E.ldx2 = INW;
        pg8::gemm_phase<pg8::Epi<pg8::EP_BA>, pg8::StaticOrder, true, true>(L, g, S, E);
    }
    GSYNC();
    {
        pg8::Gemm g{PROJ + 3072, WoutT, INW, D, D}; pg8::StaticOrder S; S.init(M, D, G, bx);
        pg8::Epi<pg8::EP_OUT> E{}; E.F = OUT; E.R = kargs()->in[0]; E.gate = MOD + 2 * D; E.alpha = DN_ALPHA;
        pg8::gemm_phase<pg8::Epi<pg8::EP_OUT>, pg8::StaticOrder, true, true>(L, g, S, E);
    }
    GSYNC();
    ln_pass<1>(OUT, OUT, HB, kargs()->in[23], kargs()->in[24], MOD, 3 * D, 4 * D, gw, NGW, lane);
    GSYNC();
    {
        pg8::Gemm g{HB, WupT, D, D, D}; pg8::StaticOrder S; S.init(M, 2 * FF, G, bx);
        pg8::Epi<pg8::EP_UP> E{}; E.O = PROJ; E.ldo = INW;
        pg8::gemm_phase<pg8::Epi<pg8::EP_UP>, pg8::StaticOrder, true, true>(L, g, S, E);
    }
    GSYNC();
    for (int it = bx * NTHREADS + tid; it < (M / 8) * (FF / 8); it += G * NTHREADS) conv_item(PROJ, kargs()->in[26], kargs()->in[27], it);
    GSYNC();
    {
        pg8::Gemm g{PROJ + FF, WdownT, INW, FF, FF}; pg8::StaticOrder S; S.init(M, D, G, bx);
        pg8::Epi<pg8::EP_DOWN> E{}; E.F = OUT; E.R = OUT; E.gate = MOD + 5 * D; E.alpha = DN_ALPHA;
        pg8::gemm_phase<pg8::Epi<pg8::EP_DOWN>, pg8::StaticOrder, true, true>(L, g, S, E);
    }
    GSYNC();
    ln_pass<2>(OUT, OUT, nullptr, kargs()->in[29], kargs()->in[30], nullptr, 0, 0, gw, NGW, lane);
}

extern "C" void kernel_launch(void* const* d_in, const int* in_sizes, int n_in, void* d_out, int out_size, void* d_ws, size_t ws_size, hipStream_t stream) {
    static int grid = 0;
    if (grid == 0) {
        if (n_in != 31 || in_sizes[0] != M * D || out_size != M * D || ws_size < WS_END) { fprintf(stderr, "kernel_launch: unexpected shapes (n_in %d, in0 %d, out %d, ws %zu); nothing launched\n", n_in, n_in > 0 ? in_sizes[0] : -1, out_size, ws_size); grid = -1; return; }
        int dev = 0, cus = 0, per_cu = 0;
        if (hipGetDevice(&dev) != hipSuccess || hipDeviceGetAttribute(&cus, hipDeviceAttributeMultiprocessorCount, dev) != hipSuccess) { grid = -1; return; }
        if (hipFuncSetAttribute((const void*)mk_fwd, hipFuncAttributeMaxDynamicSharedMemorySize, LDS_BYTES) != hipSuccess) { fprintf(stderr, "kernel_launch: hipFuncSetAttribute failed\n"); grid = -1; return; }
        if (hipOccupancyMaxActiveBlocksPerMultiprocessor(&per_cu, (const void*)mk_fwd, NTHREADS, LDS_BYTES) != hipSuccess || per_cu < 1) { fprintf(stderr, "kernel_launch: occupancy query says %d\n", per_cu); per_cu = 1; }
        (void)hipGetLastError();
        grid = cus * per_cu;
    }
    if (grid < 0) return;
    if (hipMemsetAsync((char*)d_ws + WS_CTL, 0, CTL_ZERO_BYTES, stream) != hipSuccess) { fprintf(stderr, "kernel_launch: memset failed\n"); return; }
    Args a{};
    for (int i = 0; i < 31; ++i) a.in[i] = (const float*)d_in[i];
    a.out = (float*)d_out; a.ws = (unsigned char*)d_ws;
    void* kargs[] = {&a};
    hipError_t e = hipLaunchCooperativeKernel((const void*)mk_fwd, dim3(grid), dim3(NTHREADS), kargs, LDS_BYTES, stream);
    if (e != hipSuccess) fprintf(stderr, "kernel_launch: cooperative launch failed: %s (grid %d)\n", hipGetErrorString(e), grid);
}
```

```cpp
#include <hip/hip_runtime.h>
#include <hip/hip_cooperative_groups.h>
#include <cstdio>
#include <cstdint>
namespace cg = cooperative_groups;
namespace pg8 {
#define PG8_LAS __attribute__((address_space(3)))
typedef unsigned short bf16_t;
typedef short bf16x8 __attribute__((ext_vector_type(8)));
typedef float f32x4 __attribute__((ext_vector_type(4)));
typedef unsigned u32x4 __attribute__((ext_vector_type(4)));
constexpr int BM = 256, BK = 64, HALF = 128, HTB = HALF * BK * 2  , STAGE_BYTES = 8 * HTB, NXCD = 8, WGM = 8;

__host__ __device__ __forceinline__ int lds_byte(int r, int c) { const int st = (r >> 4) * 2 + (c >> 5), rr = r & 15, cc = c & 31, ob = rr * 64 + cc * 2; return st * 1024 + (ob ^ (((ob >> 9) & 1) << 5)); }
__host__ __device__ __forceinline__ void stage_rc(int b, int& R, int& C) { const int st = b / 1024, sb = b % 1024, swz = sb ^ (((sb >> 9) & 1) << 5); R = (st >> 1) * 16 + swz / 64; C = (st & 1) * 32 + (swz % 64) / 2; }
__host__ __device__ __forceinline__ int perm32(int rho) { const int n = rho >> 4, i = rho & 15; return 8 * (i >> 2) + 4 * n + (i & 3); }

struct Unit { int pm, pn; };
struct Gemm { const bf16_t* A; const bf16_t* Bt; int lda, ldb, K; };

struct StaticOrder {
    int nM, nN, nwg, G, c;
    __host__ __device__ void init(int M, int N, int G_, int c_) { nM = M / BM; nN = N / BM; nwg = nM * nN; G = G_; c = c_; }
    __host__ __device__ bool next(int i, Unit& u) const {
        const long L = (long)i * G + c; if (L >= nwg) return false;
        int wgid = (int)L; { const int q = nwg / NXCD, r = nwg % NXCD, xcd = wgid % NXCD, off = wgid / NXCD; wgid = (xcd < r ? xcd * (q + 1) : r * (q + 1) + (xcd - r) * q) + off; }
        const int nig = WGM * nN, gid = wgid / nig, fm = gid * WGM, gsz = (nM - fm) < WGM ? (nM - fm) : WGM;
        u.pm = fm + ((wgid % nig) % gsz); u.pn = (wgid % nig) / gsz; return true;
    }
    __device__ __forceinline__ void a_ready(const Unit&) const {}
    __device__ __forceinline__ void done(const Unit&) const {}
};

__device__ __forceinline__ unsigned cvt_pk_bf16(float lo, float hi) { unsigned r; asm volatile("v_cvt_pk_bf16_f32 %0, %1, %2" : "=v"(r) : "v"(lo), "v"(hi)); return r; }

__device__ __forceinline__ float bf_lo(unsigned u) { return __uint_as_float(u << 16); }
__device__ __forceinline__ float bf_hi(unsigned u) { return __uint_as_float(u & 0xffff0000u); }
__device__ __forceinline__ float sigmoidf_fast(float x) { return __builtin_amdgcn_rcpf(1.0f + __expf(-x)); }
__device__ __forceinline__ void unpack8(const u32x4 w, float (&f)[8]) { f[0] = bf_lo(w.x); f[1] = bf_hi(w.x); f[2] = bf_lo(w.y); f[3] = bf_hi(w.y); f[4] = bf_lo(w.z); f[5] = bf_hi(w.z); f[6] = bf_lo(w.w); f[7] = bf_hi(w.w); }
enum { EP_PROJ = 0, EP_GLU = 1, EP_BS = 2, EP_BA = 3, EP_OUT = 4, EP_UP = 5, EP_DOWN = 6 };
template <int MODE> struct Epi {
    static constexpr bool PERM = (MODE != EP_OUT && MODE != EP_DOWN), AFTER_DRAIN = false;
    bf16_t* O; int ldo;
    const bf16_t* X1; int ldx1;
    const bf16_t* X2; int ldx2;
    const float* bias;
    float* F; const float* R; const float* gate; float alpha;
    float qscale;
    __device__ __forceinline__ void operator()(const f32x4 (&acc)[2][2][4][2], const Unit& u, int wr, int wc, int fr, int fq) const {
        if constexpr (PERM) {
            const int row0 = u.pm * BM + wr * 64 + fr, col0 = u.pn * BM + wc * 32 + 8 * fq;
            float sc = 1.f; if (MODE == EP_PROJ) { const int colt = u.pn * BM; if (colt >= 1024 && colt < 2048) sc = qscale; }
            float bv[2][8];
            if (MODE == EP_GLU) {
#pragma unroll
                for (int bj = 0; bj < 2; ++bj) { const f32x4 b0 = *(const f32x4*)(bias + col0 + bj * HALF), b1 = *(const f32x4*)(bias + col0 + bj * HALF + 4);
                    bv[bj][0] = b0[0]; bv[bj][1] = b0[1]; bv[bj][2] = b0[2]; bv[bj][3] = b0[3]; bv[bj][4] = b1[0]; bv[bj][5] = b1[1]; bv[bj][6] = b1[2]; bv[bj][7] = b1[3]; }
            }
#pragma unroll
            for (int ai = 0; ai < 2; ++ai)
#pragma unroll
                for (int m = 0; m < 4; ++m) {
                    const size_t row = (size_t)(row0 + ai * HALF + m * 16);
#pragma unroll
                    for (int bj = 0; bj < 2; ++bj) {
                        const int col = col0 + bj * HALF;
                        float v[8];
#pragma unroll
                        for (int j = 0; j < 4; ++j) { v[j] = acc[ai][bj][m][0][j]; v[4 + j] = acc[ai][bj][m][1][j]; }
                        if (MODE == EP_PROJ) {
#pragma unroll
                            for (int j = 0; j < 8; ++j) v[j] *= sc;
                        }
                        if (MODE == EP_GLU) {
                            float z[8]; unpack8(*(const u32x4*)(X1 + row * ldx1 + col), z);
#pragma unroll
                            for (int j = 0; j < 8; ++j) v[j] = z[j] * sigmoidf_fast(v[j] + bv[bj][j]);
                        }
                        if (MODE == EP_BS) {
                            float gt[8]; unpack8(*(const u32x4*)(X1 + row * ldx1 + col), gt);
#pragma unroll
                            for (int j = 0; j < 8; ++j) v[j] = sigmoidf_fast(gt[j]) * v[j];
                        }
                        if (MODE == EP_BA) {
                            float gt[8], m1[8]; unpack8(*(const u32x4*)(X1 + row * ldx1 + col), gt); unpack8(*(const u32x4*)(X2 + row * ldx2 + col), m1);
#pragma unroll
                            for (int j = 0; j < 8; ++j) v[j] = m1[j] + sigmoidf_fast(gt[j]) * v[j];
                        }
                        u32x4 w; w.x = cvt_pk_bf16(v[0], v[1]); w.y = cvt_pk_bf16(v[2], v[3]); w.z = cvt_pk_bf16(v[4], v[5]); w.w = cvt_pk_bf16(v[6], v[7]);
                        *(u32x4*)(O + row * ldo + col) = w;
                    }
                    asm volatile("" ::: "memory");
                }
        } else {
            const int row0 = u.pm * BM + wr * 64 + fr, col0 = u.pn * BM + wc * 32 + 4 * fq;
            const float* gp = gate + (size_t)((u.pm * BM) >> 12) * 6144;
            f32x4 gv[2][2];
#pragma unroll
            for (int bj = 0; bj < 2; ++bj)
#pragma unroll
                for (int n = 0; n < 2; ++n) gv[bj][n] = *(const f32x4*)(gp + col0 + bj * HALF + n * 16);
#pragma unroll
            for (int ai = 0; ai < 2; ++ai)
#pragma unroll
                for (int m = 0; m < 4; ++m) {
                    const size_t off = (size_t)(row0 + ai * HALF + m * 16) * 1024 + col0;
#pragma unroll
                    for (int bj = 0; bj < 2; ++bj)
#pragma unroll
                        for (int n = 0; n < 2; ++n) { const f32x4 rs = *(const f32x4*)(R + off + bj * HALF + n * 16);
                            *(f32x4*)(F + off + bj * HALF + n * 16) = rs * alpha + gv[bj][n] * acc[ai][bj][m][n]; }
                    asm volatile("" ::: "memory");
                }
        }
    }
};

template <class Epi, class Sched, bool ALIGN_EPI = false, bool SP2 = false>
__device__ __forceinline__ void gemm_phase(PG8_LAS unsigned char* lds, const Gemm g, const Sched& S, const Epi& E) {
    int tid_ = threadIdx.x; asm volatile("" : "+v"(tid_)); const int tid = tid_, wid = __builtin_amdgcn_readfirstlane(tid >> 6), lane = tid & 63, wr = wid >> 2, wc = wid & 3, fr = lane & 15, fq = lane >> 4;
    const int K = g.K, nt = K / BK;
    unsigned voffA[2], voffB[2];
#pragma unroll
    for (int i = 0; i < 2; ++i) { int R, C; stage_rc(tid * 16 + i * 8192, R, C); const int Rb = Epi::PERM ? ((R & ~31) + perm32(R & 31)) : R;
        voffA[i] = (unsigned)(R * g.lda + C) * 2u; voffB[i] = (unsigned)(Rb * g.ldb + C) * 2u; }
    const size_t kstep = (size_t)(BK * 2);
    const size_t hstepA = (size_t)HALF * g.lda * 2, hstepB = (size_t)HALF * g.ldb * 2;
    const size_t tstepA = 2 * hstepA, tstepB = 2 * hstepB;
    const unsigned ldsw = (unsigned)wid * 1024u;
    const int aoff = lds_byte(wr * 64 + fr, fq * 8), boff = lds_byte(wc * 32 + fr, fq * 8);
#define PG8_SA(b, h) (((b) * 2 + (h)) * HTB)
#define PG8_SB(b, h) ((4 + (b) * 2 + (h)) * HTB)
#define PG8_STAGE(bufoff, gbase, voff) do { _Pragma("unroll") for (int _i = 0; _i < 2; ++_i) \
        __builtin_amdgcn_global_load_lds((const unsigned*)((const char*)(gbase) + (voff)[_i]), (PG8_LAS unsigned*)(lds + (bufoff) + ldsw + _i * 8192), 16, 0, 0); } while (0)
#define PG8_LDA(dst, b, h) do { _Pragma("unroll") for (int m = 0; m < 4; ++m) _Pragma("unroll") for (int k = 0; k < 2; ++k) dst[m][k] = *(const PG8_LAS bf16x8*)(lds + PG8_SA(b, h) + aoff + m * 2048 + k * 1024); } while (0)
#define PG8_LDB(dst, b, h) do { _Pragma("unroll") for (int n = 0; n < 2; ++n) _Pragma("unroll") for (int k = 0; k < 2; ++k) dst[n][k] = *(const PG8_LAS bf16x8*)(lds + PG8_SB(b, h) + boff + n * 2048 + k * 1024); } while (0)
#define PG8_MMA(ai, bj, At, Bt) do { __builtin_amdgcn_s_setprio(1); _Pragma("unroll") for (int m = 0; m < 4; ++m) _Pragma("unroll") for (int n = 0; n < 2; ++n) _Pragma("unroll") for (int k = 0; k < 2; ++k) \
        acc[ai][bj][m][n] = __builtin_amdgcn_mfma_f32_16x16x32_bf16(Bt[n][k], At[m][k], acc[ai][bj][m][n], 0, 0, 0); __builtin_amdgcn_s_setprio(0); } while (0)
#define PG8_WAIT_V(n) asm volatile("s_waitcnt vmcnt(" #n ")" ::: "memory")
#define PG8_WAIT_L(n) asm volatile("s_waitcnt lgkmcnt(" #n ")" ::: "memory")
#define PG8_BAR __builtin_amdgcn_s_barrier()
#define PG8_SCHED __builtin_amdgcn_sched_barrier(0)
    Unit cur, nxt; int ui = 0;
    if (!S.next(0, cur)) return;
    f32x4 acc[2][2][4][2];
#pragma unroll
    for (int a = 0; a < 2; ++a)
#pragma unroll
        for (int b = 0; b < 2; ++b)
#pragma unroll
            for (int m = 0; m < 4; ++m)
#pragma unroll
                for (int n = 0; n < 2; ++n) acc[a][b][m][n] = (f32x4){0.f, 0.f, 0.f, 0.f};
    bf16x8 At[4][2], B0[2][2], B1[2][2];
    const char* cA = (const char*)g.A + (size_t)cur.pm * tstepA; const char* cB = (const char*)g.Bt + (size_t)cur.pn * tstepB;
    S.a_ready(cur);
    if constexpr (SP2) {
        PG8_STAGE(PG8_SB(0, 0), cB, voffB); PG8_STAGE(PG8_SB(0, 1), cB + hstepB, voffB); PG8_STAGE(PG8_SA(0, 0), cA, voffA); PG8_STAGE(PG8_SA(0, 1), cA + hstepA, voffA);
        if (wr == 1) PG8_BAR;
        PG8_WAIT_V(2); PG8_BAR;
        PG8_STAGE(PG8_SB(1, 0), cB + kstep, voffB); PG8_STAGE(PG8_SA(1, 0), cA + kstep, voffA); PG8_STAGE(PG8_SB(1, 1), cB + hstepB + kstep, voffB);
        PG8_WAIT_V(6); PG8_BAR;
    } else {
        PG8_STAGE(PG8_SB(0, 0), cB, voffB); PG8_STAGE(PG8_SA(0, 0), cA, voffA); PG8_STAGE(PG8_SB(0, 1), cB + hstepB, voffB); PG8_STAGE(PG8_SA(0, 1), cA + hstepA, voffA);
        if (wr == 1) PG8_BAR;
        PG8_WAIT_V(4); PG8_BAR;
        PG8_STAGE(PG8_SB(1, 0), cB + kstep, voffB); PG8_STAGE(PG8_SA(1, 0), cA + kstep, voffA); PG8_STAGE(PG8_SB(1, 1), cB + hstepB + kstep, voffB);
        PG8_WAIT_V(6); PG8_BAR;
    }
    for (;;) {
        const bool has_next = S.next(ui + 1, nxt);
        const char* nA = has_next ? (const char*)g.A + (size_t)nxt.pm * tstepA : cA; const char* nB = has_next ? (const char*)g.Bt + (size_t)nxt.pn * tstepB : cB;
        for (int t = 0; t < nt; t += 2) {
            const bool last = (t == nt - 2);
            const char* a1 = cA + (size_t)(t + 1) * kstep;
            const char* a2 = last ? nA : cA + (size_t)(t + 2) * kstep; const char* b2 = last ? nB : cB + (size_t)(t + 2) * kstep;
            const char* a3 = a2 + kstep; const char* b3 = b2 + kstep;
            if (last && has_next) S.a_ready(nxt);
            if constexpr (SP2) {
            PG8_LDB(B0, 0, 0); PG8_LDB(B1, 0, 1); PG8_SCHED; PG8_LDA(At, 0, 0); PG8_STAGE(PG8_SA(1, 1), a1 + hstepA, voffA);
            PG8_WAIT_V(8); PG8_WAIT_L(0); PG8_BAR; PG8_MMA(0, 0, At, B0); PG8_MMA(0, 1, At, B1); PG8_BAR; PG8_SCHED;
            PG8_LDA(At, 0, 1); PG8_STAGE(PG8_SB(0, 0), b2, voffB); PG8_STAGE(PG8_SB(0, 1), b2 + hstepB, voffB); PG8_STAGE(PG8_SA(0, 0), a2, voffA);
            PG8_WAIT_V(8); PG8_WAIT_L(0); PG8_BAR; PG8_MMA(1, 0, At, B0); PG8_MMA(1, 1, At, B1); PG8_BAR; PG8_SCHED;
            PG8_LDB(B0, 1, 0); PG8_LDB(B1, 1, 1); PG8_SCHED; PG8_LDA(At, 1, 0); PG8_STAGE(PG8_SA(0, 1), a2 + hstepA, voffA);
            PG8_WAIT_V(8); PG8_WAIT_L(0); PG8_BAR; PG8_MMA(0, 0, At, B0); PG8_MMA(0, 1, At, B1); PG8_BAR; PG8_SCHED;
            PG8_LDA(At, 1, 1); PG8_STAGE(PG8_SB(1, 0), b3, voffB); PG8_STAGE(PG8_SB(1, 1), b3 + hstepB, voffB); PG8_STAGE(PG8_SA(1, 0), a3, voffA);
            PG8_WAIT_V(8); PG8_WAIT_L(0); PG8_BAR; PG8_MMA(1, 0, At, B0); PG8_MMA(1, 1, At, B1); PG8_BAR; PG8_SCHED;
            } else {
            PG8_LDB(B0, 0, 0); PG8_SCHED; PG8_LDA(At, 0, 0); PG8_STAGE(PG8_SA(1, 1), a1 + hstepA, voffA);
            PG8_WAIT_L(8); PG8_BAR; PG8_WAIT_L(0); PG8_MMA(0, 0, At, B0); PG8_BAR; PG8_SCHED;
            PG8_LDB(B1, 0, 1); PG8_STAGE(PG8_SB(0, 0), b2, voffB);
            PG8_BAR; PG8_WAIT_L(0); PG8_MMA(0, 1, At, B1); PG8_BAR;
            PG8_LDA(At, 0, 1); PG8_STAGE(PG8_SA(0, 0), a2, voffA);
            PG8_BAR; PG8_WAIT_L(0); PG8_MMA(1, 0, At, B0); PG8_BAR; PG8_SCHED;
            PG8_STAGE(PG8_SB(0, 1), b2 + hstepB, voffB);
            PG8_WAIT_V(6); PG8_BAR; PG8_MMA(1, 1, At, B1); PG8_BAR;
            PG8_LDB(B0, 1, 0); PG8_SCHED; PG8_LDA(At, 1, 0); PG8_STAGE(PG8_SA(0, 1), a2 + hstepA, voffA);
            PG8_WAIT_L(8); PG8_BAR; PG8_WAIT_L(0); PG8_MMA(0, 0, At, B0); PG8_BAR; PG8_SCHED;
            PG8_LDB(B1, 1, 1); PG8_STAGE(PG8_SB(1, 0), b3, voffB);
            PG8_BAR; PG8_WAIT_L(0); PG8_MMA(0, 1, At, B1); PG8_BAR;
            PG8_LDA(At, 1, 1); PG8_STAGE(PG8_SA(1, 0), a3, voffA);
            PG8_BAR; PG8_WAIT_L(0); PG8_MMA(1, 0, At, B0); PG8_BAR; PG8_SCHED;
            PG8_STAGE(PG8_SB(1, 1), b3 + hstepB, voffB);
            PG8_WAIT_V(6); PG8_BAR; PG8_MMA(1, 1, At, B1); PG8_BAR;
            }
        }
        if constexpr (ALIGN_EPI) { if (wr == 0) PG8_BAR; }
        if constexpr (!Epi::AFTER_DRAIN) { E(acc, cur, wr, wc, fr, fq); S.done(cur); }
        if (!has_next) break;
#pragma unroll
        for (int a = 0; a < 2; ++a)
#pragma unroll
            for (int b = 0; b < 2; ++b)
#pragma unroll
                for (int m = 0; m < 4; ++m)
#pragma unroll
                    for (int n = 0; n < 2; ++n) acc[a][b][m][n] = (f32x4){0.f, 0.f, 0.f, 0.f};
        cur = nxt; cA = nA; cB = nB; ++ui;
        if constexpr (ALIGN_EPI) { if (wr == 1) PG8_BAR; }
    }
    PG8_WAIT_V(0);
    if constexpr (!ALIGN_EPI) { if (wr == 0) PG8_BAR; }
    PG8_BAR;
    if constexpr (Epi::AFTER_DRAIN) { E.fused(acc, cur, wr, wc, fr, fq, lds, wid, lane); S.done(cur); }
#undef PG8_SA
#undef PG8_SB
#undef PG8_STAGE
#undef PG8_LDA
#undef PG8_LDB
#undef PG8_MMA
#undef PG8_WAIT_V
#undef PG8_WAIT_L
#undef PG8_BAR
#undef PG8_SCHED
}
}

#include <hip/hip_bf16.h>
#include <cmath>
namespace attn_body {
using bf16=__hip_bfloat16;
using bf16x8=__attribute__((ext_vector_type(8)))short;
using s16x4=__attribute__((ext_vector_type(4)))short;
using f32x16=__attribute__((ext_vector_type(16)))float;
using u32x4=__attribute__((ext_vector_type(4)))unsigned;
constexpr int SEQ=4096,D=64,DM=6144,OP=2048;
constexpr int NW=8,QBLK=32,QB=QBLK*NW,KVBLK=64,NQB=SEQ/QB;
constexpr int ATTN_PITCH=DM, ATTN_UNIT_ROWS=QB;
__device__ __forceinline__ int crow(int r,int hi){return (r&3)+8*(r>>2)+4*hi;}
#define SBAR() __builtin_amdgcn_sched_barrier(0)
__device__ __forceinline__ void cmask(f32x16&p0,f32x16&p1,int jb,int qrel,int hi){
  const float NEG=-INFINITY;
  if(jb>(qrel>>6)){
  #pragma unroll
  for(int r=0;r<16;++r){p0[r]=NEG;p1[r]=NEG;}}
}

constexpr int NSLOT=3, SLOTB=8192;
constexpr int LDS_K=0, LDS_V=NSLOT*SLOTB, LDS_WS=2*NSLOT*SLOTB, LDS_OST=LDS_WS+NW*64*4, LDS_BYTES=LDS_OST+NW*4096;
constexpr float C2=0.125f*1.4426950408889634f;
__device__ __forceinline__ void glds16(const void*gsrc,unsigned lds_dst){unsigned keep;
  asm volatile("s_mov_b32 %0, m0\n\ts_mov_b32 m0, %2\n\ts_nop 0\n\tglobal_load_lds_dwordx4 %1, off\n\ts_mov_b32 m0, %0":"=&s"(keep):"v"(gsrc),"s"(lds_dst):"memory");}
__device__ __forceinline__ float max3f(float a,float b,float c){float r;asm("v_max3_f32 %0, %1, %2, %3":"=v"(r):"v"(a),"v"(b),"v"(c));return r;}
__device__ __forceinline__ float max2f(float a,float b){float r;asm("v_max_f32_e32 %0, %1, %2":"=v"(r):"v"(a),"v"(b));return r;}
__device__ __forceinline__ float fadd_s(float a,float b){float r;asm("v_add_f32_e32 %0, %1, %2":"=v"(r):"v"(a),"v"(b));return r;}
__device__ __forceinline__ float fsub_s(float a,float b){float r;asm("v_sub_f32_e32 %0, %1, %2":"=v"(r):"v"(a),"v"(b));return r;}
typedef float f32x2_t __attribute__((ext_vector_type(2))); typedef __bf16 bf16x2_t __attribute__((ext_vector_type(2)));
__device__ __forceinline__ unsigned cvtpk_s(float lo,float hi){f32x2_t v={lo,hi};bf16x2_t b=__builtin_convertvector(v,bf16x2_t);return __builtin_bit_cast(unsigned,b);}
#define WAIT_BAR(N) asm volatile("s_waitcnt vmcnt(" #N ") lgkmcnt(0)\n\ts_barrier":::"memory")

__device__ __forceinline__ void qkt(f32x16&p0,f32x16&p1,const char*Kslot,const bf16x8*qr,const f32x16&negm,int r32,int hi){
  const char*kb=Kslot+hi*1024+r32*16;
  #pragma unroll
  for(int d0=0;d0<4;++d0){
    const bf16x8 b0=*reinterpret_cast<const bf16x8*>(kb+d0*2048);
    const bf16x8 b1=*reinterpret_cast<const bf16x8*>(kb+d0*2048+512);
    if(d0==0){p0=__builtin_amdgcn_mfma_f32_32x32x16_bf16(b0,qr[0],negm,0,0,0);p1=__builtin_amdgcn_mfma_f32_32x32x16_bf16(b1,qr[0],negm,0,0,0);}
    else{p0=__builtin_amdgcn_mfma_f32_32x32x16_bf16(b0,qr[d0],p0,0,0,0);p1=__builtin_amdgcn_mfma_f32_32x32x16_bf16(b1,qr[d0],p1,0,0,0);}}
}
typedef __attribute__((address_space(3))) const char* lds_cptr;
typedef short v4i16_t __attribute__((ext_vector_type(4)));
__device__ __forceinline__ void kload8(bf16x8*kf,lds_cptr kp){
  kf[0]=*(const __attribute__((address_space(3))) bf16x8*)(kp);      kf[1]=*(const __attribute__((address_space(3))) bf16x8*)(kp+512);
  kf[2]=*(const __attribute__((address_space(3))) bf16x8*)(kp+2048); kf[3]=*(const __attribute__((address_space(3))) bf16x8*)(kp+2560);
  kf[4]=*(const __attribute__((address_space(3))) bf16x8*)(kp+4096); kf[5]=*(const __attribute__((address_space(3))) bf16x8*)(kp+4608);
  kf[6]=*(const __attribute__((address_space(3))) bf16x8*)(kp+6144); kf[7]=*(const __attribute__((address_space(3))) bf16x8*)(kp+6656);
}
__device__ __forceinline__ void kload2(bf16x8*kf,lds_cptr kp,int j){ kf[2*j]=*(const __attribute__((address_space(3))) bf16x8*)(kp+j*2048); kf[2*j+1]=*(const __attribute__((address_space(3))) bf16x8*)(kp+j*2048+512); }
__device__ __forceinline__ s16x4 vtr(lds_cptr p){ return __builtin_bit_cast(s16x4,__builtin_amdgcn_ds_read_tr16_b64_v4i16((__attribute__((address_space(3))) v4i16_t*)p)); }
__device__ __forceinline__ float rowmax(const f32x16&p0,const f32x16&p1){
  float a=max3f(p0[0],p0[1],p1[0]),b=max3f(p0[2],p0[3],p1[1]);a=max3f(a,p1[2],p1[3]);
  #pragma unroll
  for(int r=4;r<16;r+=4){a=max3f(a,p0[r],p0[r+1]);b=max3f(b,p0[r+2],p0[r+3]);a=max3f(a,p1[r],p1[r+1]);b=max3f(b,p1[r+2],p1[r+3]);}
  const float m=max2f(a,b);
  auto rr=__builtin_amdgcn_permlane32_swap(__float_as_uint(m),__float_as_uint(m),false,false);
  return max2f(__uint_as_float(rr[0]),__uint_as_float(rr[1]));
}
__device__ __forceinline__ void pv(f32x16*o,int vb,bf16x8 pa0,bf16x8 pa1,bf16x8 pa2,bf16x8 pa3){
  #pragma unroll
  for(int d0=0;d0<2;++d0){s16x4 lo[4],hi[4];
    #pragma unroll
    for(int ks=0;ks<4;++ks){
      asm volatile("ds_read_b64_tr_b16 %0,%1 offset:%c2":"=&v"(lo[ks]):"v"(vb),"i"(d0*4096+ks*1024):"memory");
      asm volatile("ds_read_b64_tr_b16 %0,%1 offset:%c2":"=&v"(hi[ks]):"v"(vb),"i"(d0*4096+ks*1024+512):"memory");}
    asm volatile("s_waitcnt lgkmcnt(0)":::"memory");SBAR();
    #define PK(k) (bf16x8){lo[k][0],lo[k][1],lo[k][2],lo[k][3],hi[k][0],hi[k][1],hi[k][2],hi[k][3]}
    o[d0]=__builtin_amdgcn_mfma_f32_32x32x16_bf16(pa0,PK(0),o[d0],0,0,0);
    o[d0]=__builtin_amdgcn_mfma_f32_32x32x16_bf16(pa1,PK(1),o[d0],0,0,0);
    o[d0]=__builtin_amdgcn_mfma_f32_32x32x16_bf16(pa2,PK(2),o[d0],0,0,0);
    o[d0]=__builtin_amdgcn_mfma_f32_32x32x16_bf16(pa3,PK(3),o[d0],0,0,0);
    #undef PK
  }
}

#ifndef ATTN_STORE16
#define ATTN_STORE16(p,v) (*(u32x4*)(p)=(v))
#endif
template<int THRL> __device__ __forceinline__ void attn_unit(int b,int h,int hv,int os,int qb,const bf16*Q,const bf16*__restrict__ K,const bf16*__restrict__ V,bf16*O,char*shm){
  int tid_=threadIdx.x; asm volatile("":"+v"(tid_)); const int tid=tid_,lane=tid&63,r32=lane&31,hi=lane>>5; const int wid=__builtin_amdgcn_readfirstlane(tid>>6);
  const long rowbase=(long)b*SEQ; const int q0=qb*QB;
  const bf16*Qw=Q+(rowbase+q0+wid*QBLK)*DM+h*D;
  const bf16*Kh=K+rowbase*DM+h*D,*Vh=V+rowbase*DM+hv*D;
  const unsigned lds0=(unsigned)(uintptr_t)shm;
  float*wsf=(float*)(shm+LDS_WS)+wid*64;
  const bf16*ksrc=Kh+(long)lane*DM+wid*8;
  const bf16*vsrc=Vh+(long)(16*(wid&3)+(lane>>2))*DM+(wid>>2)*32+(lane&3)*8;
  const unsigned kdst=lds0+LDS_K+wid*1024, vdst=lds0+LDS_V+wid*1024;
  #define DMA_K(t,slot) glds16(ksrc+(long)(t)*KVBLK*DM,(unsigned)__builtin_amdgcn_readfirstlane(kdst+(slot)))
  #define DMA_V(t,slot) glds16(vsrc+(long)(t)*KVBLK*DM,(unsigned)__builtin_amdgcn_readfirstlane(vdst+(slot)))
  const int vb0=(int)(lds0+LDS_V)+((lane>>4)&1)*32+(lane&3)*8+(4*hi+((lane&15)>>2))*64;
  const char*Kbase=shm+LDS_K; bf16x8 kf[8];
  const lds_cptr shm3=(lds_cptr)shm; const lds_cptr kp0=shm3+LDS_K+hi*1024+r32*16; const lds_cptr vp0=shm3+LDS_V+((lane>>4)&1)*32+(lane&3)*8+(4*hi+((lane&15)>>2))*64;
  const int NT=(q0+QB)/KVBLK;
  DMA_K(0,0);DMA_V(0,0);DMA_K(1,SLOTB);
  bf16x8 qr[4];
  #pragma unroll
  for(int d0=0;d0<4;++d0)qr[d0]=*reinterpret_cast<const bf16x8*>(&Qw[(long)r32*DM+d0*16+hi*8]);
  float mhat=0.f,l_reg=0.f;f32x16 o[2];o[0]=f32x16{};o[1]=f32x16{};f32x16 negm=f32x16{};asm volatile("":"+v"(negm));
  const int qrel=wid*QBLK+r32;
  #define CMASK(P0,P1,t) do{int jb_=(t)-(NT-4); if(jb_>=0)cmask(P0,P1,jb_,qrel,hi);}while(0)
  bool resc=false;
  #define START(P0,P1) do{ const float rm=rowmax(P0,P1); resc=false; \
    { const float dl=rm; mhat=fadd_s(mhat,dl); \
      _Pragma("unroll") for(int r=0;r<16;++r){P0[r]=fsub_s(P0[r],dl);P1[r]=fsub_s(P1[r],dl);} \
      _Pragma("unroll") for(int r=0;r<16;++r)negm[r]=-mhat; asm volatile("":"+v"(negm)); } \
    _Pragma("unroll") for(int r=0;r<16;++r)P0[r]=__builtin_amdgcn_exp2f(P0[r]); }while(0)
  #define RESC() do{ if(resc){ asm volatile("s_waitcnt lgkmcnt(0)":::"memory"); \
      _Pragma("unroll") for(int d_=0;d_<2;++d_) _Pragma("unroll") for(int r=0;r<16;++r)o[d_][r]*=wsf[crow(r,hi)]; } }while(0)
  f32x16 pA0,pA1,pB0,pB1;
  int sl_prev=0,sl_cur=0,sl_next=SLOTB;
  #define ROT() do{sl_prev=sl_cur;sl_cur=sl_next;sl_next=(sl_next==(NSLOT-1)*SLOTB)?0:sl_next+SLOTB;}while(0)
  DMA_K(2,2*SLOTB);
  WAIT_BAR(3);
  qkt(pA0,pA1,Kbase,qr,negm,r32,hi);asm volatile("s_nop 15\n\ts_nop 7":"+v"(pA0),"+v"(pA1));CMASK(pA0,pA1,0);
  START(pA0,pA1);
  _Pragma("unroll") for(int r=0;r<16;++r)pA1[r]=__builtin_amdgcn_exp2f(pA1[r]);
  WAIT_BAR(0);
  DMA_K(3,0);DMA_V(1,SLOTB);
  ROT();
  kload8(kf,kp0+sl_cur);
  WAIT_BAR(2);
  s16x4 vlo[8],vhi[8]; u32x4 pw0,pw1,pw2,pw3;
  #define PKW(P,B) cvtpk_s(P[B],P[B+1])
  #define PAF(k) __builtin_bit_cast(bf16x8,pw##k)
  #define VFR(i) (bf16x8){vlo[i][0],vlo[i][1],vlo[i][2],vlo[i][3],vhi[i][0],vhi[i][1],vhi[i][2],vhi[i][3]}
  #define PIN(x) asm volatile("":"+v"(x))
  #define MX3(a,b,c) __builtin_fmaxf(__builtin_fmaxf((a),(b)),(c))
  #define GAPA(MF,A0,A1,A2,A3,W0,W1,PW) do{ MF; sacc+=A0; sacc+=A1; sacc+=A2; sacc+=A3; PIN(sacc); W0; W1; PIN(PW); SBAR(); }while(0)
  #define EX(v) __builtin_amdgcn_exp2f(v)
  #define GAPB(MF,X,B) do{ MF; X[B]=EX(X[B]); X[B+1]=EX(X[B+1]); X[B+2]=EX(X[B+2]); X[B+3]=EX(X[B+3]); PIN(X); SBAR(); }while(0)
  #define VRD(i) do{ vlo[i]=vtr(vp_+(((i)>>2)*4096+((i)&3)*1024)); vhi[i]=vtr(vp_+(((i)>>2)*4096+((i)&3)*1024+512)); }while(0)
  #define KRD(G,j) do{ if(G){ kload2(kf,kp0+sl_next,j); SBAR(); } }while(0)
  #define STEP(C0,C1,P0,P1,t,GK,GV,GL) do{ SBAR(); \
    const lds_cptr vp_=vp0+sl_prev; \
    VRD(0); SBAR(); float sacc=(P0[0]+P0[1]); \
    GAPA(C0=__builtin_amdgcn_mfma_f32_32x32x16_bf16(kf[0],qr[0],negm,0,0,0), P0[2],P0[3],P0[4],P0[5],     pw0[0]=PKW(P0,0), pw0[1]=PKW(P0,2), pw0); \
    VRD(4); SBAR(); GAPA(C1=__builtin_amdgcn_mfma_f32_32x32x16_bf16(kf[1],qr[0],negm,0,0,0), P0[6],P0[7],P0[8],P0[9],     pw0[2]=PKW(P0,4), pw0[3]=PKW(P0,6), pw0); \
    VRD(1); SBAR(); GAPA(C0=__builtin_amdgcn_mfma_f32_32x32x16_bf16(kf[2],qr[1],C0,0,0,0),   P0[10],P0[11],P0[12],P0[13], pw1[0]=PKW(P0,8), pw1[1]=PKW(P0,10), pw1); \
    VRD(5); SBAR(); GAPA(C1=__builtin_amdgcn_mfma_f32_32x32x16_bf16(kf[3],qr[1],C1,0,0,0),   P0[14],P0[15],P1[0],P1[1],   pw1[2]=PKW(P0,12),pw1[3]=PKW(P0,14), pw1); \
    VRD(2); SBAR(); GAPA(C0=__builtin_amdgcn_mfma_f32_32x32x16_bf16(kf[4],qr[2],C0,0,0,0),   P1[2],P1[3],P1[4],P1[5],     pw2[0]=PKW(P1,0), pw2[1]=PKW(P1,2), pw2); \
    VRD(6); SBAR(); GAPA(C1=__builtin_amdgcn_mfma_f32_32x32x16_bf16(kf[5],qr[2],C1,0,0,0),   P1[6],P1[7],P1[8],P1[9],     pw2[2]=PKW(P1,4), pw2[3]=PKW(P1,6), pw2); \
    VRD(3); SBAR(); GAPA(C0=__builtin_amdgcn_mfma_f32_32x32x16_bf16(kf[6],qr[3],C0,0,0,0),   P1[10],P1[11],P1[12],P1[13], pw3[0]=PKW(P1,8), pw3[1]=PKW(P1,10), pw3); \
    VRD(7); SBAR(); GAPA(C1=__builtin_amdgcn_mfma_f32_32x32x16_bf16(kf[7],qr[3],C1,0,0,0),   P1[14],P1[15],0.f,0.f,       pw3[2]=PKW(P1,12),pw3[3]=PKW(P1,14), pw3); \
    l_reg+=sacc; \
    if(GK){DMA_K((t)+3,sl_cur);} if(GV){DMA_V((t)+1,sl_next);} \
    CMASK(C0,C1,t); \
    { float a=MX3(C0[0],C0[1],C1[0]),b=MX3(C0[2],C0[3],C1[1]); a=MX3(a,C1[2],C1[3]); \
      _Pragma("unroll") for(int r=4;r<16;r+=4){a=MX3(a,C0[r],C0[r+1]);b=MX3(b,C0[r+2],C0[r+3]);a=MX3(a,C1[r],C1[r+1]);b=MX3(b,C1[r+2],C1[r+3]);} \
      float rm=__builtin_fmaxf(a,b); { auto rr=__builtin_amdgcn_permlane32_swap(__float_as_uint(rm),__float_as_uint(rm),false,false); rm=__builtin_fmaxf(__uint_as_float(rr[0]),__uint_as_float(rr[1])); } \
      resc=false; \
      if(__builtin_expect(__any(rm>(float)THRL),0)){ const float dl=__builtin_fmaxf(rm,0.f); mhat+=dl; \
        _Pragma("unroll") for(int r=0;r<16;++r){C0[r]-=dl;C1[r]-=dl;} \
        _Pragma("unroll") for(int r=0;r<16;++r)negm[r]=-mhat; asm volatile("":"+v"(negm)); \
        const float f=__builtin_amdgcn_exp2f(-dl); l_reg*=f; if(hi==0)wsf[r32]=f; resc=true; } } \
    SBAR(); \
    GAPB(o[0]=__builtin_amdgcn_mfma_f32_32x32x16_bf16(PAF(0),VFR(0),o[0],0,0,0), C0,0); \
    GAPB(o[1]=__builtin_amdgcn_mfma_f32_32x32x16_bf16(PAF(0),VFR(4),o[1],0,0,0), C0,4); \
    KRD(GL,0); GAPB(o[0]=__builtin_amdgcn_mfma_f32_32x32x16_bf16(PAF(1),VFR(1),o[0],0,0,0), C0,8); \
    KRD(GL,1); GAPB(o[1]=__builtin_amdgcn_mfma_f32_32x32x16_bf16(PAF(1),VFR(5),o[1],0,0,0), C0,12); \
    KRD(GL,2); GAPB(o[0]=__builtin_amdgcn_mfma_f32_32x32x16_bf16(PAF(2),VFR(2),o[0],0,0,0), C1,0); \
    KRD(GL,3); GAPB(o[1]=__builtin_amdgcn_mfma_f32_32x32x16_bf16(PAF(2),VFR(6),o[1],0,0,0), C1,4); \
    GAPB(o[0]=__builtin_amdgcn_mfma_f32_32x32x16_bf16(PAF(3),VFR(3),o[0],0,0,0), C1,8); \
    GAPB(o[1]=__builtin_amdgcn_mfma_f32_32x32x16_bf16(PAF(3),VFR(7),o[1],0,0,0), C1,12); \
    }while(0)
  int t=1;
  #undef CMASK
  #define CMASK(P0,P1,t) do{}while(0)
  for(;t+5<NT;t+=2){
    STEP(pB0,pB1,pA0,pA1,t,true,true,true);     WAIT_BAR(2); RESC(); ROT();
    STEP(pA0,pA1,pB0,pB1,t+1,true,true,true);   WAIT_BAR(2); RESC(); ROT();
  }
  #undef CMASK
  #define CMASK(P0,P1,t) do{int jb_=(t)-(NT-4); if(jb_>=0)cmask(P0,P1,jb_,qrel,hi);}while(0)
  #define ENDW(tt) do{ if((tt)+3<NT){WAIT_BAR(2);} else if((tt)+2<NT){WAIT_BAR(1);} else {WAIT_BAR(0);} }while(0)
  for(;t+1<NT;t+=2){
    STEP(pB0,pB1,pA0,pA1,t,(t+3<NT),(t+1<NT),(t+1<NT));       ENDW(t);   RESC(); ROT();
    STEP(pA0,pA1,pB0,pB1,t+1,(t+4<NT),(t+2<NT),(t+2<NT));     ENDW(t+1); RESC(); ROT();
  }
  STEP(pB0,pB1,pA0,pA1,NT-1,false,false,false); RESC();
  { float sacc=pB0[0]+pB0[1]; _Pragma("unroll") for(int r=2;r<16;++r)sacc+=pB0[r]; _Pragma("unroll") for(int r=0;r<16;++r)sacc+=pB1[r]; l_reg+=sacc;
    pw0=(u32x4){PKW(pB0,0),PKW(pB0,2),PKW(pB0,4),PKW(pB0,6)};pw1=(u32x4){PKW(pB0,8),PKW(pB0,10),PKW(pB0,12),PKW(pB0,14)};pw2=(u32x4){PKW(pB1,0),PKW(pB1,2),PKW(pB1,4),PKW(pB1,6)};pw3=(u32x4){PKW(pB1,8),PKW(pB1,10),PKW(pB1,12),PKW(pB1,14)};
    SBAR(); pv(o,vb0+sl_cur,PAF(0),PAF(1),PAF(2),PAF(3)); }
  #undef PKW
  #undef PAF
  #undef VFR
  #undef PIN
  #undef MX3
  #undef GAPA
  #undef GAPB
  #undef EX
  #undef VRD
  #undef KRD
  #undef STEP
  #undef ENDW
  {auto rr=__builtin_amdgcn_permlane32_swap(__float_as_uint(l_reg),__float_as_uint(l_reg),false,false);l_reg=__uint_as_float(rr[0])+__uint_as_float(rr[1]);}
  if(hi==0)wsf[32+r32]=l_reg;asm volatile("s_waitcnt lgkmcnt(0)":::"memory");
  float rli[16];
  #pragma unroll
  for(int r=0;r<16;++r)rli[r]=__builtin_amdgcn_rcpf(wsf[32+crow(r,hi)]);
  bf16*Ow=O+(rowbase+q0+wid*QBLK)*OP+os*D;
  { bf16*stg=(bf16*)(shm+LDS_OST)+wid*2048;
    #pragma unroll
    for(int r=0;r<16;++r){const int orow=crow(r,hi);
      #pragma unroll
      for(int d0=0;d0<2;++d0)stg[orow*64+d0*32+r32]=__float2bfloat16(o[d0][r]*rli[r]);}
    asm volatile("s_waitcnt lgkmcnt(0)":::"memory");
    #pragma unroll
    for(int i=0;i<4;++i){const int row=i*8+(lane>>3),ch=lane&7; const u32x4 v=*(const u32x4*)(stg+row*64+ch*8); ATTN_STORE16(Ow+(long)row*OP+ch*8,v);} }
  asm volatile("s_waitcnt lgkmcnt(0)\n\ts_barrier":::"memory");
  #undef DMA_K
  #undef DMA_V
  #undef CMASK
  #undef START
  #undef RESC
  #undef ROT
}
constexpr int ATTN_LDS_BYTES=LDS_BYTES;
#undef SBAR
#undef WAIT_BAR
}


constexpr int NB = 16, T = 4096, D = 1024, M = NB * T, INW = 6144, FF = 2816, NG = 64, NP = 64;
constexpr float LN_EPS = 1e-5f, RMS_EPS = 1e-5f;
constexpr float DN_ALPHA = 1.189207115002721f;
constexpr float LAMBDA_INIT = 0.2f;
constexpr int NWAVES = 8, NTHREADS = 512;
constexpr size_t MiB = 1u << 20;
constexpr size_t WS_MODP = 0;
constexpr size_t WS_MOD = 6 * MiB;
constexpr size_t WS_WIN = 8 * MiB, WS_WGLU = 20 * MiB, WS_WBS = 22 * MiB, WS_WBA = 24 * MiB, WS_WOUT = 26 * MiB, WS_WUP = 28 * MiB, WS_WDOWN = 40 * MiB;
constexpr size_t WS_PROJ = 64 * MiB;
constexpr size_t WS_HB = 832 * MiB;
constexpr size_t WS_END = 960 * MiB;
constexpr int LDS_BYTES = 147456;
constexpr size_t WS_CTL = 7 * MiB, CTL_ZERO_BYTES = 64 * 1024;
constexpr int CW_BAR = 1024, CW_QUEUE = 8192;
constexpr int LDSCTL_OFF = 131072, MISC_OFF = LDSCTL_OFF + 320;

#define GAS __attribute__((address_space(1)))
#define LAS __attribute__((address_space(3)))
typedef unsigned short bf16;
typedef unsigned v4u __attribute__((ext_vector_type(4)));
typedef unsigned v2u __attribute__((ext_vector_type(2)));
typedef float f32x4 __attribute__((ext_vector_type(4)));
typedef float f32x16 __attribute__((ext_vector_type(16)));
typedef short bf16x8 __attribute__((ext_vector_type(8)));
#define LDS_WAIT() asm volatile("s_waitcnt lgkmcnt(0)" ::: "memory")
__device__ __forceinline__ unsigned f2bf(float f) { unsigned u = __builtin_bit_cast(unsigned, f); return (u + 0x7fffu + ((u >> 16) & 1u)) >> 16; }
typedef float f32x2_t __attribute__((ext_vector_type(2))); typedef __bf16 bf16x2_t __attribute__((ext_vector_type(2)));
__device__ __forceinline__ unsigned pk2(float lo, float hi) { f32x2_t v = {lo, hi}; bf16x2_t b = __builtin_convertvector(v, bf16x2_t); return __builtin_bit_cast(unsigned, b); }
__device__ __forceinline__ float bfl(unsigned u) { return __uint_as_float(u << 16); }
__device__ __forceinline__ float bfh(unsigned u) { return __uint_as_float(u & 0xffff0000u); }
__device__ __forceinline__ float wave_sum(float v) {
#pragma unroll
    for (int o = 1; o < 64; o <<= 1) v += __shfl_xor(v, o);
    return v;
}
__device__ __forceinline__ float sigm(float x) { return 1.0f / (1.0f + __expf(-x)); }

struct Args { const float* in[31]; float* out; unsigned char* ws; };
typedef const Args __attribute__((address_space(4)))* KArgs;
__device__ __forceinline__ KArgs kargs() { unsigned long long p = (unsigned long long)__builtin_amdgcn_kernarg_segment_ptr(); asm volatile("" : "+s"(p)); return (KArgs)p; }

typedef GAS unsigned gu32;
#define XB_TMO      128
#define XB_XCNT(j)  (256  + 64 * (j))
#define XB_XSUB(j)  (1280 + 64 * (j))
#define XB_XGEN(j)  (2304 + 64 * (j))
#define XB_TOP      3328
#define XB_TOPGEN   3392
#define XCD_BAR_WORDS 3456
#define XB_SPIN_CAP (1u << 18)

__device__ __forceinline__ unsigned xb_ld(unsigned* p)              { return __hip_atomic_load(p, __ATOMIC_RELAXED, __HIP_MEMORY_SCOPE_AGENT); }
__device__ __forceinline__ unsigned xb_add(unsigned* p, unsigned v) { return __hip_atomic_fetch_add(p, v, __ATOMIC_RELAXED, __HIP_MEMORY_SCOPE_AGENT); }
__device__ __forceinline__ unsigned xb_xcc_id() { return (unsigned)__builtin_amdgcn_s_getreg((3 << 11) | 20) & 0xFu; }
#define XB_SPIN(cond, bar) do { unsigned _sp = 0; while (cond) { __builtin_amdgcn_s_sleep(1); \
    if ((++_sp & 255u) == 0u) { if (xb_ld(&(bar)[XB_TMO])) break; if (_sp > XB_SPIN_CAP) { atomicAdd(&(bar)[XB_TMO], 1u); break; } } } } while (0)

struct XcdBarrier {
    unsigned* bar; unsigned x;
    volatile LAS unsigned* st;
};

__device__ __forceinline__ XcdBarrier xcd_barrier_post(unsigned* bar, volatile LAS unsigned* st) {
    XcdBarrier b; b.bar = bar; b.x = xb_xcc_id(); b.st = st;
    if (threadIdx.x == 0) (void)xb_add(&bar[XB_XCNT(b.x)], 1u);
    return b;
}
__device__ __forceinline__ void xcd_barrier_complete(unsigned* bar, unsigned x, unsigned& nloc, unsigned& nx) {
    const unsigned G = gridDim.x * gridDim.y * gridDim.z;
    unsigned sum, cnt, mine, sp = 0u;
    for (;;) {
        sum = 0u; cnt = 0u; mine = 0u;
#pragma unroll
        for (unsigned j = 0; j < 16; ++j) { const unsigned c = xb_ld(&bar[XB_XCNT(j)]); sum += c; cnt += (c > 0u) ? 1u : 0u; mine = (j == x) ? c : mine; }
        if (sum == G) break;
        __builtin_amdgcn_s_sleep(1);
        if ((++sp & 255u) == 0u) { if (xb_ld(&bar[XB_TMO])) break; if (sp > XB_SPIN_CAP) { atomicAdd(&bar[XB_TMO], 1u); break; } }
    }
    nloc = mine > 0u ? mine : 1u; nx = cnt > 0u ? cnt : 1u;
}

__device__ __forceinline__ void xcd_barrier(const XcdBarrier& b) {
    asm volatile("s_waitcnt vmcnt(0)" ::: "memory");
    __syncthreads();
    if (threadIdx.x == 0) {
        unsigned* bar = b.bar;
        __builtin_amdgcn_s_waitcnt(0);
        unsigned nloc = b.st[0], nx = b.st[1];
        if (nloc == 0u) { xcd_barrier_complete(bar, b.x, nloc, nx); b.st[0] = nloc; b.st[1] = nx; }
        const unsigned old = xb_add(&bar[XB_XSUB(b.x)], 1u);
        const unsigned gen = old / nloc;
        if (old + 1u == (gen + 1u) * nloc) {
            __builtin_amdgcn_fence(__ATOMIC_RELEASE, "agent");
            asm volatile("s_waitcnt vmcnt(0)" ::: "memory");
            const unsigned og = xb_add(&bar[XB_TOP], 1u);
            const unsigned tg = og / nx;
            if (og + 1u == (tg + 1u) * nx) xb_add(&bar[XB_TOPGEN], 1u);
            else XB_SPIN(xb_ld(&bar[XB_TOPGEN]) == tg, bar);
            __builtin_amdgcn_fence(__ATOMIC_ACQUIRE, "agent");
            xb_add(&bar[XB_XGEN(b.x)], 1u);
            asm volatile("s_waitcnt vmcnt(0)" ::: "memory");
        } else {
            XB_SPIN(xb_ld(&bar[XB_XGEN(b.x)]) == gen, bar);
            __builtin_amdgcn_fence(__ATOMIC_ACQUIRE, "agent");
            asm volatile("s_waitcnt vmcnt(0)" ::: "memory");
        }
    }
    __syncthreads();
}


__device__ __forceinline__ void p0_transpose_item(const float* W, int K, int N, bf16* WT, LAS float* scr, int item, int lane) {
    const int nblk = N / 32, kb = item / nblk, nb = item % nblk, k0 = 64 * kb, n0 = 32 * nb;
#pragma unroll 8
    for (int i = 0; i < 32; ++i) { const int kk = 2 * i + (lane >> 5); scr[kk * 33 + (lane & 31)] = W[(size_t)(k0 + kk) * N + n0 + (lane & 31)]; }
    LDS_WAIT(); asm volatile("" ::: "memory");
    const int c = lane & 7;
#pragma unroll
    for (int j = 0; j < 4; ++j) { const int n = (lane >> 3) + 8 * j; const LAS float* s = scr + (8 * c) * 33 + n;
        v4u o; o.x = pk2(s[0 * 33], s[1 * 33]); o.y = pk2(s[2 * 33], s[3 * 33]); o.z = pk2(s[4 * 33], s[5 * 33]); o.w = pk2(s[6 * 33], s[7 * 33]);
        *(v4u*)(WT + (size_t)(n0 + n) * K + k0 + 8 * c) = o; }
    LDS_WAIT(); asm volatile("" ::: "memory");
}

__device__ __forceinline__ void p0_mod_item(const float* c, const float* w_mod, const float* b_mod, float* part, int item, int lane) {
    const int cgp = item % 96, ks = item / 96, col = cgp * 64 + lane;
    float acc[16];
#pragma unroll
    for (int b = 0; b < 16; ++b) acc[b] = 0.f;
    for (int kk = 0; kk < 64; ++kk) {
        const int k = ks * 64 + kk;
        const float w = w_mod[(size_t)k * INW + col];
#pragma unroll
        for (int b = 0; b < 16; ++b) { const float cv = c[b * D + k]; acc[b] += (cv * sigm(cv)) * w; }
    }
    const float bm = (ks == 0) ? b_mod[col] : 0.f;
#pragma unroll
    for (int b = 0; b < 16; ++b) part[((size_t)ks * 16 + b) * INW + col] = acc[b] + bm;
}


__device__ __forceinline__ void ldrow(const float* p, int lane, f32x4 (&v)[4]) { const f32x4* xr = (const f32x4*)p + lane;
#pragma unroll
    for (int j = 0; j < 4; ++j) v[j] = xr[64 * j]; }
__device__ __forceinline__ void row_stats2(const f32x4 (&a)[4], const f32x4 (&b)[4], float& ma, float& ra, float& mb, float& rb) {
    float sa = 0.f, qa = 0.f, sb = 0.f, qb = 0.f;
#pragma unroll
    for (int j = 0; j < 4; ++j) { sa += (a[j].x + a[j].y) + (a[j].z + a[j].w); qa += (a[j].x * a[j].x + a[j].y * a[j].y) + (a[j].z * a[j].z + a[j].w * a[j].w);
                                  sb += (b[j].x + b[j].y) + (b[j].z + b[j].w); qb += (b[j].x * b[j].x + b[j].y * b[j].y) + (b[j].z * b[j].z + b[j].w * b[j].w); }
#pragma unroll
    for (int o = 1; o < 64; o <<= 1) { sa += __shfl_xor(sa, o); qa += __shfl_xor(qa, o); sb += __shfl_xor(sb, o); qb += __shfl_xor(qb, o); }
    ma = sa * (1.f / D); mb = sb * (1.f / D);
    ra = 1.f / sqrtf(fmaxf(qa * (1.f / D) - ma * ma, 0.f) + LN_EPS); rb = 1.f / sqrtf(fmaxf(qb * (1.f / D) - mb * mb, 0.f) + LN_EPS);
}
__device__ __forceinline__ void st_bf16row(bf16* orow, int lane, const f32x4 (&y)[4]) { v2u* o8 = (v2u*)orow + lane;
#pragma unroll
    for (int j = 0; j < 4; ++j) { v2u w; w.x = pk2(y[j].x, y[j].y); w.y = pk2(y[j].z, y[j].w); o8[64 * j] = w; } }
template <int MODE> __device__ __forceinline__ void ln_pass(const float* src, float* dstf, bf16* dsth, const float* g, const float* bta, const float* mod, int sh_off, int sc_off, int gw, int NGW, int lane) {
    f32x4 ca[4], cb[4], na[4], nb[4];
    int m = gw;
    if (m < M) { ldrow(src + (size_t)m * D, lane, ca); ldrow(src + (size_t)(m + NGW) * D, lane, cb); }
    for (; m < M; m += 2 * NGW) {
        const int mn = m + 2 * NGW;
        if (mn < M) { ldrow(src + (size_t)mn * D, lane, na); ldrow(src + (size_t)(mn + NGW) * D, lane, nb); }
        float ma, ra, mb, rb; row_stats2(ca, cb, ma, ra, mb, rb);
        if (MODE == 0) {
            const float* moda = mod + (size_t)(m >> 12) * INW; const float* modb = mod + (size_t)((m + NGW) >> 12) * INW;
#pragma unroll
            for (int j = 0; j < 4; ++j) { const f32x4 sca = ((const f32x4*)(moda + sc_off))[lane + 64 * j], sha = ((const f32x4*)(moda + sh_off))[lane + 64 * j];
                                          const f32x4 scb = ((const f32x4*)(modb + sc_off))[lane + 64 * j], shb = ((const f32x4*)(modb + sh_off))[lane + 64 * j];
                ca[j] = (ca[j] - ma) * ra * (sca + 1.0f) + sha; cb[j] = (cb[j] - mb) * rb * (scb + 1.0f) + shb; }
            st_bf16row(dsth + (size_t)m * D, lane, ca); st_bf16row(dsth + (size_t)(m + NGW) * D, lane, cb);
        } else {
#pragma unroll
            for (int j = 0; j < 4; ++j) { const f32x4 gg = ((const f32x4*)g)[lane + 64 * j], bb = ((const f32x4*)bta)[lane + 64 * j];
                ca[j] = (ca[j] - ma) * ra * gg + bb; cb[j] = (cb[j] - mb) * rb * gg + bb;
                ((f32x4*)(dstf + (size_t)m * D))[lane + 64 * j] = ca[j]; ((f32x4*)(dstf + (size_t)(m + NGW) * D))[lane + 64 * j] = cb[j]; }
            if (MODE == 1) {
                row_stats2(ca, cb, ma, ra, mb, rb);
                const float* moda = mod + (size_t)(m >> 12) * INW; const float* modb = mod + (size_t)((m + NGW) >> 12) * INW;
#pragma unroll
                for (int j = 0; j < 4; ++j) { const f32x4 sca = ((const f32x4*)(moda + sc_off))[lane + 64 * j], sha = ((const f32x4*)(moda + sh_off))[lane + 64 * j];
                                              const f32x4 scb = ((const f32x4*)(modb + sc_off))[lane + 64 * j], shb = ((const f32x4*)(modb + sh_off))[lane + 64 * j];
                    ca[j] = (ca[j] - ma) * ra * (sca + 1.0f) + sha; cb[j] = (cb[j] - mb) * rb * (scb + 1.0f) + shb; }
                st_bf16row(dsth + (size_t)m * D, lane, ca); st_bf16row(dsth + (size_t)(m + NGW) * D, lane, cb);
            }
        }
#pragma unroll
        for (int j = 0; j < 4; ++j) { ca[j] = na[j]; cb[j] = nb[j]; }
    }
}

__device__ __forceinline__ float gelu_tanh(float x) {
    const float u = 0.7978845608028654f * (x + 0.044715f * x * x * x);
    return x * __builtin_amdgcn_rcpf(1.0f + __expf(-2.0f * u));
}
__device__ __forceinline__ bf16x8 pack8(const float (&f)[8]) {
    v4u w; w.x = pk2(f[0], f[1]); w.y = pk2(f[2], f[3]); w.z = pk2(f[4], f[5]); w.w = pk2(f[6], f[7]); return __builtin_bit_cast(bf16x8, w);
}

__device__ __forceinline__ void ssm_item(KArgs a, int g, int bp, LAS unsigned char* wl, int lane) {
    const float* lam_re = a->in[5]; const float* lam_im = a->in[6]; const float* log_dt = a->in[7];
    const float* b_re = a->in[8]; const float* b_im = a->in[9]; const float* c_re = a->in[10]; const float* c_im = a->in[11]; const float* dsk = a->in[12];
    const bf16* proj = (const bf16*)(a->ws + WS_PROJ); bf16* zb = (bf16*)(a->ws + WS_HB);
    const int r = lane & 31, h = lane >> 5;
    const float dt = expf(log_dt[g]);
    float are[2], aim[2];
    bf16x8 bfr[4];
#pragma unroll
    for (int i = 0; i < 2; ++i) {
        const int p = r + 32 * i; const float lr = lam_re[g * NP + p], li = lam_im[g * NP + p];
        const float mag = expf(lr * dt), ar = mag * cosf(li * dt), ai = mag * sinf(li * dt);
        const float den = lr * lr + li * li, nr = ar - 1.0f, ni = ai;
        const float cr = (nr * lr + ni * li) / den, ci = (ni * lr - nr * li) / den;
        are[i] = ar; aim[i] = ai;
        const float* br = b_re + ((size_t)(g * NP + p)) * 16 + 8 * h; const float* bi = b_im + ((size_t)(g * NP + p)) * 16 + 8 * h;
        float fre[8], fim[8];
#pragma unroll
        for (int j = 0; j < 8; ++j) { fre[j] = cr * br[j] - ci * bi[j]; fim[j] = cr * bi[j] + ci * br[j]; }
        bfr[i] = pack8(fre); bfr[2 + i] = pack8(fim);
    }
    const int cch = lane & 15, kg = lane >> 4;
    bf16x8 cfr[4], dfr;
#pragma unroll
    for (int s = 0; s < 4; ++s) {
        const int p0 = 8 * s + 2 * kg; const float* cr = c_re + ((size_t)(g * 16 + cch)) * NP; const float* ci = c_im + ((size_t)(g * 16 + cch)) * NP;
        float f[8] = {cr[p0], -ci[p0], cr[p0 + 32], -ci[p0 + 32], cr[p0 + 1], -ci[p0 + 1], cr[p0 + 33], -ci[p0 + 33]};
        cfr[s] = pack8(f);
    }
    { float f[8];
#pragma unroll
      for (int j = 0; j < 8; ++j) f[j] = (kg < 2 && (8 * kg + j) == cch) ? dsk[g * 16 + cch] : 0.f;
      dfr = pack8(f); }
    const int b0 = 2 * bp;
    const int beta_r = (r >> 2) & 1, tok_r = 4 * (r >> 3) + (r & 3);
    const bf16* ua = proj + ((size_t)(b0 + beta_r) * T + tok_r) * INW + g * 16 + 8 * h;
    const bf16* ud = proj + ((size_t)b0 * T + cch) * INW + g * 16 + 8 * (kg & 1);
    bf16* zo = zb + ((size_t)b0 * T + 4 * kg) * D + g * 16 + cch;
    float sr[2] = {0.f, 0.f}, si[2] = {0.f, 0.f};
    LAS unsigned char* wrow = wl + (16 * h) * 272 + 8 * r;
    const LAS unsigned char* rrow = wl + cch * 272 + 16 * kg;
    bf16x8 af = *(const bf16x8*)(ua);
    for (int t0 = 0; t0 < T; t0 += 16) {
        const bf16x8 afc = af;
        if (t0 + 16 < T) af = *(const bf16x8*)(ua + (size_t)(t0 + 16) * INW);
        bf16x8 u0 = {0, 0, 0, 0, 0, 0, 0, 0}, u1 = {0, 0, 0, 0, 0, 0, 0, 0};
        if (kg < 2) { u0 = *(const bf16x8*)(ud + (size_t)t0 * INW); u1 = *(const bf16x8*)(ud + (size_t)(T + t0) * INW); }
        const f32x16 zz = {0.f, 0.f, 0.f, 0.f, 0.f, 0.f, 0.f, 0.f, 0.f, 0.f, 0.f, 0.f, 0.f, 0.f, 0.f, 0.f};
        const f32x16 bre0 = __builtin_amdgcn_mfma_f32_32x32x16_bf16(afc, bfr[0], zz, 0, 0, 0);
        const f32x16 bre1 = __builtin_amdgcn_mfma_f32_32x32x16_bf16(afc, bfr[1], zz, 0, 0, 0);
        const f32x16 bim0 = __builtin_amdgcn_mfma_f32_32x32x16_bf16(afc, bfr[2], zz, 0, 0, 0);
        const f32x16 bim1 = __builtin_amdgcn_mfma_f32_32x32x16_bf16(afc, bfr[3], zz, 0, 0, 0);
#pragma unroll
        for (int t = 0; t < 16; ++t) {
            const float nr0 = are[0] * sr[0] - aim[0] * si[0] + bre0[t], ni0 = are[0] * si[0] + aim[0] * sr[0] + bim0[t];
            const float nr1 = are[1] * sr[1] - aim[1] * si[1] + bre1[t], ni1 = are[1] * si[1] + aim[1] * sr[1] + bim1[t];
            sr[0] = nr0; si[0] = ni0; sr[1] = nr1; si[1] = ni1;
            v2u w; w.x = pk2(nr0, ni0); w.y = pk2(nr1, ni1);
            *(LAS v2u*)(wrow + t * 272) = w;
        }
        LDS_WAIT(); asm volatile("" ::: "memory");
#pragma unroll
        for (int be = 0; be < 2; ++be) {
            f32x4 y = {0.f, 0.f, 0.f, 0.f};
#pragma unroll
            for (int s = 0; s < 4; ++s) { const bf16x8 sa = *(const LAS bf16x8*)(rrow + be * 16 * 272 + 64 * s); y = __builtin_amdgcn_mfma_f32_16x16x32_bf16(sa, cfr[s], y, 0, 0, 0); }
            y = __builtin_amdgcn_mfma_f32_16x16x32_bf16(be ? u1 : u0, dfr, y, 0, 0, 0);
#pragma unroll
            for (int q = 0; q < 4; ++q) zo[((size_t)be * T + t0 + q) * D] = (bf16)pk2(gelu_tanh(y[q]), 0.f);
        }
        LDS_WAIT(); asm volatile("" ::: "memory");
    }
}

struct YRow { v4u a0, a1, b0, b1; };
__device__ __forceinline__ void yatt_load(const bf16* orow, int lane, YRow& r) {
    const int hh = lane >> 3, e0 = (lane & 7) * 16;
    const bf16* p1 = orow + (4 * hh + (e0 >> 6)) * 64 + (e0 & 63);
    r.a0 = *(const v4u*)(p1); r.a1 = *(const v4u*)(p1 + 8); r.b0 = *(const v4u*)(p1 + 128); r.b1 = *(const v4u*)(p1 + 136);
}
__device__ __forceinline__ void yatt_fin(const YRow& r, bf16* yrow, const float (&sg)[16], float lam, int lane) {
    const int hh = lane >> 3, e0 = (lane & 7) * 16;
    float o[16];
#pragma unroll
    for (int i = 0; i < 2; ++i) { const v4u a = i ? r.a1 : r.a0, b = i ? r.b1 : r.b0;
        o[8 * i + 0] = bfl(a.x) - lam * bfl(b.x); o[8 * i + 1] = bfh(a.x) - lam * bfh(b.x); o[8 * i + 2] = bfl(a.y) - lam * bfl(b.y); o[8 * i + 3] = bfh(a.y) - lam * bfh(b.y);
        o[8 * i + 4] = bfl(a.z) - lam * bfl(b.z); o[8 * i + 5] = bfh(a.z) - lam * bfh(b.z); o[8 * i + 6] = bfl(a.w) - lam * bfl(b.w); o[8 * i + 7] = bfh(a.w) - lam * bfh(b.w); }
    float ss = 0.f;
#pragma unroll
    for (int j = 0; j < 16; ++j) ss += o[j] * o[j];
    ss += __shfl_xor(ss, 1); ss += __shfl_xor(ss, 2); ss += __shfl_xor(ss, 4);
    const float rs = 1.f / sqrtf(ss * (1.f / 128.f) + RMS_EPS) * (1.0f - LAMBDA_INIT);
    float y[16];
#pragma unroll
    for (int j = 0; j < 16; ++j) y[j] = o[j] * rs * sg[j];
    v4u w0, w1; w0.x = pk2(y[0], y[1]); w0.y = pk2(y[2], y[3]); w0.z = pk2(y[4], y[5]); w0.w = pk2(y[6], y[7]); w1.x = pk2(y[8], y[9]); w1.y = pk2(y[10], y[11]); w1.z = pk2(y[12], y[13]); w1.w = pk2(y[14], y[15]);
    *(v4u*)(yrow + hh * 128 + e0) = w0; *(v4u*)(yrow + hh * 128 + e0 + 8) = w1;
}
__device__ __forceinline__ void yatt_pass(const bf16* OBp, bf16* PROJp, const float* subg, float lam, int gw, int NGW, int lane) {
    float sg[16];
#pragma unroll
    for (int j = 0; j < 16; ++j) sg[j] = subg[(lane & 7) * 16 + j];
    YRow c0, c1, c2, c3, n0, n1, n2, n3;
    int m = gw;
    if (m < M) { yatt_load(OBp + (size_t)m * 2048, lane, c0); yatt_load(OBp + (size_t)(m + NGW) * 2048, lane, c1); yatt_load(OBp + (size_t)(m + 2 * NGW) * 2048, lane, c2); yatt_load(OBp + (size_t)(m + 3 * NGW) * 2048, lane, c3); }
    for (; m < M; m += 4 * NGW) {
        const int mn = m + 4 * NGW;
        if (mn < M) { yatt_load(OBp + (size_t)mn * 2048, lane, n0); yatt_load(OBp + (size_t)(mn + NGW) * 2048, lane, n1); yatt_load(OBp + (size_t)(mn + 2 * NGW) * 2048, lane, n2); yatt_load(OBp + (size_t)(mn + 3 * NGW) * 2048, lane, n3); }
        yatt_fin(c0, PROJp + (size_t)m * INW + 1024, sg, lam, lane); yatt_fin(c1, PROJp + (size_t)(m + NGW) * INW + 1024, sg, lam, lane);
        yatt_fin(c2, PROJp + (size_t)(m + 2 * NGW) * INW + 1024, sg, lam, lane); yatt_fin(c3, PROJp + (size_t)(m + 3 * NGW) * INW + 1024, sg, lam, lane);
        c0 = n0; c1 = n1; c2 = n2; c3 = n3;
    }
}

__device__ __forceinline__ void up8(const v4u p, float (&f)[8]) { f[0] = bfl(p.x); f[1] = bfh(p.x); f[2] = bfl(p.y); f[3] = bfh(p.y); f[4] = bfl(p.z); f[5] = bfh(p.z); f[6] = bfl(p.w); f[7] = bfh(p.w); }
__device__ __forceinline__ void conv_item(bf16* proj, const float* cw, const float* cb, int item) {
    const int cc = item % (FF / 8), rr = item / (FF / 8), f0 = cc * 8, t0 = rr * 8;
    bf16* base = proj + (size_t)t0 * INW + f0;
    v4u pa[10], pv[8];
    const bool first = (t0 & (T - 1)) == 0;
    const v4u zero4 = {0u, 0u, 0u, 0u};
    pa[0] = first ? zero4 : *(const v4u*)(base - 2 * (size_t)INW); pa[1] = first ? zero4 : *(const v4u*)(base - (size_t)INW);
#pragma unroll
    for (int i = 0; i < 8; ++i) { pa[2 + i] = *(const v4u*)(base + (size_t)i * INW); pv[i] = *(const v4u*)(base + (size_t)i * INW + FF); }
    float w0[8], w1[8], w2[8], bb[8];
#pragma unroll
    for (int j = 0; j < 8; ++j) { w0[j] = cw[f0 + j]; w1[j] = cw[FF + f0 + j]; w2[j] = cw[2 * FF + f0 + j]; bb[j] = cb[f0 + j]; }
    float am2[8], am1[8];
    up8(pa[0], am2); up8(pa[1], am1);
#pragma unroll
    for (int i = 0; i < 8; ++i) {
        float a0[8], vv[8], o[8]; up8(pa[2 + i], a0); up8(pv[i], vv);
#pragma unroll
        for (int j = 0; j < 8; ++j) { const float cv = w0[j] * am2[j] + w1[j] * am1[j] + w2[j] * a0[j] + bb[j]; o[j] = cv * __builtin_amdgcn_rcpf(1.0f + __expf(-cv)) * vv[j]; am2[j] = am1[j]; am1[j] = a0[j]; }
        v4u w; w.x = pk2(o[0], o[1]); w.y = pk2(o[2], o[3]); w.z = pk2(o[4], o[5]); w.w = pk2(o[6], o[7]);
        *(v4u*)(base + (size_t)i * INW + FF) = w;
    }
}

__global__ void __launch_bounds__(NTHREADS, 2) mk_fwd(Args args) {
    extern __shared__ __attribute__((aligned(16))) unsigned char lds[];
    cg::grid_group grid = cg::this_grid();
    LAS unsigned char* L = (LAS unsigned char*)lds;
    const int tid = threadIdx.x, lane = tid & 63, wave = __builtin_amdgcn_readfirstlane(tid >> 6);
    const int G = gridDim.x, bx = blockIdx.x;
    const int vcu = (G % 8 == 0) ? (bx % 8) * (G / 8) + bx / 8 : bx;
    const int gw = vcu * NWAVES + wave, NGW = G * NWAVES;
    unsigned char* ws = kargs()->ws;
    bf16* WinT = (bf16*)(ws + WS_WIN); bf16* WgluT = (bf16*)(ws + WS_WGLU); bf16* WbsT = (bf16*)(ws + WS_WBS); bf16* WbaT = (bf16*)(ws + WS_WBA);
    bf16* WoutT = (bf16*)(ws + WS_WOUT); bf16* WupT = (bf16*)(ws + WS_WUP); bf16* WdownT = (bf16*)(ws + WS_WDOWN);
    bf16* PROJ = (bf16*)(ws + WS_PROJ); bf16* HB = (bf16*)(ws + WS_HB);
    float* MODP = (float*)(ws + WS_MODP); float* MOD = (float*)(ws + WS_MOD);
    float* OUT = kargs()->out; bf16* OB = (bf16*)kargs()->out;
#define GSYNC_CG() do { __builtin_amdgcn_fence(__ATOMIC_RELEASE, "agent"); grid.sync(); __builtin_amdgcn_fence(__ATOMIC_ACQUIRE, "agent"); } while (0)
#define GSYNC() xcd_barrier(bar)
    for (int u = tid; u < (LDS_BYTES - LDSCTL_OFF) / 4; u += NTHREADS) ((LAS unsigned*)(L + LDSCTL_OFF))[u] = 0u;
    __syncthreads();
    const XcdBarrier bar = xcd_barrier_post((unsigned*)(ws + WS_CTL) + CW_BAR, (volatile LAS unsigned*)(L + MISC_OFF) + 8);

    {
        LAS float* scr = (LAS float*)(L + wave * 16384);
        constexpr int I_IN = (D / 64) * (INW / 32), I_SQ = (D / 64) * (D / 32), I_UP = (D / 64) * (2 * FF / 32), I_DN = (FF / 64) * (D / 32);
        constexpr int NITEMS = I_IN + 4 * I_SQ + I_UP + I_DN;
        for (int it = gw; it < NITEMS; it += NGW) {
            int r = it;
            if (r < I_IN) { p0_transpose_item(kargs()->in[4], D, INW, WinT, scr, r, lane); continue; } r -= I_IN;
            if (r < I_SQ) { p0_transpose_item(kargs()->in[13], D, D, WgluT, scr, r, lane); continue; } r -= I_SQ;
            if (r < I_SQ) { p0_transpose_item(kargs()->in[20], D, D, WbsT, scr, r, lane); continue; } r -= I_SQ;
            if (r < I_SQ) { p0_transpose_item(kargs()->in[21], D, D, WbaT, scr, r, lane); continue; } r -= I_SQ;
            if (r < I_SQ) { p0_transpose_item(kargs()->in[22], D, D, WoutT, scr, r, lane); continue; } r -= I_SQ;
            if (r < I_UP) { p0_transpose_item(kargs()->in[25], D, 2 * FF, WupT, scr, r, lane); continue; } r -= I_UP;
            p0_transpose_item(kargs()->in[28], FF, D, WdownT, scr, r, lane);
        }
        for (int it = gw; it < 96 * 16; it += NGW) p0_mod_item(kargs()->in[1], kargs()->in[2], kargs()->in[3], MODP, it, lane);
    }
    GSYNC_CG();
    for (int i = bx * NTHREADS + tid; i < 16 * INW; i += G * NTHREADS) { float s = 0.f;
#pragma unroll
        for (int ks = 0; ks < 16; ++ks) s += MODP[(size_t)ks * 16 * INW + i];
        MOD[i] = s; }
    GSYNC();
    ln_pass<0>(kargs()->in[0], nullptr, HB, nullptr, nullptr, MOD, 0, D, gw, NGW, lane);
    GSYNC();
    {
        pg8::Gemm g{HB, WinT, D, D, D}; pg8::StaticOrder S; S.init(M, INW, G, bx);
        pg8::Epi<pg8::EP_PROJ> E{}; E.O = PROJ; E.ldo = INW; E.qscale = attn_body::C2;
        pg8::gemm_phase<pg8::Epi<pg8::EP_PROJ>, pg8::StaticOrder, true, true>(L, g, S, E);
    }
    GSYNC();
    {
        if (bx < 64) {
            ssm_item(kargs(), (bx * 8 + wave) >> 3, (bx * 8 + wave) & 7, L + wave * 16384, lane);
            __syncthreads();
        }
        unsigned* qctr = (unsigned*)(ws + WS_CTL) + CW_QUEUE;
        volatile LAS unsigned* qw = (volatile LAS unsigned*)(L + MISC_OFF) + 16;
        const int xcc = (int)(xb_xcc_id() & 7u);
        for (int s = 0; s < 8; ++s) {
            const int xq = (xcc + s) & 7;
            for (;;) {
                if (tid == 0) qw[0] = __hip_atomic_fetch_add(qctr + 64 * xq, 1u, __ATOMIC_RELAXED, __HIP_MEMORY_SCOPE_AGENT);
                __syncthreads();
                const int idx = __builtin_amdgcn_readfirstlane((int)qw[0]);
                __syncthreads();
                if (idx >= 1024) break;
                const int gp = idx >> 6, within = idx & 63, qb = 15 - (within >> 2), sub = within & 3, vh = sub & 1;
                const int gidx = xq + 8 * (2 * gp + (sub >> 1)), b = gidx >> 4, hm = gidx & 15;
                attn_body::attn_unit<8>(b, hm, 2 * (hm >> 1) + vh, 2 * hm + vh, qb, (const attn_body::bf16*)(PROJ + 1024), (const attn_body::bf16*)(PROJ + 2048), (const attn_body::bf16*)(PROJ + 3072), (attn_body::bf16*)OB, (char*)lds);
            }
        }
    }
    GSYNC();
    {
        float lam;
        { const float v1 = kargs()->in[15][lane] * kargs()->in[16][lane], v2 = kargs()->in[17][lane] * kargs()->in[18][lane];
          lam = expf(wave_sum(v1)) - expf(wave_sum(v2)) + LAMBDA_INIT; }
        yatt_pass(OB, PROJ, kargs()->in[19], lam, gw, NGW, lane);
        pg8::Gemm g{HB, WgluT, D, D, D}; pg8::StaticOrder S; S.init(M, D, G, bx);
        pg8::Epi<pg8::EP_GLU> E{}; E.O = PROJ; E.ldo = INW; E.X1 = HB; E.ldx1 = D; E.bias = kargs()->in[14];
        pg8::gemm_phase<pg8::Epi<pg8::EP_GLU>, pg8::StaticOrder, true, true>(L, g, S, E);
    }
    GSYNC();
    {
        pg8::Gemm g{PROJ, WbsT, INW, D, D}; pg8::StaticOrder S; S.init(M, D, G, bx);
        pg8::Epi<pg8::EP_BS> E{}; E.O = PROJ + 2048; E.ldo = INW; E.X1 = PROJ + 4096; E.ldx1 = INW;
        pg8::gemm_phase<pg8::Epi<pg8::EP_BS>, pg8::StaticOrder, true, true>(L, g, S, E);
    }
    {
        pg8::Gemm g{PROJ + 1024, WbaT, INW, D, D}; pg8::StaticOrder S; S.init(M, D, G, bx);
        pg8::Epi<pg8::EP_BA> E{}; E.O = PROJ + 3072; E.ldo = INW; E.X1 = PROJ + 5120; E.ldx1 = INW; E.X2 = PROJ + 2048; E.ldx2 = INW;
        pg8::gemm_phase<pg8::Epi<pg8::EP_BA>, pg8::StaticOrder, true, true>(L, g, S, E);
    }
    GSYNC();
    {
        pg8::Gemm g{PROJ + 3072, WoutT, INW, D, D}; pg8::StaticOrder S; S.init(M, D, G, bx);
        pg8::Epi<pg8::EP_OUT> E{}; E.F = OUT; E.R = kargs()->in[0]; E.gate = MOD + 2 * D; E.alpha = DN_ALPHA;
        pg8::gemm_phase<pg8::Epi<pg8::EP_OUT>, pg8::StaticOrder, true, true>(L, g, S, E);
    }
    GSYNC();
    ln_pass<1>(OUT, OUT, HB, kargs()->in[23], kargs()->in[24], MOD, 3 * D, 4 * D, gw, NGW, lane);
    GSYNC();
    {
        pg8::Gemm g{HB, WupT, D, D, D}; pg8::StaticOrder S; S.init(M, 2 * FF, G, bx);
        pg8::Epi<pg8::EP_UP> E{}; E.O = PROJ; E.ldo = INW;
        pg8::gemm_phase<pg8::Epi<pg8::EP_UP>, pg8::StaticOrder, true, true>(L, g, S, E);
    }
    GSYNC();
    for (int it = bx * NTHREADS + tid; it < (M / 8) * (FF / 8); it += G * NTHREADS) conv_item(PROJ, kargs()->in[26], kargs()->in[27], it);
    GSYNC();
    {
        pg8::Gemm g{PROJ + FF, WdownT, INW, FF, FF}; pg8::StaticOrder S; S.init(M, D, G, bx);
        pg8::Epi<pg8::EP_DOWN> E{}; E.F = OUT; E.R = OUT; E.gate = MOD + 5 * D; E.alpha = DN_ALPHA;
        pg8::gemm_phase<pg8::Epi<pg8::EP_DOWN>, pg8::StaticOrder, true, true>(L, g, S, E);
    }
    GSYNC();
    ln_pass<2>(OUT, OUT, nullptr, kargs()->in[29], kargs()->in[30], nullptr, 0, 0, gw, NGW, lane);
}

extern "C" void kernel_launch(void* const* d_in, const int* in_sizes, int n_in, void* d_out, int out_size, void* d_ws, size_t ws_size, hipStream_t stream) {
    static int grid = 0;
    if (grid == 0) {
        if (n_in != 31 || in_sizes[0] != M * D || out_size != M * D || ws_size < WS_END) { fprintf(stderr, "kernel_launch: unexpected shapes (n_in %d, in0 %d, out %d, ws %zu); nothing launched\n", n_in, n_in > 0 ? in_sizes[0] : -1, out_size, ws_size); grid = -1; return; }
        int dev = 0, cus = 0, per_cu = 0;
        if (hipGetDevice(&dev) != hipSuccess || hipDeviceGetAttribute(&cus, hipDeviceAttributeMultiprocessorCount, dev) != hipSuccess) { grid = -1; return; }
        if (hipFuncSetAttribute((const void*)mk_fwd, hipFuncAttributeMaxDynamicSharedMemorySize, LDS_BYTES) != hipSuccess) { fprintf(stderr, "kernel_launch: hipFuncSetAttribute failed\n"); grid = -1; return; }
        if (hipOccupancyMaxActiveBlocksPerMultiprocessor(&per_cu, (const void*)mk_fwd, NTHREADS, LDS_BYTES) != hipSuccess || per_cu < 1) { fprintf(stderr, "kernel_launch: occupancy query says %d\n", per_cu); per_cu = 1; }
        (void)hipGetLastError();
        grid = cus * per_cu;
    }
    if (grid < 0) return;
    if (hipMemsetAsync((char*)d_ws + WS_CTL, 0, CTL_ZERO_BYTES, stream) != hipSuccess) { fprintf(stderr, "kernel_launch: memset failed\n"); return; }
    Args a{};
    for (int i = 0; i < 31; ++i) a.in[i] = (const float*)d_in[i];
    a.out = (float*)d_out; a.ws = (unsigned char*)d_ws;
    void* kargs[] = {&a};
    hipError_t e = hipLaunchCooperativeKernel((const void*)mk_fwd, dim3(grid), dim3(NTHREADS), kargs, LDS_BYTES, stream);
    if (e != hipSuccess) fprintf(stderr, "kernel_launch: cooperative launch failed: %s (grid %d)\n", hipGetErrorString(e), grid);
}
```

```cpp
#include <hip/hip_runtime.h>
#include <hip/hip_cooperative_groups.h>
#include <cstdio>
#include <cstdint>
namespace cg = cooperative_groups;
namespace pg8 {
#define PG8_LAS __attribute__((address_space(3)))
typedef unsigned short bf16_t;
typedef short bf16x8 __attribute__((ext_vector_type(8)));
typedef float f32x4 __attribute__((ext_vector_type(4)));
typedef unsigned u32x4 __attribute__((ext_vector_type(4)));
constexpr int BM = 256, BK = 64, HALF = 128, HTB = HALF * BK * 2  , STAGE_BYTES = 8 * HTB, NXCD = 8, WGM = 8;

__host__ __device__ __forceinline__ int lds_byte(int r, int c) { const int st = (r >> 4) * 2 + (c >> 5), rr = r & 15, cc = c & 31, ob = rr * 64 + cc * 2; return st * 1024 + (ob ^ (((ob >> 9) & 1) << 5)); }
__host__ __device__ __forceinline__ void stage_rc(int b, int& R, int& C) { const int st = b / 1024, sb = b % 1024, swz = sb ^ (((sb >> 9) & 1) << 5); R = (st >> 1) * 16 + swz / 64; C = (st & 1) * 32 + (swz % 64) / 2; }
__host__ __device__ __forceinline__ int perm32(int rho) { const int n = rho >> 4, i = rho & 15; return 8 * (i >> 2) + 4 * n + (i & 3); }

struct Unit { int pm, pn; };
struct Gemm { const bf16_t* A; const bf16_t* Bt; int lda, ldb, K; };

struct StaticOrder {
    int nM, nN, nwg, G, c;
    __host__ __device__ void init(int M, int N, int G_, int c_) { nM = M / BM; nN = N / BM; nwg = nM * nN; G = G_; c = c_; }
    __host__ __device__ bool next(int i, Unit& u) const {
        const long L = (long)i * G + c; if (L >= nwg) return false;
        int wgid = (int)L; { const int q = nwg / NXCD, r = nwg % NXCD, xcd = wgid % NXCD, off = wgid / NXCD; wgid = (xcd < r ? xcd * (q + 1) : r * (q + 1) + (xcd - r) * q) + off; }
        const int nig = WGM * nN, gid = wgid / nig, fm = gid * WGM, gsz = (nM - fm) < WGM ? (nM - fm) : WGM;
        u.pm = fm + ((wgid % nig) % gsz); u.pn = (wgid % nig) / gsz; return true;
    }
    __device__ __forceinline__ void a_ready(const Unit&) const {}
    __device__ __forceinline__ void done(const Unit&) const {}
};

__device__ __forceinline__ unsigned cvt_pk_bf16(float lo, float hi) { unsigned r; asm volatile("v_cvt_pk_bf16_f32 %0, %1, %2" : "=v"(r) : "v"(lo), "v"(hi)); return r; }

__device__ __forceinline__ float bf_lo(unsigned u) { return __uint_as_float(u << 16); }
__device__ __forceinline__ float bf_hi(unsigned u) { return __uint_as_float(u & 0xffff0000u); }
__device__ __forceinline__ float sigmoidf_fast(float x) { return __builtin_amdgcn_rcpf(1.0f + __expf(-x)); }
__device__ __forceinline__ void unpack8(const u32x4 w, float (&f)[8]) { f[0] = bf_lo(w.x); f[1] = bf_hi(w.x); f[2] = bf_lo(w.y); f[3] = bf_hi(w.y); f[4] = bf_lo(w.z); f[5] = bf_hi(w.z); f[6] = bf_lo(w.w); f[7] = bf_hi(w.w); }
enum { EP_PROJ = 0, EP_GLU = 1, EP_BS = 2, EP_BA = 3, EP_OUT = 4, EP_UP = 5, EP_DOWN = 6, EP_UPC = 7 };
template <int MODE> struct Epi {
    static constexpr bool PERM = (MODE != EP_OUT && MODE != EP_DOWN), AFTER_DRAIN = false;
    bf16_t* O; int ldo;
    const bf16_t* X1; int ldx1;
    const bf16_t* X2; int ldx2;
    const float* bias;
    float* F; const float* R; const float* gate; float alpha;
    float qscale;
    bf16_t* S0; bf16_t* S1; bf16_t* S2; const float* cw; const float* cb;
    __device__ __forceinline__ void operator()(const f32x4 (&acc)[2][2][4][2], const Unit& u, int wr, int wc, int fr, int fq) const {
        if constexpr (MODE == EP_UPC) {
            constexpr int FFc = 2816;
            const int lane_ = (int)(threadIdx.x & 63);
            const int src1 = (lane_ & 48) | ((fr + 15) & 15), src2 = (lane_ & 48) | ((fr + 14) & 15);
            const int row0 = u.pm * BM + wr * 64 + fr, fb0 = u.pn * 128 + wc * 16 + 4 * fq;
            f32x4 w0v[2], w1v[2], w2v[2], cbv[2];
#pragma unroll
            for (int bj = 0; bj < 2; ++bj) { w0v[bj] = *(const f32x4*)(cw + fb0 + bj * 64); w1v[bj] = *(const f32x4*)(cw + FFc + fb0 + bj * 64); w2v[bj] = *(const f32x4*)(cw + 2 * FFc + fb0 + bj * 64); cbv[bj] = *(const f32x4*)(cb + fb0 + bj * 64); }
#pragma unroll
            for (int ai = 0; ai < 2; ++ai)
#pragma unroll
                for (int m = 0; m < 4; ++m) {
                    const int row = row0 + ai * HALF + m * 16; const int strip = row >> 6;
#pragma unroll
                    for (int bj = 0; bj < 2; ++bj) {
                        const int fb = fb0 + bj * 64;
                        const f32x4 A = acc[ai][bj][m][0], V = acc[ai][bj][m][1];
                        const f32x4 Ap = acc[ai][bj][m > 0 ? m - 1 : 0][0];
                        float g[4];
#pragma unroll
                        for (int i = 0; i < 4; ++i) {
                            const float c1 = __shfl(A[i], src1), c2 = __shfl(A[i], src2);
                            float p1 = c1, p2 = c2;
                            if (m > 0) { const float d1 = __shfl(Ap[i], src1), d2 = __shfl(Ap[i], src2); p1 = (fr >= 1) ? c1 : d1; p2 = (fr >= 2) ? c2 : d2; }
                            const float cv = w0v[bj][i] * p2 + w1v[bj][i] * p1 + w2v[bj][i] * A[i] + cbv[bj][i];
                            g[i] = cv * sigmoidf_fast(cv) * V[i];
                        }
                        typedef unsigned u32x2 __attribute__((ext_vector_type(2)));
                        if (m == 0 && fr < 2) {
                            u32x2 wa; wa.x = cvt_pk_bf16(A[0], A[1]); wa.y = cvt_pk_bf16(A[2], A[3]);
                            u32x2 wv; wv.x = cvt_pk_bf16(V[0], V[1]); wv.y = cvt_pk_bf16(V[2], V[3]);
                            *(u32x2*)(S0 + ((size_t)strip * 2 + fr) * FFc + fb) = wa; *(u32x2*)(S1 + ((size_t)strip * 2 + fr) * FFc + fb) = wv;
                        } else {
                            u32x2 wg; wg.x = cvt_pk_bf16(g[0], g[1]); wg.y = cvt_pk_bf16(g[2], g[3]);
                            *(u32x2*)(O + (size_t)row * ldo + fb) = wg;
                        }
                        if (m == 3 && fr >= 14) { u32x2 wa; wa.x = cvt_pk_bf16(A[0], A[1]); wa.y = cvt_pk_bf16(A[2], A[3]); *(u32x2*)(S2 + ((size_t)strip * 2 + (fr - 14)) * FFc + fb) = wa; }
                    }
                    asm volatile("" ::: "memory");
                }
        } else
        if constexpr (PERM) {
            const int row0 = u.pm * BM + wr * 64 + fr, col0 = u.pn * BM + wc * 32 + 8 * fq;
            float sc = 1.f; if (MODE == EP_PROJ) { const int colt = u.pn * BM; if (colt >= 1024 && colt < 2048) sc = qscale; }
            float bv[2][8];
            if (MODE == EP_GLU) {
#pragma unroll
                for (int bj = 0; bj < 2; ++bj) { const f32x4 b0 = *(const f32x4*)(bias + col0 + bj * HALF), b1 = *(const f32x4*)(bias + col0 + bj * HALF + 4);
                    bv[bj][0] = b0[0]; bv[bj][1] = b0[1]; bv[bj][2] = b0[2]; bv[bj][3] = b0[3]; bv[bj][4] = b1[0]; bv[bj][5] = b1[1]; bv[bj][6] = b1[2]; bv[bj][7] = b1[3]; }
            }
#pragma unroll
            for (int ai = 0; ai < 2; ++ai)
#pragma unroll
                for (int m = 0; m < 4; ++m) {
                    const size_t row = (size_t)(row0 + ai * HALF + m * 16);
#pragma unroll
                    for (int bj = 0; bj < 2; ++bj) {
                        const int col = col0 + bj * HALF;
                        float v[8];
#pragma unroll
                        for (int j = 0; j < 4; ++j) { v[j] = acc[ai][bj][m][0][j]; v[4 + j] = acc[ai][bj][m][1][j]; }
                        if (MODE == EP_PROJ) {
#pragma unroll
                            for (int j = 0; j < 8; ++j) v[j] *= sc;
                        }
                        if (MODE == EP_GLU) {
                            float z[8]; unpack8(*(const u32x4*)(X1 + row * ldx1 + col), z);
#pragma unroll
                            for (int j = 0; j < 8; ++j) v[j] = z[j] * sigmoidf_fast(v[j] + bv[bj][j]);
                        }
                        if (MODE == EP_BS) {
                            float gt[8]; unpack8(*(const u32x4*)(X1 + row * ldx1 + col), gt);
#pragma unroll
                            for (int j = 0; j < 8; ++j) v[j] = sigmoidf_fast(gt[j]) * v[j];
                        }
                        if (MODE == EP_BA) {
                            float gt[8], m1[8]; unpack8(*(const u32x4*)(X1 + row * ldx1 + col), gt); unpack8(*(const u32x4*)(X2 + row * ldx2 + col), m1);
#pragma unroll
                            for (int j = 0; j < 8; ++j) v[j] = m1[j] + sigmoidf_fast(gt[j]) * v[j];
                        }
                        u32x4 w; w.x = cvt_pk_bf16(v[0], v[1]); w.y = cvt_pk_bf16(v[2], v[3]); w.z = cvt_pk_bf16(v[4], v[5]); w.w = cvt_pk_bf16(v[6], v[7]);
                        *(u32x4*)(O + row * ldo + col) = w;
                    }
                    asm volatile("" ::: "memory");
                }
        } else {
            const int row0 = u.pm * BM + wr * 64 + fr, col0 = u.pn * BM + wc * 32 + 4 * fq;
            const float* gp = gate + (size_t)((u.pm * BM) >> 12) * 6144;
            f32x4 gv[2][2];
#pragma unroll
            for (int bj = 0; bj < 2; ++bj)
#pragma unroll
                for (int n = 0; n < 2; ++n) gv[bj][n] = *(const f32x4*)(gp + col0 + bj * HALF + n * 16);
#pragma unroll
            for (int ai = 0; ai < 2; ++ai)
#pragma unroll
                for (int m = 0; m < 4; ++m) {
                    const size_t off = (size_t)(row0 + ai * HALF + m * 16) * 1024 + col0;
#pragma unroll
                    for (int bj = 0; bj < 2; ++bj)
#pragma unroll
                        for (int n = 0; n < 2; ++n) { const f32x4 rs = *(const f32x4*)(R + off + bj * HALF + n * 16);
                            *(f32x4*)(F + off + bj * HALF + n * 16) = rs * alpha + gv[bj][n] * acc[ai][bj][m][n]; }
                    asm volatile("" ::: "memory");
                }
        }
    }
};

template <class Epi, class Sched, bool ALIGN_EPI = false, bool SP2 = false>
__device__ __forceinline__ void gemm_phase(PG8_LAS unsigned char* lds, const Gemm g, const Sched& S, const Epi& E) {
    int tid_ = threadIdx.x; asm volatile("" : "+v"(tid_)); const int tid = tid_, wid = __builtin_amdgcn_readfirstlane(tid >> 6), lane = tid & 63, wr = wid >> 2, wc = wid & 3, fr = lane & 15, fq = lane >> 4;
    const int K = g.K, nt = K / BK;
    unsigned voffA[2], voffB[2];
#pragma unroll
    for (int i = 0; i < 2; ++i) { int R, C; stage_rc(tid * 16 + i * 8192, R, C); const int Rb = Epi::PERM ? ((R & ~31) + perm32(R & 31)) : R;
        voffA[i] = (unsigned)(R * g.lda + C) * 2u; voffB[i] = (unsigned)(Rb * g.ldb + C) * 2u; }
    const size_t kstep = (size_t)(BK * 2);
    const size_t hstepA = (size_t)HALF * g.lda * 2, hstepB = (size_t)HALF * g.ldb * 2;
    const size_t tstepA = 2 * hstepA, tstepB = 2 * hstepB;
    const unsigned ldsw = (unsigned)wid * 1024u;
    const int aoff = lds_byte(wr * 64 + fr, fq * 8), boff = lds_byte(wc * 32 + fr, fq * 8);
#define PG8_SA(b, h) (((b) * 2 + (h)) * HTB)
#define PG8_SB(b, h) ((4 + (b) * 2 + (h)) * HTB)
#define PG8_STAGE(bufoff, gbase, voff) do { _Pragma("unroll") for (int _i = 0; _i < 2; ++_i) \
        __builtin_amdgcn_global_load_lds((const unsigned*)((const char*)(gbase) + (voff)[_i]), (PG8_LAS unsigned*)(lds + (bufoff) + ldsw + _i * 8192), 16, 0, 0); } while (0)
#define PG8_LDA(dst, b, h) do { _Pragma("unroll") for (int m = 0; m < 4; ++m) _Pragma("unroll") for (int k = 0; k < 2; ++k) dst[m][k] = *(const PG8_LAS bf16x8*)(lds + PG8_SA(b, h) + aoff + m * 2048 + k * 1024); } while (0)
#define PG8_LDB(dst, b, h) do { _Pragma("unroll") for (int n = 0; n < 2; ++n) _Pragma("unroll") for (int k = 0; k < 2; ++k) dst[n][k] = *(const PG8_LAS bf16x8*)(lds + PG8_SB(b, h) + boff + n * 2048 + k * 1024); } while (0)
#define PG8_MMA(ai, bj, At, Bt) do { __builtin_amdgcn_s_setprio(1); _Pragma("unroll") for (int m = 0; m < 4; ++m) _Pragma("unroll") for (int n = 0; n < 2; ++n) _Pragma("unroll") for (int k = 0; k < 2; ++k) \
        acc[ai][bj][m][n] = __builtin_amdgcn_mfma_f32_16x16x32_bf16(Bt[n][k], At[m][k], acc[ai][bj][m][n], 0, 0, 0); __builtin_amdgcn_s_setprio(0); } while (0)
#define PG8_WAIT_V(n) asm volatile("s_waitcnt vmcnt(" #n ")" ::: "memory")
#define PG8_WAIT_L(n) asm volatile("s_waitcnt lgkmcnt(" #n ")" ::: "memory")
#define PG8_BAR __builtin_amdgcn_s_barrier()
#define PG8_SCHED __builtin_amdgcn_sched_barrier(0)
    Unit cur, nxt; int ui = 0;
    if (!S.next(0, cur)) return;
    f32x4 acc[2][2][4][2];
#pragma unroll
    for (int a = 0; a < 2; ++a)
#pragma unroll
        for (int b = 0; b < 2; ++b)
#pragma unroll
            for (int m = 0; m < 4; ++m)
#pragma unroll
                for (int n = 0; n < 2; ++n) acc[a][b][m][n] = (f32x4){0.f, 0.f, 0.f, 0.f};
    bf16x8 At[4][2], B0[2][2], B1[2][2];
    const char* cA = (const char*)g.A + (size_t)cur.pm * tstepA; const char* cB = (const char*)g.Bt + (size_t)cur.pn * tstepB;
    S.a_ready(cur);
    if constexpr (SP2) {
        PG8_STAGE(PG8_SB(0, 0), cB, voffB); PG8_STAGE(PG8_SB(0, 1), cB + hstepB, voffB); PG8_STAGE(PG8_SA(0, 0), cA, voffA); PG8_STAGE(PG8_SA(0, 1), cA + hstepA, voffA);
        if (wr == 1) PG8_BAR;
        PG8_WAIT_V(2); PG8_BAR;
        PG8_STAGE(PG8_SB(1, 0), cB + kstep, voffB); PG8_STAGE(PG8_SA(1, 0), cA + kstep, voffA); PG8_STAGE(PG8_SB(1, 1), cB + hstepB + kstep, voffB);
        PG8_WAIT_V(6); PG8_BAR;
    } else {
        PG8_STAGE(PG8_SB(0, 0), cB, voffB); PG8_STAGE(PG8_SA(0, 0), cA, voffA); PG8_STAGE(PG8_SB(0, 1), cB + hstepB, voffB); PG8_STAGE(PG8_SA(0, 1), cA + hstepA, voffA);
        if (wr == 1) PG8_BAR;
        PG8_WAIT_V(4); PG8_BAR;
        PG8_STAGE(PG8_SB(1, 0), cB + kstep, voffB); PG8_STAGE(PG8_SA(1, 0), cA + kstep, voffA); PG8_STAGE(PG8_SB(1, 1), cB + hstepB + kstep, voffB);
        PG8_WAIT_V(6); PG8_BAR;
    }
    for (;;) {
        const bool has_next = S.next(ui + 1, nxt);
        const char* nA = has_next ? (const char*)g.A + (size_t)nxt.pm * tstepA : cA; const char* nB = has_next ? (const char*)g.Bt + (size_t)nxt.pn * tstepB : cB;
        for (int t = 0; t < nt; t += 2) {
            const bool last = (t == nt - 2);
            const char* a1 = cA + (size_t)(t + 1) * kstep;
            const char* a2 = last ? nA : cA + (size_t)(t + 2) * kstep; const char* b2 = last ? nB : cB + (size_t)(t + 2) * kstep;
            const char* a3 = a2 + kstep; const char* b3 = b2 + kstep;
            if (last && has_next) S.a_ready(nxt);
            if constexpr (SP2) {
            PG8_LDB(B0, 0, 0); PG8_LDB(B1, 0, 1); PG8_SCHED; PG8_LDA(At, 0, 0); PG8_STAGE(PG8_SA(1, 1), a1 + hstepA, voffA);
            PG8_WAIT_V(8); PG8_WAIT_L(0); PG8_BAR; PG8_MMA(0, 0, At, B0); PG8_MMA(0, 1, At, B1); PG8_BAR; PG8_SCHED;
            PG8_LDA(At, 0, 1); PG8_STAGE(PG8_SB(0, 0), b2, voffB); PG8_STAGE(PG8_SB(0, 1), b2 + hstepB, voffB); PG8_STAGE(PG8_SA(0, 0), a2, voffA);
            PG8_WAIT_V(8); PG8_WAIT_L(0); PG8_BAR; PG8_MMA(1, 0, At, B0); PG8_MMA(1, 1, At, B1); PG8_BAR; PG8_SCHED;
            PG8_LDB(B0, 1, 0); PG8_LDB(B1, 1, 1); PG8_SCHED; PG8_LDA(At, 1, 0); PG8_STAGE(PG8_SA(0, 1), a2 + hstepA, voffA);
            PG8_WAIT_V(8); PG8_WAIT_L(0); PG8_BAR; PG8_MMA(0, 0, At, B0); PG8_MMA(0, 1, At, B1); PG8_BAR; PG8_SCHED;
            PG8_LDA(At, 1, 1); PG8_STAGE(PG8_SB(1, 0), b3, voffB); PG8_STAGE(PG8_SB(1, 1), b3 + hstepB, voffB); PG8_STAGE(PG8_SA(1, 0), a3, voffA);
            PG8_WAIT_V(8); PG8_WAIT_L(0); PG8_BAR; PG8_MMA(1, 0, At, B0); PG8_MMA(1, 1, At, B1); PG8_BAR; PG8_SCHED;
            } else {
            PG8_LDB(B0, 0, 0); PG8_SCHED; PG8_LDA(At, 0, 0); PG8_STAGE(PG8_SA(1, 1), a1 + hstepA, voffA);
            PG8_WAIT_L(8); PG8_BAR; PG8_WAIT_L(0); PG8_MMA(0, 0, At, B0); PG8_BAR; PG8_SCHED;
            PG8_LDB(B1, 0, 1); PG8_STAGE(PG8_SB(0, 0), b2, voffB);
            PG8_BAR; PG8_WAIT_L(0); PG8_MMA(0, 1, At, B1); PG8_BAR;
            PG8_LDA(At, 0, 1); PG8_STAGE(PG8_SA(0, 0), a2, voffA);
            PG8_BAR; PG8_WAIT_L(0); PG8_MMA(1, 0, At, B0); PG8_BAR; PG8_SCHED;
            PG8_STAGE(PG8_SB(0, 1), b2 + hstepB, voffB);
            PG8_WAIT_V(6); PG8_BAR; PG8_MMA(1, 1, At, B1); PG8_BAR;
            PG8_LDB(B0, 1, 0); PG8_SCHED; PG8_LDA(At, 1, 0); PG8_STAGE(PG8_SA(0, 1), a2 + hstepA, voffA);
            PG8_WAIT_L(8); PG8_BAR; PG8_WAIT_L(0); PG8_MMA(0, 0, At, B0); PG8_BAR; PG8_SCHED;
            PG8_LDB(B1, 1, 1); PG8_STAGE(PG8_SB(1, 0), b3, voffB);
            PG8_BAR; PG8_WAIT_L(0); PG8_MMA(0, 1, At, B1); PG8_BAR;
            PG8_LDA(At, 1, 1); PG8_STAGE(PG8_SA(1, 0), a3, voffA);
            PG8_BAR; PG8_WAIT_L(0); PG8_MMA(1, 0, At, B0); PG8_BAR; PG8_SCHED;
            PG8_STAGE(PG8_SB(1, 1), b3 + hstepB, voffB);
            PG8_WAIT_V(6); PG8_BAR; PG8_MMA(1, 1, At, B1); PG8_BAR;
            }
        }
        if constexpr (ALIGN_EPI) { if (wr == 0) PG8_BAR; }
        if constexpr (!Epi::AFTER_DRAIN) { E(acc, cur, wr, wc, fr, fq); S.done(cur); }
        if (!has_next) break;
#pragma unroll
        for (int a = 0; a < 2; ++a)
#pragma unroll
            for (int b = 0; b < 2; ++b)
#pragma unroll
                for (int m = 0; m < 4; ++m)
#pragma unroll
                    for (int n = 0; n < 2; ++n) acc[a][b][m][n] = (f32x4){0.f, 0.f, 0.f, 0.f};
        cur = nxt; cA = nA; cB = nB; ++ui;
        if constexpr (ALIGN_EPI) { if (wr == 1) PG8_BAR; }
    }
    PG8_WAIT_V(0);
    if constexpr (!ALIGN_EPI) { if (wr == 0) PG8_BAR; }
    PG8_BAR;
    if constexpr (Epi::AFTER_DRAIN) { E.fused(acc, cur, wr, wc, fr, fq, lds, wid, lane); S.done(cur); }
#undef PG8_SA
#undef PG8_SB
#undef PG8_STAGE
#undef PG8_LDA
#undef PG8_LDB
#undef PG8_MMA
#undef PG8_WAIT_V
#undef PG8_WAIT_L
#undef PG8_BAR
#undef PG8_SCHED
}
}

#include <hip/hip_bf16.h>
#include <cmath>
namespace attn_body {
using bf16=__hip_bfloat16;
using bf16x8=__attribute__((ext_vector_type(8)))short;
using s16x4=__attribute__((ext_vector_type(4)))short;
using f32x16=__attribute__((ext_vector_type(16)))float;
using u32x4=__attribute__((ext_vector_type(4)))unsigned;
constexpr int SEQ=4096,D=64,DM=6144,OP=2048;
constexpr int NW=8,QBLK=32,QB=QBLK*NW,KVBLK=64,NQB=SEQ/QB;
constexpr int ATTN_PITCH=DM, ATTN_UNIT_ROWS=QB;
__device__ __forceinline__ int crow(int r,int hi){return (r&3)+8*(r>>2)+4*hi;}
#define SBAR() __builtin_amdgcn_sched_barrier(0)
__device__ __forceinline__ void cmask(f32x16&p0,f32x16&p1,int jb,int qrel,int hi){
  const float NEG=-INFINITY;
  if(jb>(qrel>>6)){
  #pragma unroll
  for(int r=0;r<16;++r){p0[r]=NEG;p1[r]=NEG;}}
}

constexpr int NSLOT=3, SLOTB=8192;
constexpr int LDS_K=0, LDS_V=NSLOT*SLOTB, LDS_WS=2*NSLOT*SLOTB, LDS_OST=LDS_WS+NW*64*4, LDS_BYTES=LDS_OST+NW*4096;
constexpr float C2=0.125f*1.4426950408889634f;
__device__ __forceinline__ void glds16(const void*gsrc,unsigned lds_dst){unsigned keep;
  asm volatile("s_mov_b32 %0, m0\n\ts_mov_b32 m0, %2\n\ts_nop 0\n\tglobal_load_lds_dwordx4 %1, off\n\ts_mov_b32 m0, %0":"=&s"(keep):"v"(gsrc),"s"(lds_dst):"memory");}
__device__ __forceinline__ float max3f(float a,float b,float c){float r;asm("v_max3_f32 %0, %1, %2, %3":"=v"(r):"v"(a),"v"(b),"v"(c));return r;}
__device__ __forceinline__ float max2f(float a,float b){float r;asm("v_max_f32_e32 %0, %1, %2":"=v"(r):"v"(a),"v"(b));return r;}
__device__ __forceinline__ float fadd_s(float a,float b){float r;asm("v_add_f32_e32 %0, %1, %2":"=v"(r):"v"(a),"v"(b));return r;}
__device__ __forceinline__ float fsub_s(float a,float b){float r;asm("v_sub_f32_e32 %0, %1, %2":"=v"(r):"v"(a),"v"(b));return r;}
typedef float f32x2_t __attribute__((ext_vector_type(2))); typedef __bf16 bf16x2_t __attribute__((ext_vector_type(2)));
__device__ __forceinline__ unsigned cvtpk_s(float lo,float hi){f32x2_t v={lo,hi};bf16x2_t b=__builtin_convertvector(v,bf16x2_t);return __builtin_bit_cast(unsigned,b);}
#define WAIT_BAR(N) asm volatile("s_waitcnt vmcnt(" #N ") lgkmcnt(0)\n\ts_barrier":::"memory")

__device__ __forceinline__ void qkt(f32x16&p0,f32x16&p1,const char*Kslot,const bf16x8*qr,const f32x16&negm,int r32,int hi){
  const char*kb=Kslot+hi*1024+r32*16;
  #pragma unroll
  for(int d0=0;d0<4;++d0){
    const bf16x8 b0=*reinterpret_cast<const bf16x8*>(kb+d0*2048);
    const bf16x8 b1=*reinterpret_cast<const bf16x8*>(kb+d0*2048+512);
    if(d0==0){p0=__builtin_amdgcn_mfma_f32_32x32x16_bf16(b0,qr[0],negm,0,0,0);p1=__builtin_amdgcn_mfma_f32_32x32x16_bf16(b1,qr[0],negm,0,0,0);}
    else{p0=__builtin_amdgcn_mfma_f32_32x32x16_bf16(b0,qr[d0],p0,0,0,0);p1=__builtin_amdgcn_mfma_f32_32x32x16_bf16(b1,qr[d0],p1,0,0,0);}}
}
typedef __attribute__((address_space(3))) const char* lds_cptr;
typedef short v4i16_t __attribute__((ext_vector_type(4)));
__device__ __forceinline__ void kload8(bf16x8*kf,lds_cptr kp){
  kf[0]=*(const __attribute__((address_space(3))) bf16x8*)(kp);      kf[1]=*(const __attribute__((address_space(3))) bf16x8*)(kp+512);
  kf[2]=*(const __attribute__((address_space(3))) bf16x8*)(kp+2048); kf[3]=*(const __attribute__((address_space(3))) bf16x8*)(kp+2560);
  kf[4]=*(const __attribute__((address_space(3))) bf16x8*)(kp+4096); kf[5]=*(const __attribute__((address_space(3))) bf16x8*)(kp+4608);
  kf[6]=*(const __attribute__((address_space(3))) bf16x8*)(kp+6144); kf[7]=*(const __attribute__((address_space(3))) bf16x8*)(kp+6656);
}
__device__ __forceinline__ void kload2(bf16x8*kf,lds_cptr kp,int j){ kf[2*j]=*(const __attribute__((address_space(3))) bf16x8*)(kp+j*2048); kf[2*j+1]=*(const __attribute__((address_space(3))) bf16x8*)(kp+j*2048+512); }
__device__ __forceinline__ s16x4 vtr(lds_cptr p){ return __builtin_bit_cast(s16x4,__builtin_amdgcn_ds_read_tr16_b64_v4i16((__attribute__((address_space(3))) v4i16_t*)p)); }
__device__ __forceinline__ float rowmax(const f32x16&p0,const f32x16&p1){
  float a=max3f(p0[0],p0[1],p1[0]),b=max3f(p0[2],p0[3],p1[1]);a=max3f(a,p1[2],p1[3]);
  #pragma unroll
  for(int r=4;r<16;r+=4){a=max3f(a,p0[r],p0[r+1]);b=max3f(b,p0[r+2],p0[r+3]);a=max3f(a,p1[r],p1[r+1]);b=max3f(b,p1[r+2],p1[r+3]);}
  const float m=max2f(a,b);
  auto rr=__builtin_amdgcn_permlane32_swap(__float_as_uint(m),__float_as_uint(m),false,false);
  return max2f(__uint_as_float(rr[0]),__uint_as_float(rr[1]));
}
__device__ __forceinline__ void pv(f32x16*o,int vb,bf16x8 pa0,bf16x8 pa1,bf16x8 pa2,bf16x8 pa3){
  #pragma unroll
  for(int d0=0;d0<2;++d0){s16x4 lo[4],hi[4];
    #pragma unroll
    for(int ks=0;ks<4;++ks){
      asm volatile("ds_read_b64_tr_b16 %0,%1 offset:%c2":"=&v"(lo[ks]):"v"(vb),"i"(d0*4096+ks*1024):"memory");
      asm volatile("ds_read_b64_tr_b16 %0,%1 offset:%c2":"=&v"(hi[ks]):"v"(vb),"i"(d0*4096+ks*1024+512):"memory");}
    asm volatile("s_waitcnt lgkmcnt(0)":::"memory");SBAR();
    #define PK(k) (bf16x8){lo[k][0],lo[k][1],lo[k][2],lo[k][3],hi[k][0],hi[k][1],hi[k][2],hi[k][3]}
    o[d0]=__builtin_amdgcn_mfma_f32_32x32x16_bf16(pa0,PK(0),o[d0],0,0,0);
    o[d0]=__builtin_amdgcn_mfma_f32_32x32x16_bf16(pa1,PK(1),o[d0],0,0,0);
    o[d0]=__builtin_amdgcn_mfma_f32_32x32x16_bf16(pa2,PK(2),o[d0],0,0,0);
    o[d0]=__builtin_amdgcn_mfma_f32_32x32x16_bf16(pa3,PK(3),o[d0],0,0,0);
    #undef PK
  }
}

#ifndef ATTN_STORE16
#define ATTN_STORE16(p,v) (*(u32x4*)(p)=(v))
#endif
template<int THRL> __device__ __forceinline__ void attn_unit(int b,int h,int hv,int os,int qb,const bf16*Q,const bf16*__restrict__ K,const bf16*__restrict__ V,bf16*O,char*shm){
  int tid_=threadIdx.x; asm volatile("":"+v"(tid_)); const int tid=tid_,lane=tid&63,r32=lane&31,hi=lane>>5; const int wid=__builtin_amdgcn_readfirstlane(tid>>6);
  const long rowbase=(long)b*SEQ; const int q0=qb*QB;
  const bf16*Qw=Q+(rowbase+q0+wid*QBLK)*DM+h*D;
  const bf16*Kh=K+rowbase*DM+h*D,*Vh=V+rowbase*DM+hv*D;
  const unsigned lds0=(unsigned)(uintptr_t)shm;
  float*wsf=(float*)(shm+LDS_WS)+wid*64;
  const bf16*ksrc=Kh+(long)lane*DM+wid*8;
  const bf16*vsrc=Vh+(long)(16*(wid&3)+(lane>>2))*DM+(wid>>2)*32+(lane&3)*8;
  const unsigned kdst=lds0+LDS_K+wid*1024, vdst=lds0+LDS_V+wid*1024;
  #define DMA_K(t,slot) glds16(ksrc+(long)(t)*KVBLK*DM,(unsigned)__builtin_amdgcn_readfirstlane(kdst+(slot)))
  #define DMA_V(t,slot) glds16(vsrc+(long)(t)*KVBLK*DM,(unsigned)__builtin_amdgcn_readfirstlane(vdst+(slot)))
  const int vb0=(int)(lds0+LDS_V)+((lane>>4)&1)*32+(lane&3)*8+(4*hi+((lane&15)>>2))*64;
  const char*Kbase=shm+LDS_K; bf16x8 kf[8];
  const lds_cptr shm3=(lds_cptr)shm; const lds_cptr kp0=shm3+LDS_K+hi*1024+r32*16; const lds_cptr vp0=shm3+LDS_V+((lane>>4)&1)*32+(lane&3)*8+(4*hi+((lane&15)>>2))*64;
  const int NT=(q0+QB)/KVBLK;
  DMA_K(0,0);DMA_V(0,0);DMA_K(1,SLOTB);
  bf16x8 qr[4];
  #pragma unroll
  for(int d0=0;d0<4;++d0)qr[d0]=*reinterpret_cast<const bf16x8*>(&Qw[(long)r32*DM+d0*16+hi*8]);
  float mhat=0.f,l_reg=0.f;f32x16 o[2];o[0]=f32x16{};o[1]=f32x16{};f32x16 negm=f32x16{};asm volatile("":"+v"(negm));
  const int qrel=wid*QBLK+r32;
  #define CMASK(P0,P1,t) do{int jb_=(t)-(NT-4); if(jb_>=0)cmask(P0,P1,jb_,qrel,hi);}while(0)
  bool resc=false;
  #define START(P0,P1) do{ const float rm=rowmax(P0,P1); resc=false; \
    { const float dl=rm; mhat=fadd_s(mhat,dl); \
      _Pragma("unroll") for(int r=0;r<16;++r){P0[r]=fsub_s(P0[r],dl);P1[r]=fsub_s(P1[r],dl);} \
      _Pragma("unroll") for(int r=0;r<16;++r)negm[r]=-mhat; asm volatile("":"+v"(negm)); } \
    _Pragma("unroll") for(int r=0;r<16;++r)P0[r]=__builtin_amdgcn_exp2f(P0[r]); }while(0)
  #define RESC() do{ if(resc){ asm volatile("s_waitcnt lgkmcnt(0)":::"memory"); \
      _Pragma("unroll") for(int d_=0;d_<2;++d_) _Pragma("unroll") for(int r=0;r<16;++r)o[d_][r]*=wsf[crow(r,hi)]; } }while(0)
  f32x16 pA0,pA1,pB0,pB1;
  int sl_prev=0,sl_cur=0,sl_next=SLOTB;
  #define ROT() do{sl_prev=sl_cur;sl_cur=sl_next;sl_next=(sl_next==(NSLOT-1)*SLOTB)?0:sl_next+SLOTB;}while(0)
  DMA_K(2,2*SLOTB);
  WAIT_BAR(3);
  qkt(pA0,pA1,Kbase,qr,negm,r32,hi);asm volatile("s_nop 15\n\ts_nop 7":"+v"(pA0),"+v"(pA1));CMASK(pA0,pA1,0);
  START(pA0,pA1);
  _Pragma("unroll") for(int r=0;r<16;++r)pA1[r]=__builtin_amdgcn_exp2f(pA1[r]);
  WAIT_BAR(0);
  DMA_K(3,0);DMA_V(1,SLOTB);
  ROT();
  kload8(kf,kp0+sl_cur);
  WAIT_BAR(2);
  s16x4 vlo[8],vhi[8]; u32x4 pw0,pw1,pw2,pw3;
  #define PKW(P,B) cvtpk_s(P[B],P[B+1])
  #define PAF(k) __builtin_bit_cast(bf16x8,pw##k)
  #define VFR(i) (bf16x8){vlo[i][0],vlo[i][1],vlo[i][2],vlo[i][3],vhi[i][0],vhi[i][1],vhi[i][2],vhi[i][3]}
  #define PIN(x) asm volatile("":"+v"(x))
  #define MX3(a,b,c) __builtin_fmaxf(__builtin_fmaxf((a),(b)),(c))
  #define GAPA(MF,A0,A1,A2,A3,W0,W1,PW) do{ MF; sacc+=A0; sacc+=A1; sacc+=A2; sacc+=A3; PIN(sacc); W0; W1; PIN(PW); SBAR(); }while(0)
  #define EX(v) __builtin_amdgcn_exp2f(v)
  #define GAPB(MF,X,B) do{ MF; X[B]=EX(X[B]); X[B+1]=EX(X[B+1]); X[B+2]=EX(X[B+2]); X[B+3]=EX(X[B+3]); PIN(X); SBAR(); }while(0)
  #define VRD(i) do{ vlo[i]=vtr(vp_+(((i)>>2)*4096+((i)&3)*1024)); vhi[i]=vtr(vp_+(((i)>>2)*4096+((i)&3)*1024+512)); }while(0)
  #define KRD(G,j) do{ if(G){ kload2(kf,kp0+sl_next,j); SBAR(); } }while(0)
  #define STEP(C0,C1,P0,P1,t,GK,GV,GL) do{ SBAR(); \
    const lds_cptr vp_=vp0+sl_prev; \
    VRD(0); SBAR(); float sacc=(P0[0]+P0[1]); \
    GAPA(C0=__builtin_amdgcn_mfma_f32_32x32x16_bf16(kf[0],qr[0],negm,0,0,0), P0[2],P0[3],P0[4],P0[5],     pw0[0]=PKW(P0,0), pw0[1]=PKW(P0,2), pw0); \
    VRD(4); SBAR(); GAPA(C1=__builtin_amdgcn_mfma_f32_32x32x16_bf16(kf[1],qr[0],negm,0,0,0), P0[6],P0[7],P0[8],P0[9],     pw0[2]=PKW(P0,4), pw0[3]=PKW(P0,6), pw0); \
    VRD(1); SBAR(); GAPA(C0=__builtin_amdgcn_mfma_f32_32x32x16_bf16(kf[2],qr[1],C0,0,0,0),   P0[10],P0[11],P0[12],P0[13], pw1[0]=PKW(P0,8), pw1[1]=PKW(P0,10), pw1); \
    VRD(5); SBAR(); GAPA(C1=__builtin_amdgcn_mfma_f32_32x32x16_bf16(kf[3],qr[1],C1,0,0,0),   P0[14],P0[15],P1[0],P1[1],   pw1[2]=PKW(P0,12),pw1[3]=PKW(P0,14), pw1); \
    VRD(2); SBAR(); GAPA(C0=__builtin_amdgcn_mfma_f32_32x32x16_bf16(kf[4],qr[2],C0,0,0,0),   P1[2],P1[3],P1[4],P1[5],     pw2[0]=PKW(P1,0), pw2[1]=PKW(P1,2), pw2); \
    VRD(6); SBAR(); GAPA(C1=__builtin_amdgcn_mfma_f32_32x32x16_bf16(kf[5],qr[2],C1,0,0,0),   P1[6],P1[7],P1[8],P1[9],     pw2[2]=PKW(P1,4), pw2[3]=PKW(P1,6), pw2); \
    VRD(3); SBAR(); GAPA(C0=__builtin_amdgcn_mfma_f32_32x32x16_bf16(kf[6],qr[3],C0,0,0,0),   P1[10],P1[11],P1[12],P1[13], pw3[0]=PKW(P1,8), pw3[1]=PKW(P1,10), pw3); \
    VRD(7); SBAR(); GAPA(C1=__builtin_amdgcn_mfma_f32_32x32x16_bf16(kf[7],qr[3],C1,0,0,0),   P1[14],P1[15],0.f,0.f,       pw3[2]=PKW(P1,12),pw3[3]=PKW(P1,14), pw3); \
    l_reg+=sacc; \
    if(GK){DMA_K((t)+3,sl_cur);} if(GV){DMA_V((t)+1,sl_next);} \
    CMASK(C0,C1,t); \
    { float a=MX3(C0[0],C0[1],C1[0]),b=MX3(C0[2],C0[3],C1[1]); a=MX3(a,C1[2],C1[3]); \
      _Pragma("unroll") for(int r=4;r<16;r+=4){a=MX3(a,C0[r],C0[r+1]);b=MX3(b,C0[r+2],C0[r+3]);a=MX3(a,C1[r],C1[r+1]);b=MX3(b,C1[r+2],C1[r+3]);} \
      float rm=__builtin_fmaxf(a,b); { auto rr=__builtin_amdgcn_permlane32_swap(__float_as_uint(rm),__float_as_uint(rm),false,false); rm=__builtin_fmaxf(__uint_as_float(rr[0]),__uint_as_float(rr[1])); } \
      resc=false; \
      if(__builtin_expect(__any(rm>(float)THRL),0)){ const float dl=__builtin_fmaxf(rm,0.f); mhat+=dl; \
        _Pragma("unroll") for(int r=0;r<16;++r){C0[r]-=dl;C1[r]-=dl;} \
        _Pragma("unroll") for(int r=0;r<16;++r)negm[r]=-mhat; asm volatile("":"+v"(negm)); \
        const float f=__builtin_amdgcn_exp2f(-dl); l_reg*=f; if(hi==0)wsf[r32]=f; resc=true; } } \
    SBAR(); \
    GAPB(o[0]=__builtin_amdgcn_mfma_f32_32x32x16_bf16(PAF(0),VFR(0),o[0],0,0,0), C0,0); \
    GAPB(o[1]=__builtin_amdgcn_mfma_f32_32x32x16_bf16(PAF(0),VFR(4),o[1],0,0,0), C0,4); \
    KRD(GL,0); GAPB(o[0]=__builtin_amdgcn_mfma_f32_32x32x16_bf16(PAF(1),VFR(1),o[0],0,0,0), C0,8); \
    KRD(GL,1); GAPB(o[1]=__builtin_amdgcn_mfma_f32_32x32x16_bf16(PAF(1),VFR(5),o[1],0,0,0), C0,12); \
    KRD(GL,2); GAPB(o[0]=__builtin_amdgcn_mfma_f32_32x32x16_bf16(PAF(2),VFR(2),o[0],0,0,0), C1,0); \
    KRD(GL,3); GAPB(o[1]=__builtin_amdgcn_mfma_f32_32x32x16_bf16(PAF(2),VFR(6),o[1],0,0,0), C1,4); \
    GAPB(o[0]=__builtin_amdgcn_mfma_f32_32x32x16_bf16(PAF(3),VFR(3),o[0],0,0,0), C1,8); \
    GAPB(o[1]=__builtin_amdgcn_mfma_f32_32x32x16_bf16(PAF(3),VFR(7),o[1],0,0,0), C1,12); \
    }while(0)
  int t=1;
  #undef CMASK
  #define CMASK(P0,P1,t) do{}while(0)
  for(;t+5<NT;t+=2){
    STEP(pB0,pB1,pA0,pA1,t,true,true,true);     WAIT_BAR(2); RESC(); ROT();
    STEP(pA0,pA1,pB0,pB1,t+1,true,true,true);   WAIT_BAR(2); RESC(); ROT();
  }
  #undef CMASK
  #define CMASK(P0,P1,t) do{int jb_=(t)-(NT-4); if(jb_>=0)cmask(P0,P1,jb_,qrel,hi);}while(0)
  #define ENDW(tt) do{ if((tt)+3<NT){WAIT_BAR(2);} else if((tt)+2<NT){WAIT_BAR(1);} else {WAIT_BAR(0);} }while(0)
  for(;t+1<NT;t+=2){
    STEP(pB0,pB1,pA0,pA1,t,(t+3<NT),(t+1<NT),(t+1<NT));       ENDW(t);   RESC(); ROT();
    STEP(pA0,pA1,pB0,pB1,t+1,(t+4<NT),(t+2<NT),(t+2<NT));     ENDW(t+1); RESC(); ROT();
  }
  STEP(pB0,pB1,pA0,pA1,NT-1,false,false,false); RESC();
  { float sacc=pB0[0]+pB0[1]; _Pragma("unroll") for(int r=2;r<16;++r)sacc+=pB0[r]; _Pragma("unroll") for(int r=0;r<16;++r)sacc+=pB1[r]; l_reg+=sacc;
    pw0=(u32x4){PKW(pB0,0),PKW(pB0,2),PKW(pB0,4),PKW(pB0,6)};pw1=(u32x4){PKW(pB0,8),PKW(pB0,10),PKW(pB0,12),PKW(pB0,14)};pw2=(u32x4){PKW(pB1,0),PKW(pB1,2),PKW(pB1,4),PKW(pB1,6)};pw3=(u32x4){PKW(pB1,8),PKW(pB1,10),PKW(pB1,12),PKW(pB1,14)};
    SBAR(); pv(o,vb0+sl_cur,PAF(0),PAF(1),PAF(2),PAF(3)); }
  #undef PKW
  #undef PAF
  #undef VFR
  #undef PIN
  #undef MX3
  #undef GAPA
  #undef GAPB
  #undef EX
  #undef VRD
  #undef KRD
  #undef STEP
  #undef ENDW
  {auto rr=__builtin_amdgcn_permlane32_swap(__float_as_uint(l_reg),__float_as_uint(l_reg),false,false);l_reg=__uint_as_float(rr[0])+__uint_as_float(rr[1]);}
  if(hi==0)wsf[32+r32]=l_reg;asm volatile("s_waitcnt lgkmcnt(0)":::"memory");
  float rli[16];
  #pragma unroll
  for(int r=0;r<16;++r)rli[r]=__builtin_amdgcn_rcpf(wsf[32+crow(r,hi)]);
  bf16*Ow=O+(rowbase+q0+wid*QBLK)*OP+os*D;
  { bf16*stg=(bf16*)(shm+LDS_OST)+wid*2048;
    #pragma unroll
    for(int r=0;r<16;++r){const int orow=crow(r,hi);
      #pragma unroll
      for(int d0=0;d0<2;++d0)stg[orow*64+d0*32+r32]=__float2bfloat16(o[d0][r]*rli[r]);}
    asm volatile("s_waitcnt lgkmcnt(0)":::"memory");
    #pragma unroll
    for(int i=0;i<4;++i){const int row=i*8+(lane>>3),ch=lane&7; const u32x4 v=*(const u32x4*)(stg+row*64+ch*8); ATTN_STORE16(Ow+(long)row*OP+ch*8,v);} }
  asm volatile("s_waitcnt lgkmcnt(0)\n\ts_barrier":::"memory");
  #undef DMA_K
  #undef DMA_V
  #undef CMASK
  #undef START
  #undef RESC
  #undef ROT
}
constexpr int ATTN_LDS_BYTES=LDS_BYTES;
#undef SBAR
#undef WAIT_BAR
}


constexpr int NB = 16, T = 4096, D = 1024, M = NB * T, INW = 6144, FF = 2816, NG = 64, NP = 64;
constexpr float LN_EPS = 1e-5f, RMS_EPS = 1e-5f;
constexpr float DN_ALPHA = 1.189207115002721f;
constexpr float LAMBDA_INIT = 0.2f;
constexpr int NWAVES = 8, NTHREADS = 512;
constexpr size_t MiB = 1u << 20;
constexpr size_t WS_MODP = 0;
constexpr size_t WS_MOD = 6 * MiB;
constexpr size_t WS_WIN = 8 * MiB, WS_WGLU = 20 * MiB, WS_WBS = 22 * MiB, WS_WBA = 24 * MiB, WS_WOUT = 26 * MiB, WS_WUP = 28 * MiB, WS_WDOWN = 40 * MiB;
constexpr size_t WS_PROJ = 64 * MiB;
constexpr size_t WS_HB = 832 * MiB;
constexpr size_t WS_END = 960 * MiB;
constexpr int LDS_BYTES = 147456;
constexpr size_t WS_CTL = 7 * MiB, CTL_ZERO_BYTES = 64 * 1024;
constexpr int CW_BAR = 1024, CW_QUEUE = 8192;
constexpr int LDSCTL_OFF = 131072, MISC_OFF = LDSCTL_OFF + 320;

#define GAS __attribute__((address_space(1)))
#define LAS __attribute__((address_space(3)))
typedef unsigned short bf16;
typedef unsigned v4u __attribute__((ext_vector_type(4)));
typedef unsigned v2u __attribute__((ext_vector_type(2)));
typedef float f32x4 __attribute__((ext_vector_type(4)));
typedef float f32x16 __attribute__((ext_vector_type(16)));
typedef short bf16x8 __attribute__((ext_vector_type(8)));
#define LDS_WAIT() asm volatile("s_waitcnt lgkmcnt(0)" ::: "memory")
__device__ __forceinline__ unsigned f2bf(float f) { unsigned u = __builtin_bit_cast(unsigned, f); return (u + 0x7fffu + ((u >> 16) & 1u)) >> 16; }
typedef float f32x2_t __attribute__((ext_vector_type(2))); typedef __bf16 bf16x2_t __attribute__((ext_vector_type(2)));
__device__ __forceinline__ unsigned pk2(float lo, float hi) { f32x2_t v = {lo, hi}; bf16x2_t b = __builtin_convertvector(v, bf16x2_t); return __builtin_bit_cast(unsigned, b); }
__device__ __forceinline__ float bfl(unsigned u) { return __uint_as_float(u << 16); }
__device__ __forceinline__ float bfh(unsigned u) { return __uint_as_float(u & 0xffff0000u); }
__device__ __forceinline__ float wave_sum(float v) {
#pragma unroll
    for (int o = 1; o < 64; o <<= 1) v += __shfl_xor(v, o);
    return v;
}
__device__ __forceinline__ float sigm(float x) { return 1.0f / (1.0f + __expf(-x)); }

struct Args { const float* in[31]; float* out; unsigned char* ws; };
typedef const Args __attribute__((address_space(4)))* KArgs;
__device__ __forceinline__ KArgs kargs() { unsigned long long p = (unsigned long long)__builtin_amdgcn_kernarg_segment_ptr(); asm volatile("" : "+s"(p)); return (KArgs)p; }

typedef GAS unsigned gu32;
#define XB_TMO      128
#define XB_XCNT(j)  (256  + 64 * (j))
#define XB_XSUB(j)  (1280 + 64 * (j))
#define XB_XGEN(j)  (2304 + 64 * (j))
#define XB_TOP      3328
#define XB_TOPGEN   3392
#define XCD_BAR_WORDS 3456
#define XB_SPIN_CAP (1u << 18)

__device__ __forceinline__ unsigned xb_ld(unsigned* p)              { return __hip_atomic_load(p, __ATOMIC_RELAXED, __HIP_MEMORY_SCOPE_AGENT); }
__device__ __forceinline__ unsigned xb_add(unsigned* p, unsigned v) { return __hip_atomic_fetch_add(p, v, __ATOMIC_RELAXED, __HIP_MEMORY_SCOPE_AGENT); }
__device__ __forceinline__ unsigned xb_xcc_id() { return (unsigned)__builtin_amdgcn_s_getreg((3 << 11) | 20) & 0xFu; }
#define XB_SPIN(cond, bar) do { unsigned _sp = 0; while (cond) { __builtin_amdgcn_s_sleep(1); \
    if ((++_sp & 255u) == 0u) { if (xb_ld(&(bar)[XB_TMO])) break; if (_sp > XB_SPIN_CAP) { atomicAdd(&(bar)[XB_TMO], 1u); break; } } } } while (0)

struct XcdBarrier {
    unsigned* bar; unsigned x;
    volatile LAS unsigned* st;
};

__device__ __forceinline__ XcdBarrier xcd_barrier_post(unsigned* bar, volatile LAS unsigned* st) {
    XcdBarrier b; b.bar = bar; b.x = xb_xcc_id(); b.st = st;
    if (threadIdx.x == 0) (void)xb_add(&bar[XB_XCNT(b.x)], 1u);
    return b;
}
__device__ __forceinline__ void xcd_barrier_complete(unsigned* bar, unsigned x, unsigned& nloc, unsigned& nx) {
    const unsigned G = gridDim.x * gridDim.y * gridDim.z;
    unsigned sum, cnt, mine, sp = 0u;
    for (;;) {
        sum = 0u; cnt = 0u; mine = 0u;
#pragma unroll
        for (unsigned j = 0; j < 16; ++j) { const unsigned c = xb_ld(&bar[XB_XCNT(j)]); sum += c; cnt += (c > 0u) ? 1u : 0u; mine = (j == x) ? c : mine; }
        if (sum == G) break;
        __builtin_amdgcn_s_sleep(1);
        if ((++sp & 255u) == 0u) { if (xb_ld(&bar[XB_TMO])) break; if (sp > XB_SPIN_CAP) { atomicAdd(&bar[XB_TMO], 1u); break; } }
    }
    nloc = mine > 0u ? mine : 1u; nx = cnt > 0u ? cnt : 1u;
}

__device__ __forceinline__ void xcd_barrier(const XcdBarrier& b) {
    asm volatile("s_waitcnt vmcnt(0)" ::: "memory");
    __syncthreads();
    if (threadIdx.x == 0) {
        unsigned* bar = b.bar;
        __builtin_amdgcn_s_waitcnt(0);
        unsigned nloc = b.st[0], nx = b.st[1];
        if (nloc == 0u) { xcd_barrier_complete(bar, b.x, nloc, nx); b.st[0] = nloc; b.st[1] = nx; }
        const unsigned old = xb_add(&bar[XB_XSUB(b.x)], 1u);
        const unsigned gen = old / nloc;
        if (old + 1u == (gen + 1u) * nloc) {
            __builtin_amdgcn_fence(__ATOMIC_RELEASE, "agent");
            asm volatile("s_waitcnt vmcnt(0)" ::: "memory");
            const unsigned og = xb_add(&bar[XB_TOP], 1u);
            const unsigned tg = og / nx;
            if (og + 1u == (tg + 1u) * nx) xb_add(&bar[XB_TOPGEN], 1u);
            else XB_SPIN(xb_ld(&bar[XB_TOPGEN]) == tg, bar);
            __builtin_amdgcn_fence(__ATOMIC_ACQUIRE, "agent");
            xb_add(&bar[XB_XGEN(b.x)], 1u);
            asm volatile("s_waitcnt vmcnt(0)" ::: "memory");
        } else {
            XB_SPIN(xb_ld(&bar[XB_XGEN(b.x)]) == gen, bar);
            __builtin_amdgcn_fence(__ATOMIC_ACQUIRE, "agent");
            asm volatile("s_waitcnt vmcnt(0)" ::: "memory");
        }
    }
    __syncthreads();
}


template <bool UPPERM = false> __device__ __forceinline__ void p0_transpose_item(const float* W, int K, int N, bf16* WT, LAS float* scr, int item, int lane) {
    const int nblk = N / 32, kb = item / nblk, nb = item % nblk, k0 = 64 * kb, n0 = 32 * nb;
#pragma unroll 8
    for (int i = 0; i < 32; ++i) { const int kk = 2 * i + (lane >> 5); scr[kk * 33 + (lane & 31)] = W[(size_t)(k0 + kk) * N + n0 + (lane & 31)]; }
    LDS_WAIT(); asm volatile("" ::: "memory");
    const int c = lane & 7;
#pragma unroll
    for (int j = 0; j < 4; ++j) { const int n = (lane >> 3) + 8 * j; const LAS float* s = scr + (8 * c) * 33 + n;
        v4u o; o.x = pk2(s[0 * 33], s[1 * 33]); o.y = pk2(s[2 * 33], s[3 * 33]); o.z = pk2(s[4 * 33], s[5 * 33]); o.w = pk2(s[6 * 33], s[7 * 33]);
        int dr = n0 + n; if (UPPERM) { const int f = dr >= FF ? dr - FF : dr; dr = 8 * (f >> 2) + (dr >= FF ? 4 : 0) + (f & 3); }
        *(v4u*)(WT + (size_t)dr * K + k0 + 8 * c) = o; }
    LDS_WAIT(); asm volatile("" ::: "memory");
}

__device__ __forceinline__ void p0_mod_item(const float* c, const float* w_mod, const float* b_mod, float* part, int item, int lane) {
    const int cgp = item % 96, ks = item / 96, col = cgp * 64 + lane;
    float acc[16];
#pragma unroll
    for (int b = 0; b < 16; ++b) acc[b] = 0.f;
    for (int kk = 0; kk < 64; ++kk) {
        const int k = ks * 64 + kk;
        const float w = w_mod[(size_t)k * INW + col];
#pragma unroll
        for (int b = 0; b < 16; ++b) { const float cv = c[b * D + k]; acc[b] += (cv * sigm(cv)) * w; }
    }
    const float bm = (ks == 0) ? b_mod[col] : 0.f;
#pragma unroll
    for (int b = 0; b < 16; ++b) part[((size_t)ks * 16 + b) * INW + col] = acc[b] + bm;
}


__device__ __forceinline__ void ldrow(const float* p, int lane, f32x4 (&v)[4]) { const f32x4* xr = (const f32x4*)p + lane;
#pragma unroll
    for (int j = 0; j < 4; ++j) v[j] = xr[64 * j]; }
__device__ __forceinline__ void row_stats2(const f32x4 (&a)[4], const f32x4 (&b)[4], float& ma, float& ra, float& mb, float& rb) {
    float sa = 0.f, qa = 0.f, sb = 0.f, qb = 0.f;
#pragma unroll
    for (int j = 0; j < 4; ++j) { sa += (a[j].x + a[j].y) + (a[j].z + a[j].w); qa += (a[j].x * a[j].x + a[j].y * a[j].y) + (a[j].z * a[j].z + a[j].w * a[j].w);
                                  sb += (b[j].x + b[j].y) + (b[j].z + b[j].w); qb += (b[j].x * b[j].x + b[j].y * b[j].y) + (b[j].z * b[j].z + b[j].w * b[j].w); }
#pragma unroll
    for (int o = 1; o < 64; o <<= 1) { sa += __shfl_xor(sa, o); qa += __shfl_xor(qa, o); sb += __shfl_xor(sb, o); qb += __shfl_xor(qb, o); }
    ma = sa * (1.f / D); mb = sb * (1.f / D);
    ra = 1.f / sqrtf(fmaxf(qa * (1.f / D) - ma * ma, 0.f) + LN_EPS); rb = 1.f / sqrtf(fmaxf(qb * (1.f / D) - mb * mb, 0.f) + LN_EPS);
}
__device__ __forceinline__ void st_bf16row(bf16* orow, int lane, const f32x4 (&y)[4]) { v2u* o8 = (v2u*)orow + lane;
#pragma unroll
    for (int j = 0; j < 4; ++j) { v2u w; w.x = pk2(y[j].x, y[j].y); w.y = pk2(y[j].z, y[j].w); o8[64 * j] = w; } }
template <int MODE> __device__ __forceinline__ void ln_pass(const float* src, float* dstf, bf16* dsth, const float* g, const float* bta, const float* mod, int sh_off, int sc_off, int gw, int NGW, int lane) {
    f32x4 ca[4], cb[4], na[4], nb[4];
    int m = gw;
    if (m < M) { ldrow(src + (size_t)m * D, lane, ca); ldrow(src + (size_t)(m + NGW) * D, lane, cb); }
    for (; m < M; m += 2 * NGW) {
        const int mn = m + 2 * NGW;
        if (mn < M) { ldrow(src + (size_t)mn * D, lane, na); ldrow(src + (size_t)(mn + NGW) * D, lane, nb); }
        float ma, ra, mb, rb; row_stats2(ca, cb, ma, ra, mb, rb);
        if (MODE == 0) {
            const float* moda = mod + (size_t)(m >> 12) * INW; const float* modb = mod + (size_t)((m + NGW) >> 12) * INW;
#pragma unroll
            for (int j = 0; j < 4; ++j) { const f32x4 sca = ((const f32x4*)(moda + sc_off))[lane + 64 * j], sha = ((const f32x4*)(moda + sh_off))[lane + 64 * j];
                                          const f32x4 scb = ((const f32x4*)(modb + sc_off))[lane + 64 * j], shb = ((const f32x4*)(modb + sh_off))[lane + 64 * j];
                ca[j] = (ca[j] - ma) * ra * (sca + 1.0f) + sha; cb[j] = (cb[j] - mb) * rb * (scb + 1.0f) + shb; }
            st_bf16row(dsth + (size_t)m * D, lane, ca); st_bf16row(dsth + (size_t)(m + NGW) * D, lane, cb);
        } else {
#pragma unroll
            for (int j = 0; j < 4; ++j) { const f32x4 gg = ((const f32x4*)g)[lane + 64 * j], bb = ((const f32x4*)bta)[lane + 64 * j];
                ca[j] = (ca[j] - ma) * ra * gg + bb; cb[j] = (cb[j] - mb) * rb * gg + bb;
                ((f32x4*)(dstf + (size_t)m * D))[lane + 64 * j] = ca[j]; ((f32x4*)(dstf + (size_t)(m + NGW) * D))[lane + 64 * j] = cb[j]; }
            if (MODE == 1) {
                row_stats2(ca, cb, ma, ra, mb, rb);
                const float* moda = mod + (size_t)(m >> 12) * INW; const float* modb = mod + (size_t)((m + NGW) >> 12) * INW;
#pragma unroll
                for (int j = 0; j < 4; ++j) { const f32x4 sca = ((const f32x4*)(moda + sc_off))[lane + 64 * j], sha = ((const f32x4*)(moda + sh_off))[lane + 64 * j];
                                              const f32x4 scb = ((const f32x4*)(modb + sc_off))[lane + 64 * j], shb = ((const f32x4*)(modb + sh_off))[lane + 64 * j];
                    ca[j] = (ca[j] - ma) * ra * (sca + 1.0f) + sha; cb[j] = (cb[j] - mb) * rb * (scb + 1.0f) + shb; }
                st_bf16row(dsth + (size_t)m * D, lane, ca); st_bf16row(dsth + (size_t)(m + NGW) * D, lane, cb);
            }
        }
#pragma unroll
        for (int j = 0; j < 4; ++j) { ca[j] = na[j]; cb[j] = nb[j]; }
    }
}

__device__ __forceinline__ float gelu_tanh(float x) {
    const float u = 0.7978845608028654f * (x + 0.044715f * x * x * x);
    return x * __builtin_amdgcn_rcpf(1.0f + __expf(-2.0f * u));
}
__device__ __forceinline__ bf16x8 pack8(const float (&f)[8]) {
    v4u w; w.x = pk2(f[0], f[1]); w.y = pk2(f[2], f[3]); w.z = pk2(f[4], f[5]); w.w = pk2(f[6], f[7]); return __builtin_bit_cast(bf16x8, w);
}

__device__ __forceinline__ void ssm_item(KArgs a, int g, int bp, LAS unsigned char* wl, int lane) {
    const float* lam_re = a->in[5]; const float* lam_im = a->in[6]; const float* log_dt = a->in[7];
    const float* b_re = a->in[8]; const float* b_im = a->in[9]; const float* c_re = a->in[10]; const float* c_im = a->in[11]; const float* dsk = a->in[12];
    const bf16* proj = (const bf16*)(a->ws + WS_PROJ); bf16* zb = (bf16*)(a->ws + WS_HB);
    const int r = lane & 31, h = lane >> 5;
    const float dt = expf(log_dt[g]);
    float are[2], aim[2];
    bf16x8 bfr[4];
#pragma unroll
    for (int i = 0; i < 2; ++i) {
        const int p = r + 32 * i; const float lr = lam_re[g * NP + p], li = lam_im[g * NP + p];
        const float mag = expf(lr * dt), ar = mag * cosf(li * dt), ai = mag * sinf(li * dt);
        const float den = lr * lr + li * li, nr = ar - 1.0f, ni = ai;
        const float cr = (nr * lr + ni * li) / den, ci = (ni * lr - nr * li) / den;
        are[i] = ar; aim[i] = ai;
        const float* br = b_re + ((size_t)(g * NP + p)) * 16 + 8 * h; const float* bi = b_im + ((size_t)(g * NP + p)) * 16 + 8 * h;
        float fre[8], fim[8];
#pragma unroll
        for (int j = 0; j < 8; ++j) { fre[j] = cr * br[j] - ci * bi[j]; fim[j] = cr * bi[j] + ci * br[j]; }
        bfr[i] = pack8(fre); bfr[2 + i] = pack8(fim);
    }
    const int cch = lane & 15, kg = lane >> 4;
    bf16x8 cfr[4], dfr;
#pragma unroll
    for (int s = 0; s < 4; ++s) {
        const int p0 = 8 * s + 2 * kg; const float* cr = c_re + ((size_t)(g * 16 + cch)) * NP; const float* ci = c_im + ((size_t)(g * 16 + cch)) * NP;
        float f[8] = {cr[p0], -ci[p0], cr[p0 + 32], -ci[p0 + 32], cr[p0 + 1], -ci[p0 + 1], cr[p0 + 33], -ci[p0 + 33]};
        cfr[s] = pack8(f);
    }
    { float f[8];
#pragma unroll
      for (int j = 0; j < 8; ++j) f[j] = (kg < 2 && (8 * kg + j) == cch) ? dsk[g * 16 + cch] : 0.f;
      dfr = pack8(f); }
    const int b0 = 2 * bp;
    const int beta_r = (r >> 2) & 1, tok_r = 4 * (r >> 3) + (r & 3);
    const bf16* ua = proj + ((size_t)(b0 + beta_r) * T + tok_r) * INW + g * 16 + 8 * h;
    const bf16* ud = proj + ((size_t)b0 * T + cch) * INW + g * 16 + 8 * (kg & 1);
    bf16* zo = zb + ((size_t)b0 * T + 4 * kg) * D + g * 16 + cch;
    float sr[2] = {0.f, 0.f}, si[2] = {0.f, 0.f};
    LAS unsigned char* wrow = wl + (16 * h) * 272 + 8 * r;
    const LAS unsigned char* rrow = wl + cch * 272 + 16 * kg;
    bf16x8 af = *(const bf16x8*)(ua);
    for (int t0 = 0; t0 < T; t0 += 16) {
        const bf16x8 afc = af;
        if (t0 + 16 < T) af = *(const bf16x8*)(ua + (size_t)(t0 + 16) * INW);
        bf16x8 u0 = {0, 0, 0, 0, 0, 0, 0, 0}, u1 = {0, 0, 0, 0, 0, 0, 0, 0};
        if (kg < 2) { u0 = *(const bf16x8*)(ud + (size_t)t0 * INW); u1 = *(const bf16x8*)(ud + (size_t)(T + t0) * INW); }
        const f32x16 zz = {0.f, 0.f, 0.f, 0.f, 0.f, 0.f, 0.f, 0.f, 0.f, 0.f, 0.f, 0.f, 0.f, 0.f, 0.f, 0.f};
        const f32x16 bre0 = __builtin_amdgcn_mfma_f32_32x32x16_bf16(afc, bfr[0], zz, 0, 0, 0);
        const f32x16 bre1 = __builtin_amdgcn_mfma_f32_32x32x16_bf16(afc, bfr[1], zz, 0, 0, 0);
        const f32x16 bim0 = __builtin_amdgcn_mfma_f32_32x32x16_bf16(afc, bfr[2], zz, 0, 0, 0);
        const f32x16 bim1 = __builtin_amdgcn_mfma_f32_32x32x16_bf16(afc, bfr[3], zz, 0, 0, 0);
#pragma unroll
        for (int t = 0; t < 16; ++t) {
            const float nr0 = are[0] * sr[0] - aim[0] * si[0] + bre0[t], ni0 = are[0] * si[0] + aim[0] * sr[0] + bim0[t];
            const float nr1 = are[1] * sr[1] - aim[1] * si[1] + bre1[t], ni1 = are[1] * si[1] + aim[1] * sr[1] + bim1[t];
            sr[0] = nr0; si[0] = ni0; sr[1] = nr1; si[1] = ni1;
            v2u w; w.x = pk2(nr0, ni0); w.y = pk2(nr1, ni1);
            *(LAS v2u*)(wrow + t * 272) = w;
        }
        LDS_WAIT(); asm volatile("" ::: "memory");
#pragma unroll
        for (int be = 0; be < 2; ++be) {
            f32x4 y = {0.f, 0.f, 0.f, 0.f};
#pragma unroll
            for (int s = 0; s < 4; ++s) { const bf16x8 sa = *(const LAS bf16x8*)(rrow + be * 16 * 272 + 64 * s); y = __builtin_amdgcn_mfma_f32_16x16x32_bf16(sa, cfr[s], y, 0, 0, 0); }
            y = __builtin_amdgcn_mfma_f32_16x16x32_bf16(be ? u1 : u0, dfr, y, 0, 0, 0);
#pragma unroll
            for (int q = 0; q < 4; ++q) zo[((size_t)be * T + t0 + q) * D] = (bf16)pk2(gelu_tanh(y[q]), 0.f);
        }
        LDS_WAIT(); asm volatile("" ::: "memory");
    }
}

struct YRow { v4u a0, a1, b0, b1; };
__device__ __forceinline__ void yatt_load(const bf16* orow, int lane, YRow& r) {
    const int hh = lane >> 3, e0 = (lane & 7) * 16;
    const bf16* p1 = orow + (4 * hh + (e0 >> 6)) * 64 + (e0 & 63);
    r.a0 = *(const v4u*)(p1); r.a1 = *(const v4u*)(p1 + 8); r.b0 = *(const v4u*)(p1 + 128); r.b1 = *(const v4u*)(p1 + 136);
}
__device__ __forceinline__ void yatt_fin(const YRow& r, bf16* yrow, const float (&sg)[16], float lam, int lane) {
    const int hh = lane >> 3, e0 = (lane & 7) * 16;
    float o[16];
#pragma unroll
    for (int i = 0; i < 2; ++i) { const v4u a = i ? r.a1 : r.a0, b = i ? r.b1 : r.b0;
        o[8 * i + 0] = bfl(a.x) - lam * bfl(b.x); o[8 * i + 1] = bfh(a.x) - lam * bfh(b.x); o[8 * i + 2] = bfl(a.y) - lam * bfl(b.y); o[8 * i + 3] = bfh(a.y) - lam * bfh(b.y);
        o[8 * i + 4] = bfl(a.z) - lam * bfl(b.z); o[8 * i + 5] = bfh(a.z) - lam * bfh(b.z); o[8 * i + 6] = bfl(a.w) - lam * bfl(b.w); o[8 * i + 7] = bfh(a.w) - lam * bfh(b.w); }
    float ss = 0.f;
#pragma unroll
    for (int j = 0; j < 16; ++j) ss += o[j] * o[j];
    ss += __shfl_xor(ss, 1); ss += __shfl_xor(ss, 2); ss += __shfl_xor(ss, 4);
    const float rs = 1.f / sqrtf(ss * (1.f / 128.f) + RMS_EPS) * (1.0f - LAMBDA_INIT);
    float y[16];
#pragma unroll
    for (int j = 0; j < 16; ++j) y[j] = o[j] * rs * sg[j];
    v4u w0, w1; w0.x = pk2(y[0], y[1]); w0.y = pk2(y[2], y[3]); w0.z = pk2(y[4], y[5]); w0.w = pk2(y[6], y[7]); w1.x = pk2(y[8], y[9]); w1.y = pk2(y[10], y[11]); w1.z = pk2(y[12], y[13]); w1.w = pk2(y[14], y[15]);
    *(v4u*)(yrow + hh * 128 + e0) = w0; *(v4u*)(yrow + hh * 128 + e0 + 8) = w1;
}
__device__ __forceinline__ void yatt_pass(const bf16* OBp, bf16* PROJp, const float* subg, float lam, int gw, int NGW, int lane) {
    float sg[16];
#pragma unroll
    for (int j = 0; j < 16; ++j) sg[j] = subg[(lane & 7) * 16 + j];
    YRow c0, c1, c2, c3, n0, n1, n2, n3;
    int m = gw;
    if (m < M) { yatt_load(OBp + (size_t)m * 2048, lane, c0); yatt_load(OBp + (size_t)(m + NGW) * 2048, lane, c1); yatt_load(OBp + (size_t)(m + 2 * NGW) * 2048, lane, c2); yatt_load(OBp + (size_t)(m + 3 * NGW) * 2048, lane, c3); }
    for (; m < M; m += 4 * NGW) {
        const int mn = m + 4 * NGW;
        if (mn < M) { yatt_load(OBp + (size_t)mn * 2048, lane, n0); yatt_load(OBp + (size_t)(mn + NGW) * 2048, lane, n1); yatt_load(OBp + (size_t)(mn + 2 * NGW) * 2048, lane, n2); yatt_load(OBp + (size_t)(mn + 3 * NGW) * 2048, lane, n3); }
        yatt_fin(c0, PROJp + (size_t)m * INW + 1024, sg, lam, lane); yatt_fin(c1, PROJp + (size_t)(m + NGW) * INW + 1024, sg, lam, lane);
        yatt_fin(c2, PROJp + (size_t)(m + 2 * NGW) * INW + 1024, sg, lam, lane); yatt_fin(c3, PROJp + (size_t)(m + 3 * NGW) * INW + 1024, sg, lam, lane);
        c0 = n0; c1 = n1; c2 = n2; c3 = n3;
    }
}

__device__ __forceinline__ void up8(const v4u p, float (&f)[8]) { f[0] = bfl(p.x); f[1] = bfh(p.x); f[2] = bfl(p.y); f[3] = bfh(p.y); f[4] = bfl(p.z); f[5] = bfh(p.z); f[6] = bfl(p.w); f[7] = bfh(p.w); }
__device__ __forceinline__ void conv_item(bf16* proj, const float* cw, const float* cb, int item) {
    const int cc = item % (FF / 8), rr = item / (FF / 8), f0 = cc * 8, t0 = rr * 8;
    bf16* base = proj + (size_t)t0 * INW + f0;
    v4u pa[10], pv[8];
    const bool first = (t0 & (T - 1)) == 0;
    const v4u zero4 = {0u, 0u, 0u, 0u};
    pa[0] = first ? zero4 : *(const v4u*)(base - 2 * (size_t)INW); pa[1] = first ? zero4 : *(const v4u*)(base - (size_t)INW);
#pragma unroll
    for (int i = 0; i < 8; ++i) { pa[2 + i] = *(const v4u*)(base + (size_t)i * INW); pv[i] = *(const v4u*)(base + (size_t)i * INW + FF); }
    float w0[8], w1[8], w2[8], bb[8];
#pragma unroll
    for (int j = 0; j < 8; ++j) { w0[j] = cw[f0 + j]; w1[j] = cw[FF + f0 + j]; w2[j] = cw[2 * FF + f0 + j]; bb[j] = cb[f0 + j]; }
    float am2[8], am1[8];
    up8(pa[0], am2); up8(pa[1], am1);
#pragma unroll
    for (int i = 0; i < 8; ++i) {
        float a0[8], vv[8], o[8]; up8(pa[2 + i], a0); up8(pv[i], vv);
#pragma unroll
        for (int j = 0; j < 8; ++j) { const float cv = w0[j] * am2[j] + w1[j] * am1[j] + w2[j] * a0[j] + bb[j]; o[j] = cv * __builtin_amdgcn_rcpf(1.0f + __expf(-cv)) * vv[j]; am2[j] = am1[j]; am1[j] = a0[j]; }
        v4u w; w.x = pk2(o[0], o[1]); w.y = pk2(o[2], o[3]); w.z = pk2(o[4], o[5]); w.w = pk2(o[6], o[7]);
        *(v4u*)(base + (size_t)i * INW + FF) = w;
    }
}

__device__ __forceinline__ void convfix_item(bf16* Gb, const bf16* S0, const bf16* S1, const bf16* S2, const float* cw, const float* cb, int item) {
    const int cc = item % (FF / 8), sj = item / (FF / 8), j = sj & 1, s = sj >> 1, f0 = cc * 8;
    const bool first = (s & 63) == 0;
    const v4u z4 = {0u, 0u, 0u, 0u};
    const v4u l62 = first ? z4 : *(const v4u*)(S2 + ((size_t)(s - 1) * 2 + 0) * FF + f0), l63 = first ? z4 : *(const v4u*)(S2 + ((size_t)(s - 1) * 2 + 1) * FF + f0);
    const v4u a0 = *(const v4u*)(S0 + ((size_t)s * 2 + 0) * FF + f0), a1 = *(const v4u*)(S0 + ((size_t)s * 2 + 1) * FF + f0);
    const v4u vv = *(const v4u*)(S1 + ((size_t)s * 2 + j) * FF + f0);
    float pm2[8], pm1[8], ac[8], vf[8], o[8];
    if (j == 0) { up8(l62, pm2); up8(l63, pm1); up8(a0, ac); } else { up8(l63, pm2); up8(a0, pm1); up8(a1, ac); }
    up8(vv, vf);
#pragma unroll
    for (int q = 0; q < 8; ++q) { const float cv = cw[f0 + q] * pm2[q] + cw[FF + f0 + q] * pm1[q] + cw[2 * FF + f0 + q] * ac[q] + cb[f0 + q]; o[q] = cv * __builtin_amdgcn_rcpf(1.0f + __expf(-cv)) * vf[q]; }
    v4u w; w.x = pk2(o[0], o[1]); w.y = pk2(o[2], o[3]); w.z = pk2(o[4], o[5]); w.w = pk2(o[6], o[7]);
    *(v4u*)(Gb + ((size_t)s * 64 + j) * FF + f0) = w;
}

__global__ void __launch_bounds__(NTHREADS, 2) mk_fwd(Args args) {
    extern __shared__ __attribute__((aligned(16))) unsigned char lds[];
    cg::grid_group grid = cg::this_grid();
    LAS unsigned char* L = (LAS unsigned char*)lds;
    const int tid = threadIdx.x, lane = tid & 63, wave = __builtin_amdgcn_readfirstlane(tid >> 6);
    const int G = gridDim.x, bx = blockIdx.x;
    const int vcu = (G % 8 == 0) ? (bx % 8) * (G / 8) + bx / 8 : bx;
    const int gw = vcu * NWAVES + wave, NGW = G * NWAVES;
    unsigned char* ws = kargs()->ws;
    bf16* WinT = (bf16*)(ws + WS_WIN); bf16* WgluT = (bf16*)(ws + WS_WGLU); bf16* WbsT = (bf16*)(ws + WS_WBS); bf16* WbaT = (bf16*)(ws + WS_WBA);
    bf16* WoutT = (bf16*)(ws + WS_WOUT); bf16* WupT = (bf16*)(ws + WS_WUP); bf16* WdownT = (bf16*)(ws + WS_WDOWN);
    bf16* PROJ = (bf16*)(ws + WS_PROJ); bf16* HB = (bf16*)(ws + WS_HB);
    float* MODP = (float*)(ws + WS_MODP); float* MOD = (float*)(ws + WS_MOD);
    float* OUT = kargs()->out; bf16* OB = (bf16*)kargs()->out;
#define GSYNC_CG() do { __builtin_amdgcn_fence(__ATOMIC_RELEASE, "agent"); grid.sync(); __builtin_amdgcn_fence(__ATOMIC_ACQUIRE, "agent"); } while (0)
#define GSYNC() xcd_barrier(bar)
    for (int u = tid; u < (LDS_BYTES - LDSCTL_OFF) / 4; u += NTHREADS) ((LAS unsigned*)(L + LDSCTL_OFF))[u] = 0u;
    __syncthreads();
    const XcdBarrier bar = xcd_barrier_post((unsigned*)(ws + WS_CTL) + CW_BAR, (volatile LAS unsigned*)(L + MISC_OFF) + 8);

    {
        LAS float* scr = (LAS float*)(L + wave * 16384);
        constexpr int I_IN = (D / 64) * (INW / 32), I_SQ = (D / 64) * (D / 32), I_UP = (D / 64) * (2 * FF / 32), I_DN = (FF / 64) * (D / 32);
        constexpr int NITEMS = I_IN + 4 * I_SQ + I_UP + I_DN;
        for (int it = gw; it < NITEMS; it += NGW) {
            int r = it;
            if (r < I_IN) { p0_transpose_item(kargs()->in[4], D, INW, WinT, scr, r, lane); continue; } r -= I_IN;
            if (r < I_SQ) { p0_transpose_item(kargs()->in[13], D, D, WgluT, scr, r, lane); continue; } r -= I_SQ;
            if (r < I_SQ) { p0_transpose_item(kargs()->in[20], D, D, WbsT, scr, r, lane); continue; } r -= I_SQ;
            if (r < I_SQ) { p0_transpose_item(kargs()->in[21], D, D, WbaT, scr, r, lane); continue; } r -= I_SQ;
            if (r < I_SQ) { p0_transpose_item(kargs()->in[22], D, D, WoutT, scr, r, lane); continue; } r -= I_SQ;
            if (r < I_UP) { p0_transpose_item<true>(kargs()->in[25], D, 2 * FF, WupT, scr, r, lane); continue; } r -= I_UP;
            p0_transpose_item(kargs()->in[28], FF, D, WdownT, scr, r, lane);
        }
        for (int it = gw; it < 96 * 16; it += NGW) p0_mod_item(kargs()->in[1], kargs()->in[2], kargs()->in[3], MODP, it, lane);
    }
    GSYNC_CG();
    for (int i = bx * NTHREADS + tid; i < 16 * INW; i += G * NTHREADS) { float s = 0.f;
#pragma unroll
        for (int ks = 0; ks < 16; ++ks) s += MODP[(size_t)ks * 16 * INW + i];
        MOD[i] = s; }
    GSYNC();
    ln_pass<0>(kargs()->in[0], nullptr, HB, nullptr, nullptr, MOD, 0, D, gw, NGW, lane);
    GSYNC();
    {
        pg8::Gemm g{HB, WinT, D, D, D}; pg8::StaticOrder S; S.init(M, INW, G, bx);
        pg8::Epi<pg8::EP_PROJ> E{}; E.O = PROJ; E.ldo = INW; E.qscale = attn_body::C2;
        pg8::gemm_phase<pg8::Epi<pg8::EP_PROJ>, pg8::StaticOrder, true, true>(L, g, S, E);
    }
    GSYNC();
    {
        if (bx < 64) {
            ssm_item(kargs(), (bx * 8 + wave) >> 3, (bx * 8 + wave) & 7, L + wave * 16384, lane);
            __syncthreads();
        }
        unsigned* qctr = (unsigned*)(ws + WS_CTL) + CW_QUEUE;
        volatile LAS unsigned* qw = (volatile LAS unsigned*)(L + MISC_OFF) + 16;
        const int xcc = (int)(xb_xcc_id() & 7u);
        for (int s = 0; s < 8; ++s) {
            const int xq = (xcc + s) & 7;
            for (;;) {
                if (tid == 0) qw[0] = __hip_atomic_fetch_add(qctr + 64 * xq, 1u, __ATOMIC_RELAXED, __HIP_MEMORY_SCOPE_AGENT);
                __syncthreads();
                const int idx = __builtin_amdgcn_readfirstlane((int)qw[0]);
                __syncthreads();
                if (idx >= 1024) break;
                const int gp = idx >> 6, within = idx & 63, qb = 15 - (within >> 2), sub = within & 3, vh = sub & 1;
                const int gidx = xq + 8 * (2 * gp + (sub >> 1)), b = gidx >> 4, hm = gidx & 15;
                attn_body::attn_unit<8>(b, hm, 2 * (hm >> 1) + vh, 2 * hm + vh, qb, (const attn_body::bf16*)(PROJ + 1024), (const attn_body::bf16*)(PROJ + 2048), (const attn_body::bf16*)(PROJ + 3072), (attn_body::bf16*)OB, (char*)lds);
            }
        }
    }
    GSYNC();
    {
        float lam;
        { const float v1 = kargs()->in[15][lane] * kargs()->in[16][lane], v2 = kargs()->in[17][lane] * kargs()->in[18][lane];
          lam = expf(wave_sum(v1)) - expf(wave_sum(v2)) + LAMBDA_INIT; }
        yatt_pass(OB, PROJ, kargs()->in[19], lam, gw, NGW, lane);
        pg8::Gemm g{HB, WgluT, D, D, D}; pg8::StaticOrder S; S.init(M, D, G, bx);
        pg8::Epi<pg8::EP_GLU> E{}; E.O = PROJ; E.ldo = INW; E.X1 = HB; E.ldx1 = D; E.bias = kargs()->in[14];
        pg8::gemm_phase<pg8::Epi<pg8::EP_GLU>, pg8::StaticOrder, true, true>(L, g, S, E);
    }
    GSYNC();
    {
        pg8::Gemm g{PROJ, WbsT, INW, D, D}; pg8::StaticOrder S; S.init(M, D, G, bx);
        pg8::Epi<pg8::EP_BS> E{}; E.O = PROJ + 2048; E.ldo = INW; E.X1 = PROJ + 4096; E.ldx1 = INW;
        pg8::gemm_phase<pg8::Epi<pg8::EP_BS>, pg8::StaticOrder, true, true>(L, g, S, E);
    }
    {
        pg8::Gemm g{PROJ + 1024, WbaT, INW, D, D}; pg8::StaticOrder S; S.init(M, D, G, bx);
        pg8::Epi<pg8::EP_BA> E{}; E.O = PROJ + 3072; E.ldo = INW; E.X1 = PROJ + 5120; E.ldx1 = INW; E.X2 = PROJ + 2048; E.ldx2 = INW;
        pg8::gemm_phase<pg8::Epi<pg8::EP_BA>, pg8::StaticOrder, true, true>(L, g, S, E);
    }
    GSYNC();
    {
        pg8::Gemm g{PROJ + 3072, WoutT, INW, D, D}; pg8::StaticOrder S; S.init(M, D, G, bx);
        pg8::Epi<pg8::EP_OUT> E{}; E.F = OUT; E.R = kargs()->in[0]; E.gate = MOD + 2 * D; E.alpha = DN_ALPHA;
        pg8::gemm_phase<pg8::Epi<pg8::EP_OUT>, pg8::StaticOrder, true, true>(L, g, S, E);
    }
    GSYNC();
    ln_pass<1>(OUT, OUT, HB, kargs()->in[23], kargs()->in[24], MOD, 3 * D, 4 * D, gw, NGW, lane);
    GSYNC();
    bf16* GB = PROJ; bf16* SB0 = (bf16*)(ws + WS_PROJ + 416 * MiB); bf16* SB1 = (bf16*)(ws + WS_PROJ + 432 * MiB); bf16* SB2 = (bf16*)(ws + WS_PROJ + 448 * MiB);
    {
        pg8::Gemm g{HB, WupT, D, D, D}; pg8::StaticOrder S; S.init(M, 2 * FF, G, bx);
        pg8::Epi<pg8::EP_UPC> E{}; E.O = GB; E.ldo = FF; E.S0 = SB0; E.S1 = SB1; E.S2 = SB2; E.cw = kargs()->in[26]; E.cb = kargs()->in[27];
        pg8::gemm_phase<pg8::Epi<pg8::EP_UPC>, pg8::StaticOrder, true, true>(L, g, S, E);
    }
    GSYNC();
    for (int it = bx * NTHREADS + tid; it < (M / 64) * 2 * (FF / 8); it += G * NTHREADS) convfix_item(GB, SB0, SB1, SB2, kargs()->in[26], kargs()->in[27], it);
    GSYNC();
    {
        pg8::Gemm g{GB, WdownT, FF, FF, FF}; pg8::StaticOrder S; S.init(M, D, G, bx);
        pg8::Epi<pg8::EP_DOWN> E{}; E.F = OUT; E.R = OUT; E.gate = MOD + 5 * D; E.alpha = DN_ALPHA;
        pg8::gemm_phase<pg8::Epi<pg8::EP_DOWN>, pg8::StaticOrder, true, true>(L, g, S, E);
    }
    GSYNC();
    ln_pass<2>(OUT, OUT, nullptr, kargs()->in[29], kargs()->in[30], nullptr, 0, 0, gw, NGW, lane);
}

extern "C" void kernel_launch(void* const* d_in, const int* in_sizes, int n_in, void* d_out, int out_size, void* d_ws, size_t ws_size, hipStream_t stream) {
    static int grid = 0;
    if (grid == 0) {
        if (n_in != 31 || in_sizes[0] != M * D || out_size != M * D || ws_size < WS_END) { fprintf(stderr, "kernel_launch: unexpected shapes (n_in %d, in0 %d, out %d, ws %zu); nothing launched\n", n_in, n_in > 0 ? in_sizes[0] : -1, out_size, ws_size); grid = -1; return; }
        int dev = 0, cus = 0, per_cu = 0;
        if (hipGetDevice(&dev) != hipSuccess || hipDeviceGetAttribute(&cus, hipDeviceAttributeMultiprocessorCount, dev) != hipSuccess) { grid = -1; return; }
        if (hipFuncSetAttribute((const void*)mk_fwd, hipFuncAttributeMaxDynamicSharedMemorySize, LDS_BYTES) != hipSuccess) { fprintf(stderr, "kernel_launch: hipFuncSetAttribute failed\n"); grid = -1; return; }
        if (hipOccupancyMaxActiveBlocksPerMultiprocessor(&per_cu, (const void*)mk_fwd, NTHREADS, LDS_BYTES) != hipSuccess || per_cu < 1) { fprintf(stderr, "kernel_launch: occupancy query says %d\n", per_cu); per_cu = 1; }
        (void)hipGetLastError();
        grid = cus * per_cu;
    }
    if (grid < 0) return;
    if (hipMemsetAsync((char*)d_ws + WS_CTL, 0, CTL_ZERO_BYTES, stream) != hipSuccess) { fprintf(stderr, "kernel_launch: memset failed\n"); return; }
    Args a{};
    for (int i = 0; i < 31; ++i) a.in[i] = (const float*)d_in[i];
    a.out = (float*)d_out; a.ws = (unsigned char*)d_ws;
    void* kargs[] = {&a};
    hipError_t e = hipLaunchCooperativeKernel((const void*)mk_fwd, dim3(grid), dim3(NTHREADS), kargs, LDS_BYTES, stream);
    if (e != hipSuccess) fprintf(stderr, "kernel_launch: cooperative launch failed: %s (grid %d)\n", hipGetErrorString(e), grid);
}
```

```cpp
#include <hip/hip_runtime.h>
#include <hip/hip_cooperative_groups.h>
#include <cstdio>
#include <cstdint>
namespace cg = cooperative_groups;
namespace pg8 {
#define PG8_LAS __attribute__((address_space(3)))
typedef unsigned short bf16_t;
typedef short bf16x8 __attribute__((ext_vector_type(8)));
typedef float f32x4 __attribute__((ext_vector_type(4)));
typedef unsigned u32x4 __attribute__((ext_vector_type(4)));
constexpr int BM = 256, BK = 64, HALF = 128, HTB = HALF * BK * 2  , STAGE_BYTES = 8 * HTB, NXCD = 8, WGM = 8;

__host__ __device__ __forceinline__ int lds_byte(int r, int c) { const int st = (r >> 4) * 2 + (c >> 5), rr = r & 15, cc = c & 31, ob = rr * 64 + cc * 2; return st * 1024 + (ob ^ (((ob >> 9) & 1) << 5)); }
__host__ __device__ __forceinline__ void stage_rc(int b, int& R, int& C) { const int st = b / 1024, sb = b % 1024, swz = sb ^ (((sb >> 9) & 1) << 5); R = (st >> 1) * 16 + swz / 64; C = (st & 1) * 32 + (swz % 64) / 2; }
__host__ __device__ __forceinline__ int perm32(int rho) { const int n = rho >> 4, i = rho & 15; return 8 * (i >> 2) + 4 * n + (i & 3); }

struct Unit { int pm, pn; };
struct Gemm { const bf16_t* A; const bf16_t* Bt; int lda, ldb, K; };

struct StaticOrder {
    int nM, nN, nwg, G, c;
    __host__ __device__ void init(int M, int N, int G_, int c_) { nM = M / BM; nN = N / BM; nwg = nM * nN; G = G_; c = c_; }
    __host__ __device__ bool next(int i, Unit& u) const {
        const long L = (long)i * G + c; if (L >= nwg) return false;
        int wgid = (int)L; { const int q = nwg / NXCD, r = nwg % NXCD, xcd = wgid % NXCD, off = wgid / NXCD; wgid = (xcd < r ? xcd * (q + 1) : r * (q + 1) + (xcd - r) * q) + off; }
        const int nig = WGM * nN, gid = wgid / nig, fm = gid * WGM, gsz = (nM - fm) < WGM ? (nM - fm) : WGM;
        u.pm = fm + ((wgid % nig) % gsz); u.pn = (wgid % nig) / gsz; return true;
    }
    __device__ __forceinline__ void a_ready(const Unit&) const {}
    __device__ __forceinline__ void done(const Unit&) const {}
};

__device__ __forceinline__ unsigned cvt_pk_bf16(float lo, float hi) { unsigned r; asm volatile("v_cvt_pk_bf16_f32 %0, %1, %2" : "=v"(r) : "v"(lo), "v"(hi)); return r; }

__device__ __forceinline__ float bf_lo(unsigned u) { return __uint_as_float(u << 16); }
__device__ __forceinline__ float bf_hi(unsigned u) { return __uint_as_float(u & 0xffff0000u); }
__device__ __forceinline__ float sigmoidf_fast(float x) { return __builtin_amdgcn_rcpf(1.0f + __expf(-x)); }
__device__ __forceinline__ void unpack8(const u32x4 w, float (&f)[8]) { f[0] = bf_lo(w.x); f[1] = bf_hi(w.x); f[2] = bf_lo(w.y); f[3] = bf_hi(w.y); f[4] = bf_lo(w.z); f[5] = bf_hi(w.z); f[6] = bf_lo(w.w); f[7] = bf_hi(w.w); }
enum { EP_PROJ = 0, EP_GLU = 1, EP_BS = 2, EP_BA = 3, EP_OUT = 4, EP_UP = 5, EP_DOWN = 6, EP_UPC = 7 };
template <int MODE> struct Epi {
    static constexpr bool PERM = (MODE != EP_OUT && MODE != EP_DOWN), AFTER_DRAIN = false;
    bf16_t* O; int ldo;
    const bf16_t* X1; int ldx1;
    const bf16_t* X2; int ldx2;
    const float* bias;
    float* F; const float* R; const float* gate; float alpha;
    float qscale;
    bf16_t* S0; bf16_t* S1; bf16_t* S2; const float* cw; const float* cb;
    __device__ __forceinline__ void operator()(const f32x4 (&acc)[2][2][4][2], const Unit& u, int wr, int wc, int fr, int fq) const {
        if constexpr (MODE == EP_UPC) {
            constexpr int FFc = 2816;
            const int lane_ = (int)(threadIdx.x & 63);
            const int src1 = (lane_ & 48) | ((fr + 15) & 15), src2 = (lane_ & 48) | ((fr + 14) & 15);
            const int row0 = u.pm * BM + wr * 64 + fr, fb0 = u.pn * 128 + wc * 16 + 4 * fq;
            f32x4 w0v[2], w1v[2], w2v[2], cbv[2];
#pragma unroll
            for (int bj = 0; bj < 2; ++bj) { w0v[bj] = *(const f32x4*)(cw + fb0 + bj * 64); w1v[bj] = *(const f32x4*)(cw + FFc + fb0 + bj * 64); w2v[bj] = *(const f32x4*)(cw + 2 * FFc + fb0 + bj * 64); cbv[bj] = *(const f32x4*)(cb + fb0 + bj * 64); }
#pragma unroll
            for (int ai = 0; ai < 2; ++ai)
#pragma unroll
                for (int m = 0; m < 4; ++m) {
                    const int row = row0 + ai * HALF + m * 16; const int strip = row >> 6;
#pragma unroll
                    for (int bj = 0; bj < 2; ++bj) {
                        const int fb = fb0 + bj * 64;
                        const f32x4 A = acc[ai][bj][m][0], V = acc[ai][bj][m][1];
                        const f32x4 Ap = acc[ai][bj][m > 0 ? m - 1 : 0][0];
                        float g[4];
#pragma unroll
                        for (int i = 0; i < 4; ++i) {
                            const float c1 = __shfl(A[i], src1), c2 = __shfl(A[i], src2);
                            float p1 = c1, p2 = c2;
                            if (m > 0) { const float d1 = __shfl(Ap[i], src1), d2 = __shfl(Ap[i], src2); p1 = (fr >= 1) ? c1 : d1; p2 = (fr >= 2) ? c2 : d2; }
                            const float cv = w0v[bj][i] * p2 + w1v[bj][i] * p1 + w2v[bj][i] * A[i] + cbv[bj][i];
                            g[i] = cv * sigmoidf_fast(cv) * V[i];
                        }
                        typedef unsigned u32x2 __attribute__((ext_vector_type(2)));
                        if (m == 0 && fr < 2) {
                            u32x2 wa; wa.x = cvt_pk_bf16(A[0], A[1]); wa.y = cvt_pk_bf16(A[2], A[3]);
                            u32x2 wv; wv.x = cvt_pk_bf16(V[0], V[1]); wv.y = cvt_pk_bf16(V[2], V[3]);
                            *(u32x2*)(S0 + ((size_t)strip * 2 + fr) * FFc + fb) = wa; *(u32x2*)(S1 + ((size_t)strip * 2 + fr) * FFc + fb) = wv;
                        } else {
                            u32x2 wg; wg.x = cvt_pk_bf16(g[0], g[1]); wg.y = cvt_pk_bf16(g[2], g[3]);
                            *(u32x2*)(O + (size_t)row * ldo + fb) = wg;
                        }
                        if (m == 3 && fr >= 14) { u32x2 wa; wa.x = cvt_pk_bf16(A[0], A[1]); wa.y = cvt_pk_bf16(A[2], A[3]); *(u32x2*)(S2 + ((size_t)strip * 2 + (fr - 14)) * FFc + fb) = wa; }
                    }
                    asm volatile("" ::: "memory");
                }
        } else
        if constexpr (PERM) {
            const int row0 = u.pm * BM + wr * 64 + fr, col0 = u.pn * BM + wc * 32 + 8 * fq;
            float sc = 1.f; if (MODE == EP_PROJ) { const int colt = u.pn * BM; if (colt >= 1024 && colt < 2048) sc = qscale; }
            float bv[2][8];
            if (MODE == EP_GLU) {
#pragma unroll
                for (int bj = 0; bj < 2; ++bj) { const f32x4 b0 = *(const f32x4*)(bias + col0 + bj * HALF), b1 = *(const f32x4*)(bias + col0 + bj * HALF + 4);
                    bv[bj][0] = b0[0]; bv[bj][1] = b0[1]; bv[bj][2] = b0[2]; bv[bj][3] = b0[3]; bv[bj][4] = b1[0]; bv[bj][5] = b1[1]; bv[bj][6] = b1[2]; bv[bj][7] = b1[3]; }
            }
#pragma unroll
            for (int ai = 0; ai < 2; ++ai)
#pragma unroll
                for (int m = 0; m < 4; ++m) {
                    const size_t row = (size_t)(row0 + ai * HALF + m * 16);
#pragma unroll
                    for (int bj = 0; bj < 2; ++bj) {
                        const int col = col0 + bj * HALF;
                        float v[8];
#pragma unroll
                        for (int j = 0; j < 4; ++j) { v[j] = acc[ai][bj][m][0][j]; v[4 + j] = acc[ai][bj][m][1][j]; }
                        if (MODE == EP_PROJ) {
#pragma unroll
                            for (int j = 0; j < 8; ++j) v[j] *= sc;
                        }
                        if (MODE == EP_GLU) {
                            float z[8]; unpack8(*(const u32x4*)(X1 + row * ldx1 + col), z);
#pragma unroll
                            for (int j = 0; j < 8; ++j) v[j] = z[j] * sigmoidf_fast(v[j] + bv[bj][j]);
                        }
                        if (MODE == EP_BS) {
                            float gt[8]; unpack8(*(const u32x4*)(X1 + row * ldx1 + col), gt);
#pragma unroll
                            for (int j = 0; j < 8; ++j) v[j] = sigmoidf_fast(gt[j]) * v[j];
                        }
                        if (MODE == EP_BA) {
                            float gt[8], m1[8]; unpack8(*(const u32x4*)(X1 + row * ldx1 + col), gt); unpack8(*(const u32x4*)(X2 + row * ldx2 + col), m1);
#pragma unroll
                            for (int j = 0; j < 8; ++j) v[j] = m1[j] + sigmoidf_fast(gt[j]) * v[j];
                        }
                        u32x4 w; w.x = cvt_pk_bf16(v[0], v[1]); w.y = cvt_pk_bf16(v[2], v[3]); w.z = cvt_pk_bf16(v[4], v[5]); w.w = cvt_pk_bf16(v[6], v[7]);
                        *(u32x4*)(O + row * ldo + col) = w;
                    }
                    asm volatile("" ::: "memory");
                }
        } else {
            const int row0 = u.pm * BM + wr * 64 + fr, col0 = u.pn * BM + wc * 32 + 4 * fq;
            const float* gp = gate + (size_t)((u.pm * BM) >> 12) * 6144;
            f32x4 gv[2][2];
#pragma unroll
            for (int bj = 0; bj < 2; ++bj)
#pragma unroll
                for (int n = 0; n < 2; ++n) gv[bj][n] = *(const f32x4*)(gp + col0 + bj * HALF + n * 16);
#pragma unroll
            for (int ai = 0; ai < 2; ++ai)
#pragma unroll
                for (int m = 0; m < 4; ++m) {
                    const size_t off = (size_t)(row0 + ai * HALF + m * 16) * 1024 + col0;
#pragma unroll
                    for (int bj = 0; bj < 2; ++bj)
#pragma unroll
                        for (int n = 0; n < 2; ++n) { const f32x4 rs = *(const f32x4*)(R + off + bj * HALF + n * 16);
                            *(f32x4*)(F + off + bj * HALF + n * 16) = rs * alpha + gv[bj][n] * acc[ai][bj][m][n]; }
                    asm volatile("" ::: "memory");
                }
        }
    }
};

template <class Epi, class Sched, bool ALIGN_EPI = false, bool SP2 = false>
__device__ __forceinline__ void gemm_phase(PG8_LAS unsigned char* lds, const Gemm g, const Sched& S, const Epi& E) {
    int tid_ = threadIdx.x; asm volatile("" : "+v"(tid_)); const int tid = tid_, wid = __builtin_amdgcn_readfirstlane(tid >> 6), lane = tid & 63, wr = wid >> 2, wc = wid & 3, fr = lane & 15, fq = lane >> 4;
    const int K = g.K, nt = K / BK;
    unsigned voffA[2], voffB[2];
#pragma unroll
    for (int i = 0; i < 2; ++i) { int R, C; stage_rc(tid * 16 + i * 8192, R, C); const int Rb = Epi::PERM ? ((R & ~31) + perm32(R & 31)) : R;
        voffA[i] = (unsigned)(R * g.lda + C) * 2u; voffB[i] = (unsigned)(Rb * g.ldb + C) * 2u; }
    const size_t kstep = (size_t)(BK * 2);
    const size_t hstepA = (size_t)HALF * g.lda * 2, hstepB = (size_t)HALF * g.ldb * 2;
    const size_t tstepA = 2 * hstepA, tstepB = 2 * hstepB;
    const unsigned ldsw = (unsigned)wid * 1024u;
    const int aoff = lds_byte(wr * 64 + fr, fq * 8), boff = lds_byte(wc * 32 + fr, fq * 8);
#define PG8_SA(b, h) (((b) * 2 + (h)) * HTB)
#define PG8_SB(b, h) ((4 + (b) * 2 + (h)) * HTB)
#define PG8_STAGE(bufoff, gbase, voff) do { _Pragma("unroll") for (int _i = 0; _i < 2; ++_i) \
        __builtin_amdgcn_global_load_lds((const unsigned*)((const char*)(gbase) + (voff)[_i]), (PG8_LAS unsigned*)(lds + (bufoff) + ldsw + _i * 8192), 16, 0, 0); } while (0)
#define PG8_LDA(dst, b, h) do { _Pragma("unroll") for (int m = 0; m < 4; ++m) _Pragma("unroll") for (int k = 0; k < 2; ++k) dst[m][k] = *(const PG8_LAS bf16x8*)(lds + PG8_SA(b, h) + aoff + m * 2048 + k * 1024); } while (0)
#define PG8_LDB(dst, b, h) do { _Pragma("unroll") for (int n = 0; n < 2; ++n) _Pragma("unroll") for (int k = 0; k < 2; ++k) dst[n][k] = *(const PG8_LAS bf16x8*)(lds + PG8_SB(b, h) + boff + n * 2048 + k * 1024); } while (0)
#define PG8_MMA(ai, bj, At, Bt) do { __builtin_amdgcn_s_setprio(1); _Pragma("unroll") for (int m = 0; m < 4; ++m) _Pragma("unroll") for (int n = 0; n < 2; ++n) _Pragma("unroll") for (int k = 0; k < 2; ++k) \
        acc[ai][bj][m][n] = __builtin_amdgcn_mfma_f32_16x16x32_bf16(Bt[n][k], At[m][k], acc[ai][bj][m][n], 0, 0, 0); __builtin_amdgcn_s_setprio(0); } while (0)
#define PG8_WAIT_V(n) asm volatile("s_waitcnt vmcnt(" #n ")" ::: "memory")
#define PG8_WAIT_L(n) asm volatile("s_waitcnt lgkmcnt(" #n ")" ::: "memory")
#define PG8_BAR __builtin_amdgcn_s_barrier()
#define PG8_SCHED __builtin_amdgcn_sched_barrier(0)
    Unit cur, nxt; int ui = 0;
    if (!S.next(0, cur)) return;
    f32x4 acc[2][2][4][2];
#pragma unroll
    for (int a = 0; a < 2; ++a)
#pragma unroll
        for (int b = 0; b < 2; ++b)
#pragma unroll
            for (int m = 0; m < 4; ++m)
#pragma unroll
                for (int n = 0; n < 2; ++n) acc[a][b][m][n] = (f32x4){0.f, 0.f, 0.f, 0.f};
    bf16x8 At[4][2], B0[2][2], B1[2][2];
    const char* cA = (const char*)g.A + (size_t)cur.pm * tstepA; const char* cB = (const char*)g.Bt + (size_t)cur.pn * tstepB;
    S.a_ready(cur);
    if constexpr (SP2) {
        PG8_STAGE(PG8_SB(0, 0), cB, voffB); PG8_STAGE(PG8_SB(0, 1), cB + hstepB, voffB); PG8_STAGE(PG8_SA(0, 0), cA, voffA); PG8_STAGE(PG8_SA(0, 1), cA + hstepA, voffA);
        if (wr == 1) PG8_BAR;
        PG8_WAIT_V(2); PG8_BAR;
        PG8_STAGE(PG8_SB(1, 0), cB + kstep, voffB); PG8_STAGE(PG8_SA(1, 0), cA + kstep, voffA); PG8_STAGE(PG8_SB(1, 1), cB + hstepB + kstep, voffB);
        PG8_WAIT_V(6); PG8_BAR;
    } else {
        PG8_STAGE(PG8_SB(0, 0), cB, voffB); PG8_STAGE(PG8_SA(0, 0), cA, voffA); PG8_STAGE(PG8_SB(0, 1), cB + hstepB, voffB); PG8_STAGE(PG8_SA(0, 1), cA + hstepA, voffA);
        if (wr == 1) PG8_BAR;
        PG8_WAIT_V(4); PG8_BAR;
        PG8_STAGE(PG8_SB(1, 0), cB + kstep, voffB); PG8_STAGE(PG8_SA(1, 0), cA + kstep, voffA); PG8_STAGE(PG8_SB(1, 1), cB + hstepB + kstep, voffB);
        PG8_WAIT_V(6); PG8_BAR;
    }
    for (;;) {
        const bool has_next = S.next(ui + 1, nxt);
        const char* nA = has_next ? (const char*)g.A + (size_t)nxt.pm * tstepA : cA; const char* nB = has_next ? (const char*)g.Bt + (size_t)nxt.pn * tstepB : cB;
        for (int t = 0; t < nt; t += 2) {
            const bool last = (t == nt - 2);
            const char* a1 = cA + (size_t)(t + 1) * kstep;
            const char* a2 = last ? nA : cA + (size_t)(t + 2) * kstep; const char* b2 = last ? nB : cB + (size_t)(t + 2) * kstep;
            const char* a3 = a2 + kstep; const char* b3 = b2 + kstep;
            if (last && has_next) S.a_ready(nxt);
            if constexpr (SP2) {
            PG8_LDB(B0, 0, 0); PG8_LDB(B1, 0, 1); PG8_SCHED; PG8_LDA(At, 0, 0); PG8_STAGE(PG8_SA(1, 1), a1 + hstepA, voffA);
            PG8_WAIT_V(8); PG8_WAIT_L(0); PG8_BAR; PG8_MMA(0, 0, At, B0); PG8_MMA(0, 1, At, B1); PG8_BAR; PG8_SCHED;
            PG8_LDA(At, 0, 1); PG8_STAGE(PG8_SB(0, 0), b2, voffB); PG8_STAGE(PG8_SB(0, 1), b2 + hstepB, voffB); PG8_STAGE(PG8_SA(0, 0), a2, voffA);
            PG8_WAIT_V(8); PG8_WAIT_L(0); PG8_BAR; PG8_MMA(1, 0, At, B0); PG8_MMA(1, 1, At, B1); PG8_BAR; PG8_SCHED;
            PG8_LDB(B0, 1, 0); PG8_LDB(B1, 1, 1); PG8_SCHED; PG8_LDA(At, 1, 0); PG8_STAGE(PG8_SA(0, 1), a2 + hstepA, voffA);
            PG8_WAIT_V(8); PG8_WAIT_L(0); PG8_BAR; PG8_MMA(0, 0, At, B0); PG8_MMA(0, 1, At, B1); PG8_BAR; PG8_SCHED;
            PG8_LDA(At, 1, 1); PG8_STAGE(PG8_SB(1, 0), b3, voffB); PG8_STAGE(PG8_SB(1, 1), b3 + hstepB, voffB); PG8_STAGE(PG8_SA(1, 0), a3, voffA);
            PG8_WAIT_V(8); PG8_WAIT_L(0); PG8_BAR; PG8_MMA(1, 0, At, B0); PG8_MMA(1, 1, At, B1); PG8_BAR; PG8_SCHED;
            } else {
            PG8_LDB(B0, 0, 0); PG8_SCHED; PG8_LDA(At, 0, 0); PG8_STAGE(PG8_SA(1, 1), a1 + hstepA, voffA);
            PG8_WAIT_L(8); PG8_BAR; PG8_WAIT_L(0); PG8_MMA(0, 0, At, B0); PG8_BAR; PG8_SCHED;
            PG8_LDB(B1, 0, 1); PG8_STAGE(PG8_SB(0, 0), b2, voffB);
            PG8_BAR; PG8_WAIT_L(0); PG8_MMA(0, 1, At, B1); PG8_BAR;
            PG8_LDA(At, 0, 1); PG8_STAGE(PG8_SA(0, 0), a2, voffA);
            PG8_BAR; PG8_WAIT_L(0); PG8_MMA(1, 0, At, B0); PG8_BAR; PG8_SCHED;
            PG8_STAGE(PG8_SB(0, 1), b2 + hstepB, voffB);
            PG8_WAIT_V(6); PG8_BAR; PG8_MMA(1, 1, At, B1); PG8_BAR;
            PG8_LDB(B0, 1, 0); PG8_SCHED; PG8_LDA(At, 1, 0); PG8_STAGE(PG8_SA(0, 1), a2 + hstepA, voffA);
            PG8_WAIT_L(8); PG8_BAR; PG8_WAIT_L(0); PG8_MMA(0, 0, At, B0); PG8_BAR; PG8_SCHED;
            PG8_LDB(B1, 1, 1); PG8_STAGE(PG8_SB(1, 0), b3, voffB);
            PG8_BAR; PG8_WAIT_L(0); PG8_MMA(0, 1, At, B1); PG8_BAR;
            PG8_LDA(At, 1, 1); PG8_STAGE(PG8_SA(1, 0), a3, voffA);
            PG8_BAR; PG8_WAIT_L(0); PG8_MMA(1, 0, At, B0); PG8_BAR; PG8_SCHED;
            PG8_STAGE(PG8_SB(1, 1), b3 + hstepB, voffB);
            PG8_WAIT_V(6); PG8_BAR; PG8_MMA(1, 1, At, B1); PG8_BAR;
            }
        }
        if constexpr (ALIGN_EPI) { if (wr == 0) PG8_BAR; }
        if constexpr (!Epi::AFTER_DRAIN) { E(acc, cur, wr, wc, fr, fq); S.done(cur); }
        if (!has_next) break;
#pragma unroll
        for (int a = 0; a < 2; ++a)
#pragma unroll
            for (int b = 0; b < 2; ++b)
#pragma unroll
                for (int m = 0; m < 4; ++m)
#pragma unroll
                    for (int n = 0; n < 2; ++n) acc[a][b][m][n] = (f32x4){0.f, 0.f, 0.f, 0.f};
        cur = nxt; cA = nA; cB = nB; ++ui;
        if constexpr (ALIGN_EPI) { if (wr == 1) PG8_BAR; }
    }
    PG8_WAIT_V(0);
    if constexpr (!ALIGN_EPI) { if (wr == 0) PG8_BAR; }
    PG8_BAR;
    if constexpr (Epi::AFTER_DRAIN) { E.fused(acc, cur, wr, wc, fr, fq, lds, wid, lane); S.done(cur); }
#undef PG8_SA
#undef PG8_SB
#undef PG8_STAGE
#undef PG8_LDA
#undef PG8_LDB
#undef PG8_MMA
#undef PG8_WAIT_V
#undef PG8_WAIT_L
#undef PG8_BAR
#undef PG8_SCHED
}
}

#include <hip/hip_bf16.h>
#include <cmath>
namespace attn_body {
using bf16=__hip_bfloat16;
using bf16x8=__attribute__((ext_vector_type(8)))short;
using s16x4=__attribute__((ext_vector_type(4)))short;
using f32x16=__attribute__((ext_vector_type(16)))float;
using u32x4=__attribute__((ext_vector_type(4)))unsigned;
constexpr int SEQ=4096,D=64,DM=6144,OP=2048;
constexpr int NW=8,QBLK=32,QB=QBLK*NW,KVBLK=64,NQB=SEQ/QB;
constexpr int ATTN_PITCH=DM, ATTN_UNIT_ROWS=QB;
__device__ __forceinline__ int crow(int r,int hi){return (r&3)+8*(r>>2)+4*hi;}
#define SBAR() __builtin_amdgcn_sched_barrier(0)
__device__ __forceinline__ void cmask(f32x16&p0,f32x16&p1,int jb,int qrel,int hi){
  const float NEG=-INFINITY;
  if(jb>(qrel>>6)){
  #pragma unroll
  for(int r=0;r<16;++r){p0[r]=NEG;p1[r]=NEG;}}
}

constexpr int NSLOT=3, SLOTB=8192;
constexpr int LDS_K=0, LDS_V=NSLOT*SLOTB, LDS_WS=LDS_V+NSLOT*2*SLOTB, LDS_OST=LDS_WS+NW*64*4, LDS_BYTES=LDS_OST+NW*4096;
constexpr float C2=0.125f*1.4426950408889634f;
__device__ __forceinline__ void glds16(const void*gsrc,unsigned lds_dst){unsigned keep;
  asm volatile("s_mov_b32 %0, m0\n\ts_mov_b32 m0, %2\n\ts_nop 0\n\tglobal_load_lds_dwordx4 %1, off\n\ts_mov_b32 m0, %0":"=&s"(keep):"v"(gsrc),"s"(lds_dst):"memory");}
__device__ __forceinline__ float max3f(float a,float b,float c){float r;asm("v_max3_f32 %0, %1, %2, %3":"=v"(r):"v"(a),"v"(b),"v"(c));return r;}
__device__ __forceinline__ float max2f(float a,float b){float r;asm("v_max_f32_e32 %0, %1, %2":"=v"(r):"v"(a),"v"(b));return r;}
__device__ __forceinline__ float fadd_s(float a,float b){float r;asm("v_add_f32_e32 %0, %1, %2":"=v"(r):"v"(a),"v"(b));return r;}
__device__ __forceinline__ float fsub_s(float a,float b){float r;asm("v_sub_f32_e32 %0, %1, %2":"=v"(r):"v"(a),"v"(b));return r;}
typedef float f32x2_t __attribute__((ext_vector_type(2))); typedef __bf16 bf16x2_t __attribute__((ext_vector_type(2)));
__device__ __forceinline__ unsigned cvtpk_s(float lo,float hi){f32x2_t v={lo,hi};bf16x2_t b=__builtin_convertvector(v,bf16x2_t);return __builtin_bit_cast(unsigned,b);}
#define WAIT_BAR(N) asm volatile("s_waitcnt vmcnt(" #N ") lgkmcnt(0)\n\ts_barrier":::"memory")

__device__ __forceinline__ void qkt(f32x16&p0,f32x16&p1,const char*Kslot,const bf16x8*qr,const f32x16&negm,int r32,int hi){
  const char*kb=Kslot+hi*1024+r32*16;
  #pragma unroll
  for(int d0=0;d0<4;++d0){
    const bf16x8 b0=*reinterpret_cast<const bf16x8*>(kb+d0*2048);
    const bf16x8 b1=*reinterpret_cast<const bf16x8*>(kb+d0*2048+512);
    if(d0==0){p0=__builtin_amdgcn_mfma_f32_32x32x16_bf16(b0,qr[0],negm,0,0,0);p1=__builtin_amdgcn_mfma_f32_32x32x16_bf16(b1,qr[0],negm,0,0,0);}
    else{p0=__builtin_amdgcn_mfma_f32_32x32x16_bf16(b0,qr[d0],p0,0,0,0);p1=__builtin_amdgcn_mfma_f32_32x32x16_bf16(b1,qr[d0],p1,0,0,0);}}
}
typedef __attribute__((address_space(3))) const char* lds_cptr;
typedef short v4i16_t __attribute__((ext_vector_type(4)));
__device__ __forceinline__ void kload8(bf16x8*kf,lds_cptr kp){
  kf[0]=*(const __attribute__((address_space(3))) bf16x8*)(kp);      kf[1]=*(const __attribute__((address_space(3))) bf16x8*)(kp+512);
  kf[2]=*(const __attribute__((address_space(3))) bf16x8*)(kp+2048); kf[3]=*(const __attribute__((address_space(3))) bf16x8*)(kp+2560);
  kf[4]=*(const __attribute__((address_space(3))) bf16x8*)(kp+4096); kf[5]=*(const __attribute__((address_space(3))) bf16x8*)(kp+4608);
  kf[6]=*(const __attribute__((address_space(3))) bf16x8*)(kp+6144); kf[7]=*(const __attribute__((address_space(3))) bf16x8*)(kp+6656);
}
__device__ __forceinline__ void kload2(bf16x8*kf,lds_cptr kp,int j){ kf[2*j]=*(const __attribute__((address_space(3))) bf16x8*)(kp+j*2048); kf[2*j+1]=*(const __attribute__((address_space(3))) bf16x8*)(kp+j*2048+512); }
__device__ __forceinline__ s16x4 vtr(lds_cptr p){ return __builtin_bit_cast(s16x4,__builtin_amdgcn_ds_read_tr16_b64_v4i16((__attribute__((address_space(3))) v4i16_t*)p)); }
__device__ __forceinline__ float rowmax(const f32x16&p0,const f32x16&p1){
  float a=max3f(p0[0],p0[1],p1[0]),b=max3f(p0[2],p0[3],p1[1]);a=max3f(a,p1[2],p1[3]);
  #pragma unroll
  for(int r=4;r<16;r+=4){a=max3f(a,p0[r],p0[r+1]);b=max3f(b,p0[r+2],p0[r+3]);a=max3f(a,p1[r],p1[r+1]);b=max3f(b,p1[r+2],p1[r+3]);}
  const float m=max2f(a,b);
  auto rr=__builtin_amdgcn_permlane32_swap(__float_as_uint(m),__float_as_uint(m),false,false);
  return max2f(__uint_as_float(rr[0]),__uint_as_float(rr[1]));
}
__device__ __forceinline__ void pv(f32x16*o,int vb,bf16x8 pa0,bf16x8 pa1,bf16x8 pa2,bf16x8 pa3){
  #pragma unroll
  for(int d0=0;d0<4;++d0){s16x4 lo[4],hi[4];
    #pragma unroll
    for(int ks=0;ks<4;++ks){
      asm volatile("ds_read_b64_tr_b16 %0,%1 offset:%c2":"=&v"(lo[ks]):"v"(vb),"i"(d0*4096+ks*1024):"memory");
      asm volatile("ds_read_b64_tr_b16 %0,%1 offset:%c2":"=&v"(hi[ks]):"v"(vb),"i"(d0*4096+ks*1024+512):"memory");}
    asm volatile("s_waitcnt lgkmcnt(0)":::"memory");SBAR();
    #define PK(k) (bf16x8){lo[k][0],lo[k][1],lo[k][2],lo[k][3],hi[k][0],hi[k][1],hi[k][2],hi[k][3]}
    o[d0]=__builtin_amdgcn_mfma_f32_32x32x16_bf16(pa0,PK(0),o[d0],0,0,0);
    o[d0]=__builtin_amdgcn_mfma_f32_32x32x16_bf16(pa1,PK(1),o[d0],0,0,0);
    o[d0]=__builtin_amdgcn_mfma_f32_32x32x16_bf16(pa2,PK(2),o[d0],0,0,0);
    o[d0]=__builtin_amdgcn_mfma_f32_32x32x16_bf16(pa3,PK(3),o[d0],0,0,0);
    #undef PK
  }
}

#ifndef ATTN_STORE16
#define ATTN_STORE16(p,v) (*(u32x4*)(p)=(v))
#endif
template<int THRL> __device__ __forceinline__ void attn_unit(int b,int h,int hv,int os,int qb,const bf16*Q,const bf16*__restrict__ K,const bf16*__restrict__ V,bf16*O,char*shm){
  int tid_=threadIdx.x; asm volatile("":"+v"(tid_)); const int tid=tid_,lane=tid&63,r32=lane&31,hi=lane>>5; const int wid=__builtin_amdgcn_readfirstlane(tid>>6);
  const long rowbase=(long)b*SEQ; const int q0=qb*QB;
  const bf16*Qw=Q+(rowbase+q0+wid*QBLK)*DM+h*D;
  const bf16*Kh=K+rowbase*DM+h*D,*Vh=V+rowbase*DM+hv*D;
  const unsigned lds0=(unsigned)(uintptr_t)shm;
  float*wsf=(float*)(shm+LDS_WS)+wid*64;
  const bf16*ksrc=Kh+(long)lane*DM+wid*8;
  const bf16*vsrc=Vh+(long)(16*(wid&3)+(lane>>2))*DM+(wid>>2)*32+(lane&3)*8;
  const unsigned kdst=lds0+LDS_K+wid*1024, vdst=lds0+LDS_V+wid*1024;
  #define DMA_K(t,slot) glds16(ksrc+(long)(t)*KVBLK*DM,(unsigned)__builtin_amdgcn_readfirstlane(kdst+(slot)))
  #define DMA_V(t,slot) do{ glds16(vsrc+(long)(t)*KVBLK*DM,(unsigned)__builtin_amdgcn_readfirstlane(vdst+2*(slot))); glds16(vsrc+64+(long)(t)*KVBLK*DM,(unsigned)__builtin_amdgcn_readfirstlane(vdst+2*(slot)+8192)); }while(0)
  const int vb0=(int)(lds0+LDS_V)+((lane>>4)&1)*32+(lane&3)*8+(4*hi+((lane&15)>>2))*64;
  const char*Kbase=shm+LDS_K; bf16x8 kf[8];
  const lds_cptr shm3=(lds_cptr)shm; const lds_cptr kp0=shm3+LDS_K+hi*1024+r32*16; const lds_cptr vp0=shm3+LDS_V+((lane>>4)&1)*32+(lane&3)*8+(4*hi+((lane&15)>>2))*64;
  const int NT=(q0+QB)/KVBLK;
  DMA_K(0,0);DMA_V(0,0);DMA_K(1,SLOTB);
  bf16x8 qr[4];
  #pragma unroll
  for(int d0=0;d0<4;++d0)qr[d0]=*reinterpret_cast<const bf16x8*>(&Qw[(long)r32*DM+d0*16+hi*8]);
  float mhat=0.f,l_reg=0.f;f32x16 o[4];o[0]=f32x16{};o[1]=f32x16{};o[2]=f32x16{};o[3]=f32x16{};const f32x16 negm=f32x16{};
  const int qrel=wid*QBLK+r32;
  #define CMASK(P0,P1,t) do{int jb_=(t)-(NT-4); if(jb_>=0)cmask(P0,P1,jb_,qrel,hi);}while(0)
  bool resc=false;
  #define START(P0,P1) do{ const float rm=rowmax(P0,P1); resc=false; \
    { const float dl=rm; mhat=fadd_s(mhat,dl); \
      _Pragma("unroll") for(int r=0;r<16;++r){P0[r]=fsub_s(P0[r],dl);P1[r]=fsub_s(P1[r],dl);} \
      } \
    _Pragma("unroll") for(int r=0;r<16;++r)P0[r]=__builtin_amdgcn_exp2f(P0[r]); }while(0)
  #define RESC() do{ if(resc){ asm volatile("s_waitcnt lgkmcnt(0)":::"memory"); \
      _Pragma("unroll") for(int d_=0;d_<4;++d_) _Pragma("unroll") for(int r=0;r<16;++r)o[d_][r]*=wsf[crow(r,hi)]; } }while(0)
  f32x16 pA0,pA1,pB0,pB1;
  int sl_prev=0,sl_cur=0,sl_next=SLOTB;
  #define ROT() do{sl_prev=sl_cur;sl_cur=sl_next;sl_next=(sl_next==(NSLOT-1)*SLOTB)?0:sl_next+SLOTB;}while(0)
  DMA_K(2,2*SLOTB);
  WAIT_BAR(4);
  qkt(pA0,pA1,Kbase,qr,negm,r32,hi);asm volatile("s_nop 15\n\ts_nop 7":"+v"(pA0),"+v"(pA1));CMASK(pA0,pA1,0);
  START(pA0,pA1);
  _Pragma("unroll") for(int r=0;r<16;++r)pA1[r]=__builtin_amdgcn_exp2f(pA1[r]);
  WAIT_BAR(0);
  DMA_K(3,0);DMA_V(1,SLOTB);
  ROT();
  kload8(kf,kp0+sl_cur);
  WAIT_BAR(3);
  s16x4 vlo[8],vhi[8]; u32x4 pw0,pw1,pw2,pw3;
  #define PKW(P,B) cvtpk_s(P[B],P[B+1])
  #define PAF(k) __builtin_bit_cast(bf16x8,pw##k)
  #define VFR(i) (bf16x8){vlo[i][0],vlo[i][1],vlo[i][2],vlo[i][3],vhi[i][0],vhi[i][1],vhi[i][2],vhi[i][3]}
  #define PIN(x) asm volatile("":"+v"(x))
  #define MX3(a,b,c) __builtin_fmaxf(__builtin_fmaxf((a),(b)),(c))
  #define GAPA(MF,A0,A1,A2,A3,W0,W1,PW) do{ MF; sacc+=A0; sacc+=A1; sacc+=A2; sacc+=A3; PIN(sacc); W0; W1; PIN(PW); SBAR(); }while(0)
  #define EX(v) __builtin_amdgcn_exp2f(v)
  #define GAPB(MF,X,B) do{ MF; X[B]=EX(X[B]); X[B+1]=EX(X[B+1]); X[B+2]=EX(X[B+2]); X[B+3]=EX(X[B+3]); PIN(X); SBAR(); }while(0)
  #define GAPB2(MF,X,B) do{ MF; X[B]=EX(X[B]); X[B+1]=EX(X[B+1]); PIN(X); SBAR(); }while(0)
  #define VRD2(i) do{ vlo[i]=vtr(vp_+(8192+((i)>>2)*4096+((i)&3)*1024)); vhi[i]=vtr(vp_+(8192+((i)>>2)*4096+((i)&3)*1024+512)); }while(0)
  #define VRD(i) do{ vlo[i]=vtr(vp_+(((i)>>2)*4096+((i)&3)*1024)); vhi[i]=vtr(vp_+(((i)>>2)*4096+((i)&3)*1024+512)); }while(0)
  #define KRD(G,j) do{ if(G){ kload2(kf,kp0+sl_next,j); SBAR(); } }while(0)
  #define STEP(C0,C1,P0,P1,t,GK,GV,GL) do{ SBAR(); \
    const lds_cptr vp_=vp0+2*sl_prev; \
    VRD(0); SBAR(); float sacc=(P0[0]+P0[1]); \
    GAPA(C0=__builtin_amdgcn_mfma_f32_32x32x16_bf16(kf[0],qr[0],negm,0,0,0), P0[2],P0[3],P0[4],P0[5],     pw0[0]=PKW(P0,0), pw0[1]=PKW(P0,2), pw0); \
    VRD(4); SBAR(); GAPA(C1=__builtin_amdgcn_mfma_f32_32x32x16_bf16(kf[1],qr[0],negm,0,0,0), P0[6],P0[7],P0[8],P0[9],     pw0[2]=PKW(P0,4), pw0[3]=PKW(P0,6), pw0); \
    VRD(1); SBAR(); GAPA(C0=__builtin_amdgcn_mfma_f32_32x32x16_bf16(kf[2],qr[1],C0,0,0,0),   P0[10],P0[11],P0[12],P0[13], pw1[0]=PKW(P0,8), pw1[1]=PKW(P0,10), pw1); \
    VRD(5); SBAR(); GAPA(C1=__builtin_amdgcn_mfma_f32_32x32x16_bf16(kf[3],qr[1],C1,0,0,0),   P0[14],P0[15],P1[0],P1[1],   pw1[2]=PKW(P0,12),pw1[3]=PKW(P0,14), pw1); \
    VRD(2); SBAR(); GAPA(C0=__builtin_amdgcn_mfma_f32_32x32x16_bf16(kf[4],qr[2],C0,0,0,0),   P1[2],P1[3],P1[4],P1[5],     pw2[0]=PKW(P1,0), pw2[1]=PKW(P1,2), pw2); \
    VRD(6); SBAR(); GAPA(C1=__builtin_amdgcn_mfma_f32_32x32x16_bf16(kf[5],qr[2],C1,0,0,0),   P1[6],P1[7],P1[8],P1[9],     pw2[2]=PKW(P1,4), pw2[3]=PKW(P1,6), pw2); \
    VRD(3); SBAR(); GAPA(C0=__builtin_amdgcn_mfma_f32_32x32x16_bf16(kf[6],qr[3],C0,0,0,0),   P1[10],P1[11],P1[12],P1[13], pw3[0]=PKW(P1,8), pw3[1]=PKW(P1,10), pw3); \
    VRD(7); SBAR(); GAPA(C1=__builtin_amdgcn_mfma_f32_32x32x16_bf16(kf[7],qr[3],C1,0,0,0),   P1[14],P1[15],0.f,0.f,       pw3[2]=PKW(P1,12),pw3[3]=PKW(P1,14), pw3); \
    l_reg+=sacc; \
    if(GK){DMA_K((t)+3,sl_cur);} if(GV){DMA_V((t)+1,sl_next);} \
    _Pragma("unroll") for(int r=0;r<16;++r){C0[r]-=mhat;C1[r]-=mhat;} \
    CMASK(C0,C1,t); \
    { float a=MX3(C0[0],C0[1],C1[0]),b=MX3(C0[2],C0[3],C1[1]); a=MX3(a,C1[2],C1[3]); \
      _Pragma("unroll") for(int r=4;r<16;r+=4){a=MX3(a,C0[r],C0[r+1]);b=MX3(b,C0[r+2],C0[r+3]);a=MX3(a,C1[r],C1[r+1]);b=MX3(b,C1[r+2],C1[r+3]);} \
      float rm=__builtin_fmaxf(a,b); { auto rr=__builtin_amdgcn_permlane32_swap(__float_as_uint(rm),__float_as_uint(rm),false,false); rm=__builtin_fmaxf(__uint_as_float(rr[0]),__uint_as_float(rr[1])); } \
      resc=false; \
      if(__builtin_expect(__any(rm>(float)THRL),0)){ const float dl=__builtin_fmaxf(rm,0.f); mhat+=dl; \
        _Pragma("unroll") for(int r=0;r<16;++r){C0[r]-=dl;C1[r]-=dl;} \
        const float f=__builtin_amdgcn_exp2f(-dl); l_reg*=f; if(hi==0)wsf[r32]=f; resc=true; } } \
    SBAR(); \
    GAPB2(o[0]=__builtin_amdgcn_mfma_f32_32x32x16_bf16(PAF(0),VFR(0),o[0],0,0,0), C0,0); VRD2(0); SBAR(); \
    GAPB2(o[1]=__builtin_amdgcn_mfma_f32_32x32x16_bf16(PAF(0),VFR(4),o[1],0,0,0), C0,2); VRD2(4); SBAR(); \
    KRD(GL,0); GAPB2(o[0]=__builtin_amdgcn_mfma_f32_32x32x16_bf16(PAF(1),VFR(1),o[0],0,0,0), C0,4); VRD2(1); SBAR(); \
    KRD(GL,1); GAPB2(o[1]=__builtin_amdgcn_mfma_f32_32x32x16_bf16(PAF(1),VFR(5),o[1],0,0,0), C0,6); VRD2(5); SBAR(); \
    KRD(GL,2); GAPB2(o[0]=__builtin_amdgcn_mfma_f32_32x32x16_bf16(PAF(2),VFR(2),o[0],0,0,0), C0,8); VRD2(2); SBAR(); \
    KRD(GL,3); GAPB2(o[1]=__builtin_amdgcn_mfma_f32_32x32x16_bf16(PAF(2),VFR(6),o[1],0,0,0), C0,10); VRD2(6); SBAR(); \
    GAPB2(o[0]=__builtin_amdgcn_mfma_f32_32x32x16_bf16(PAF(3),VFR(3),o[0],0,0,0), C0,12); VRD2(3); SBAR(); \
    GAPB2(o[1]=__builtin_amdgcn_mfma_f32_32x32x16_bf16(PAF(3),VFR(7),o[1],0,0,0), C0,14); VRD2(7); SBAR(); \
    GAPB2(o[2]=__builtin_amdgcn_mfma_f32_32x32x16_bf16(PAF(0),VFR(0),o[2],0,0,0), C1,0); \
    GAPB2(o[3]=__builtin_amdgcn_mfma_f32_32x32x16_bf16(PAF(0),VFR(4),o[3],0,0,0), C1,2); \
    GAPB2(o[2]=__builtin_amdgcn_mfma_f32_32x32x16_bf16(PAF(1),VFR(1),o[2],0,0,0), C1,4); \
    GAPB2(o[3]=__builtin_amdgcn_mfma_f32_32x32x16_bf16(PAF(1),VFR(5),o[3],0,0,0), C1,6); \
    GAPB2(o[2]=__builtin_amdgcn_mfma_f32_32x32x16_bf16(PAF(2),VFR(2),o[2],0,0,0), C1,8); \
    GAPB2(o[3]=__builtin_amdgcn_mfma_f32_32x32x16_bf16(PAF(2),VFR(6),o[3],0,0,0), C1,10); \
    GAPB2(o[2]=__builtin_amdgcn_mfma_f32_32x32x16_bf16(PAF(3),VFR(3),o[2],0,0,0), C1,12); \
    GAPB2(o[3]=__builtin_amdgcn_mfma_f32_32x32x16_bf16(PAF(3),VFR(7),o[3],0,0,0), C1,14); \
    }while(0)
  int t=1;
  #undef CMASK
  #define CMASK(P0,P1,t) do{}while(0)
  for(;t+5<NT;t+=2){
    STEP(pB0,pB1,pA0,pA1,t,true,true,true);     WAIT_BAR(3); RESC(); ROT();
    STEP(pA0,pA1,pB0,pB1,t+1,true,true,true);   WAIT_BAR(3); RESC(); ROT();
  }
  #undef CMASK
  #define CMASK(P0,P1,t) do{int jb_=(t)-(NT-4); if(jb_>=0)cmask(P0,P1,jb_,qrel,hi);}while(0)
  #define ENDW(tt) do{ if((tt)+3<NT){WAIT_BAR(3);} else if((tt)+2<NT){WAIT_BAR(2);} else {WAIT_BAR(0);} }while(0)
  for(;t+1<NT;t+=2){
    STEP(pB0,pB1,pA0,pA1,t,(t+3<NT),(t+1<NT),(t+1<NT));       ENDW(t);   RESC(); ROT();
    STEP(pA0,pA1,pB0,pB1,t+1,(t+4<NT),(t+2<NT),(t+2<NT));     ENDW(t+1); RESC(); ROT();
  }
  STEP(pB0,pB1,pA0,pA1,NT-1,false,false,false); RESC();
  { float sacc=pB0[0]+pB0[1]; _Pragma("unroll") for(int r=2;r<16;++r)sacc+=pB0[r]; _Pragma("unroll") for(int r=0;r<16;++r)sacc+=pB1[r]; l_reg+=sacc;
    pw0=(u32x4){PKW(pB0,0),PKW(pB0,2),PKW(pB0,4),PKW(pB0,6)};pw1=(u32x4){PKW(pB0,8),PKW(pB0,10),PKW(pB0,12),PKW(pB0,14)};pw2=(u32x4){PKW(pB1,0),PKW(pB1,2),PKW(pB1,4),PKW(pB1,6)};pw3=(u32x4){PKW(pB1,8),PKW(pB1,10),PKW(pB1,12),PKW(pB1,14)};
    SBAR(); pv(o,vb0+2*sl_cur,PAF(0),PAF(1),PAF(2),PAF(3)); }
  #undef PKW
  #undef PAF
  #undef VFR
  #undef PIN
  #undef MX3
  #undef GAPA
  #undef GAPB
  #undef EX
  #undef VRD
  #undef VRD2
  #undef GAPB2
  #undef KRD
  #undef STEP
  #undef ENDW
  {auto rr=__builtin_amdgcn_permlane32_swap(__float_as_uint(l_reg),__float_as_uint(l_reg),false,false);l_reg=__uint_as_float(rr[0])+__uint_as_float(rr[1]);}
  if(hi==0)wsf[32+r32]=l_reg;asm volatile("s_waitcnt lgkmcnt(0)":::"memory");
  float rli[16];
  #pragma unroll
  for(int r=0;r<16;++r)rli[r]=__builtin_amdgcn_rcpf(wsf[32+crow(r,hi)]);
  bf16*Ow=O+(rowbase+q0+wid*QBLK)*OP+os*D;
  { bf16*stg=(bf16*)(shm+LDS_OST)+wid*2048;
    #pragma unroll
    for(int hh=0;hh<2;++hh){
    #pragma unroll
    for(int r=0;r<16;++r){const int orow=crow(r,hi);
      #pragma unroll
      for(int d0=0;d0<2;++d0)stg[orow*64+d0*32+r32]=__float2bfloat16(o[2*hh+d0][r]*rli[r]);}
    asm volatile("s_waitcnt lgkmcnt(0)":::"memory");
    #pragma unroll
    for(int i=0;i<4;++i){const int row=i*8+(lane>>3),ch=lane&7; const u32x4 v=*(const u32x4*)(stg+row*64+ch*8); ATTN_STORE16(Ow+(long)row*OP+hh*64+ch*8,v);}
    asm volatile("s_waitcnt lgkmcnt(0)":::"memory"); } }
  asm volatile("s_waitcnt lgkmcnt(0)\n\ts_barrier":::"memory");
  #undef DMA_K
  #undef DMA_V
  #undef CMASK
  #undef START
  #undef RESC
  #undef ROT
}
constexpr int ATTN_LDS_BYTES=LDS_BYTES;
#undef SBAR
#undef WAIT_BAR
}


constexpr int NB = 16, T = 4096, D = 1024, M = NB * T, INW = 6144, FF = 2816, NG = 64, NP = 64;
constexpr float LN_EPS = 1e-5f, RMS_EPS = 1e-5f;
constexpr float DN_ALPHA = 1.189207115002721f;
constexpr float LAMBDA_INIT = 0.2f;
constexpr int NWAVES = 8, NTHREADS = 512;
constexpr size_t MiB = 1u << 20;
constexpr size_t WS_MODP = 0;
constexpr size_t WS_MOD = 6 * MiB;
constexpr size_t WS_WIN = 8 * MiB, WS_WGLU = 20 * MiB, WS_WBS = 22 * MiB, WS_WBA = 24 * MiB, WS_WOUT = 26 * MiB, WS_WUP = 28 * MiB, WS_WDOWN = 40 * MiB;
constexpr size_t WS_PROJ = 64 * MiB;
constexpr size_t WS_HB = 832 * MiB;
constexpr size_t WS_END = 960 * MiB;
constexpr int LDS_BYTES = 147456;
constexpr size_t WS_CTL = 7 * MiB, CTL_ZERO_BYTES = 64 * 1024;
constexpr int CW_BAR = 1024, CW_QUEUE = 8192;
constexpr int LDSCTL_OFF = 131072, MISC_OFF = LDSCTL_OFF + 320;

#define GAS __attribute__((address_space(1)))
#define LAS __attribute__((address_space(3)))
typedef unsigned short bf16;
typedef unsigned v4u __attribute__((ext_vector_type(4)));
typedef unsigned v2u __attribute__((ext_vector_type(2)));
typedef float f32x4 __attribute__((ext_vector_type(4)));
typedef float f32x16 __attribute__((ext_vector_type(16)));
typedef short bf16x8 __attribute__((ext_vector_type(8)));
#define LDS_WAIT() asm volatile("s_waitcnt lgkmcnt(0)" ::: "memory")
__device__ __forceinline__ unsigned f2bf(float f) { unsigned u = __builtin_bit_cast(unsigned, f); return (u + 0x7fffu + ((u >> 16) & 1u)) >> 16; }
typedef float f32x2_t __attribute__((ext_vector_type(2))); typedef __bf16 bf16x2_t __attribute__((ext_vector_type(2)));
__device__ __forceinline__ unsigned pk2(float lo, float hi) { f32x2_t v = {lo, hi}; bf16x2_t b = __builtin_convertvector(v, bf16x2_t); return __builtin_bit_cast(unsigned, b); }
__device__ __forceinline__ float bfl(unsigned u) { return __uint_as_float(u << 16); }
__device__ __forceinline__ float bfh(unsigned u) { return __uint_as_float(u & 0xffff0000u); }
__device__ __forceinline__ float wave_sum(float v) {
#pragma unroll
    for (int o = 1; o < 64; o <<= 1) v += __shfl_xor(v, o);
    return v;
}
__device__ __forceinline__ float sigm(float x) { return 1.0f / (1.0f + __expf(-x)); }

struct Args { const float* in[31]; float* out; unsigned char* ws; };
typedef const Args __attribute__((address_space(4)))* KArgs;
__device__ __forceinline__ KArgs kargs() { unsigned long long p = (unsigned long long)__builtin_amdgcn_kernarg_segment_ptr(); asm volatile("" : "+s"(p)); return (KArgs)p; }

typedef GAS unsigned gu32;
#define XB_TMO      128
#define XB_XCNT(j)  (256  + 64 * (j))
#define XB_XSUB(j)  (1280 + 64 * (j))
#define XB_XGEN(j)  (2304 + 64 * (j))
#define XB_TOP      3328
#define XB_TOPGEN   3392
#define XCD_BAR_WORDS 3456
#define XB_SPIN_CAP (1u << 18)

__device__ __forceinline__ unsigned xb_ld(unsigned* p)              { return __hip_atomic_load(p, __ATOMIC_RELAXED, __HIP_MEMORY_SCOPE_AGENT); }
__device__ __forceinline__ unsigned xb_add(unsigned* p, unsigned v) { return __hip_atomic_fetch_add(p, v, __ATOMIC_RELAXED, __HIP_MEMORY_SCOPE_AGENT); }
__device__ __forceinline__ unsigned xb_xcc_id() { return (unsigned)__builtin_amdgcn_s_getreg((3 << 11) | 20) & 0xFu; }
#define XB_SPIN(cond, bar) do { unsigned _sp = 0; while (cond) { __builtin_amdgcn_s_sleep(1); \
    if ((++_sp & 255u) == 0u) { if (xb_ld(&(bar)[XB_TMO])) break; if (_sp > XB_SPIN_CAP) { atomicAdd(&(bar)[XB_TMO], 1u); break; } } } } while (0)

struct XcdBarrier {
    unsigned* bar; unsigned x;
    volatile LAS unsigned* st;
};

__device__ __forceinline__ XcdBarrier xcd_barrier_post(unsigned* bar, volatile LAS unsigned* st) {
    XcdBarrier b; b.bar = bar; b.x = xb_xcc_id(); b.st = st;
    if (threadIdx.x == 0) (void)xb_add(&bar[XB_XCNT(b.x)], 1u);
    return b;
}
__device__ __forceinline__ void xcd_barrier_complete(unsigned* bar, unsigned x, unsigned& nloc, unsigned& nx) {
    const unsigned G = gridDim.x * gridDim.y * gridDim.z;
    unsigned sum, cnt, mine, sp = 0u;
    for (;;) {
        sum = 0u; cnt = 0u; mine = 0u;
#pragma unroll
        for (unsigned j = 0; j < 16; ++j) { const unsigned c = xb_ld(&bar[XB_XCNT(j)]); sum += c; cnt += (c > 0u) ? 1u : 0u; mine = (j == x) ? c : mine; }
        if (sum == G) break;
        __builtin_amdgcn_s_sleep(1);
        if ((++sp & 255u) == 0u) { if (xb_ld(&bar[XB_TMO])) break; if (sp > XB_SPIN_CAP) { atomicAdd(&bar[XB_TMO], 1u); break; } }
    }
    nloc = mine > 0u ? mine : 1u; nx = cnt > 0u ? cnt : 1u;
}

__device__ __forceinline__ void xcd_barrier(const XcdBarrier& b) {
    asm volatile("s_waitcnt vmcnt(0)" ::: "memory");
    __syncthreads();
    if (threadIdx.x == 0) {
        unsigned* bar = b.bar;
        __builtin_amdgcn_s_waitcnt(0);
        unsigned nloc = b.st[0], nx = b.st[1];
        if (nloc == 0u) { xcd_barrier_complete(bar, b.x, nloc, nx); b.st[0] = nloc; b.st[1] = nx; }
        const unsigned old = xb_add(&bar[XB_XSUB(b.x)], 1u);
        const unsigned gen = old / nloc;
        if (old + 1u == (gen + 1u) * nloc) {
            __builtin_amdgcn_fence(__ATOMIC_RELEASE, "agent");
            asm volatile("s_waitcnt vmcnt(0)" ::: "memory");
            const unsigned og = xb_add(&bar[XB_TOP], 1u);
            const unsigned tg = og / nx;
            if (og + 1u == (tg + 1u) * nx) xb_add(&bar[XB_TOPGEN], 1u);
            else XB_SPIN(xb_ld(&bar[XB_TOPGEN]) == tg, bar);
            __builtin_amdgcn_fence(__ATOMIC_ACQUIRE, "agent");
            xb_add(&bar[XB_XGEN(b.x)], 1u);
            asm volatile("s_waitcnt vmcnt(0)" ::: "memory");
        } else {
            XB_SPIN(xb_ld(&bar[XB_XGEN(b.x)]) == gen, bar);
            __builtin_amdgcn_fence(__ATOMIC_ACQUIRE, "agent");
            asm volatile("s_waitcnt vmcnt(0)" ::: "memory");
        }
    }
    __syncthreads();
}


template <bool UPPERM = false> __device__ __forceinline__ void p0_transpose_item(const float* W, int K, int N, bf16* WT, LAS float* scr, int item, int lane) {
    const int nblk = N / 32, kb = item / nblk, nb = item % nblk, k0 = 64 * kb, n0 = 32 * nb;
#pragma unroll 8
    for (int i = 0; i < 32; ++i) { const int kk = 2 * i + (lane >> 5); scr[kk * 33 + (lane & 31)] = W[(size_t)(k0 + kk) * N + n0 + (lane & 31)]; }
    LDS_WAIT(); asm volatile("" ::: "memory");
    const int c = lane & 7;
#pragma unroll
    for (int j = 0; j < 4; ++j) { const int n = (lane >> 3) + 8 * j; const LAS float* s = scr + (8 * c) * 33 + n;
        v4u o; o.x = pk2(s[0 * 33], s[1 * 33]); o.y = pk2(s[2 * 33], s[3 * 33]); o.z = pk2(s[4 * 33], s[5 * 33]); o.w = pk2(s[6 * 33], s[7 * 33]);
        int dr = n0 + n; if (UPPERM) { const int f = dr >= FF ? dr - FF : dr; dr = 8 * (f >> 2) + (dr >= FF ? 4 : 0) + (f & 3); }
        *(v4u*)(WT + (size_t)dr * K + k0 + 8 * c) = o; }
    LDS_WAIT(); asm volatile("" ::: "memory");
}

__device__ __forceinline__ void p0_mod_item(const float* c, const float* w_mod, const float* b_mod, float* part, int item, int lane) {
    const int cgp = item % 96, ks = item / 96, col = cgp * 64 + lane;
    float acc[16];
#pragma unroll
    for (int b = 0; b < 16; ++b) acc[b] = 0.f;
    for (int kk = 0; kk < 64; ++kk) {
        const int k = ks * 64 + kk;
        const float w = w_mod[(size_t)k * INW + col];
#pragma unroll
        for (int b = 0; b < 16; ++b) { const float cv = c[b * D + k]; acc[b] += (cv * sigm(cv)) * w; }
    }
    const float bm = (ks == 0) ? b_mod[col] : 0.f;
#pragma unroll
    for (int b = 0; b < 16; ++b) part[((size_t)ks * 16 + b) * INW + col] = acc[b] + bm;
}


__device__ __forceinline__ void ldrow(const float* p, int lane, f32x4 (&v)[4]) { const f32x4* xr = (const f32x4*)p + lane;
#pragma unroll
    for (int j = 0; j < 4; ++j) v[j] = xr[64 * j]; }
__device__ __forceinline__ void row_stats2(const f32x4 (&a)[4], const f32x4 (&b)[4], float& ma, float& ra, float& mb, float& rb) {
    float sa = 0.f, qa = 0.f, sb = 0.f, qb = 0.f;
#pragma unroll
    for (int j = 0; j < 4; ++j) { sa += (a[j].x + a[j].y) + (a[j].z + a[j].w); qa += (a[j].x * a[j].x + a[j].y * a[j].y) + (a[j].z * a[j].z + a[j].w * a[j].w);
                                  sb += (b[j].x + b[j].y) + (b[j].z + b[j].w); qb += (b[j].x * b[j].x + b[j].y * b[j].y) + (b[j].z * b[j].z + b[j].w * b[j].w); }
#pragma unroll
    for (int o = 1; o < 64; o <<= 1) { sa += __shfl_xor(sa, o); qa += __shfl_xor(qa, o); sb += __shfl_xor(sb, o); qb += __shfl_xor(qb, o); }
    ma = sa * (1.f / D); mb = sb * (1.f / D);
    ra = 1.f / sqrtf(fmaxf(qa * (1.f / D) - ma * ma, 0.f) + LN_EPS); rb = 1.f / sqrtf(fmaxf(qb * (1.f / D) - mb * mb, 0.f) + LN_EPS);
}
__device__ __forceinline__ void st_bf16row(bf16* orow, int lane, const f32x4 (&y)[4]) { v2u* o8 = (v2u*)orow + lane;
#pragma unroll
    for (int j = 0; j < 4; ++j) { v2u w; w.x = pk2(y[j].x, y[j].y); w.y = pk2(y[j].z, y[j].w); o8[64 * j] = w; } }
template <int MODE> __device__ __forceinline__ void ln_pass(const float* src, float* dstf, bf16* dsth, const float* g, const float* bta, const float* mod, int sh_off, int sc_off, int gw, int NGW, int lane) {
    f32x4 ca[4], cb[4], na[4], nb[4];
    int m = gw;
    if (m < M) { ldrow(src + (size_t)m * D, lane, ca); ldrow(src + (size_t)(m + NGW) * D, lane, cb); }
    for (; m < M; m += 2 * NGW) {
        const int mn = m + 2 * NGW;
        if (mn < M) { ldrow(src + (size_t)mn * D, lane, na); ldrow(src + (size_t)(mn + NGW) * D, lane, nb); }
        float ma, ra, mb, rb; row_stats2(ca, cb, ma, ra, mb, rb);
        if (MODE == 0) {
            const float* moda = mod + (size_t)(m >> 12) * INW; const float* modb = mod + (size_t)((m + NGW) >> 12) * INW;
#pragma unroll
            for (int j = 0; j < 4; ++j) { const f32x4 sca = ((const f32x4*)(moda + sc_off))[lane + 64 * j], sha = ((const f32x4*)(moda + sh_off))[lane + 64 * j];
                                          const f32x4 scb = ((const f32x4*)(modb + sc_off))[lane + 64 * j], shb = ((const f32x4*)(modb + sh_off))[lane + 64 * j];
                ca[j] = (ca[j] - ma) * ra * (sca + 1.0f) + sha; cb[j] = (cb[j] - mb) * rb * (scb + 1.0f) + shb; }
            st_bf16row(dsth + (size_t)m * D, lane, ca); st_bf16row(dsth + (size_t)(m + NGW) * D, lane, cb);
        } else {
#pragma unroll
            for (int j = 0; j < 4; ++j) { const f32x4 gg = ((const f32x4*)g)[lane + 64 * j], bb = ((const f32x4*)bta)[lane + 64 * j];
                ca[j] = (ca[j] - ma) * ra * gg + bb; cb[j] = (cb[j] - mb) * rb * gg + bb;
                ((f32x4*)(dstf + (size_t)m * D))[lane + 64 * j] = ca[j]; ((f32x4*)(dstf + (size_t)(m + NGW) * D))[lane + 64 * j] = cb[j]; }
            if (MODE == 1) {
                row_stats2(ca, cb, ma, ra, mb, rb);
                const float* moda = mod + (size_t)(m >> 12) * INW; const float* modb = mod + (size_t)((m + NGW) >> 12) * INW;
#pragma unroll
                for (int j = 0; j < 4; ++j) { const f32x4 sca = ((const f32x4*)(moda + sc_off))[lane + 64 * j], sha = ((const f32x4*)(moda + sh_off))[lane + 64 * j];
                                              const f32x4 scb = ((const f32x4*)(modb + sc_off))[lane + 64 * j], shb = ((const f32x4*)(modb + sh_off))[lane + 64 * j];
                    ca[j] = (ca[j] - ma) * ra * (sca + 1.0f) + sha; cb[j] = (cb[j] - mb) * rb * (scb + 1.0f) + shb; }
                st_bf16row(dsth + (size_t)m * D, lane, ca); st_bf16row(dsth + (size_t)(m + NGW) * D, lane, cb);
            }
        }
#pragma unroll
        for (int j = 0; j < 4; ++j) { ca[j] = na[j]; cb[j] = nb[j]; }
    }
}

__device__ __forceinline__ float gelu_tanh(float x) {
    const float u = 0.7978845608028654f * (x + 0.044715f * x * x * x);
    return x * __builtin_amdgcn_rcpf(1.0f + __expf(-2.0f * u));
}
__device__ __forceinline__ bf16x8 pack8(const float (&f)[8]) {
    v4u w; w.x = pk2(f[0], f[1]); w.y = pk2(f[2], f[3]); w.z = pk2(f[4], f[5]); w.w = pk2(f[6], f[7]); return __builtin_bit_cast(bf16x8, w);
}

__device__ __forceinline__ void ssm_item(KArgs a, int g, int bp, LAS unsigned char* wl, int lane) {
    const float* lam_re = a->in[5]; const float* lam_im = a->in[6]; const float* log_dt = a->in[7];
    const float* b_re = a->in[8]; const float* b_im = a->in[9]; const float* c_re = a->in[10]; const float* c_im = a->in[11]; const float* dsk = a->in[12];
    const bf16* proj = (const bf16*)(a->ws + WS_PROJ); bf16* zb = (bf16*)(a->ws + WS_HB);
    const int r = lane & 31, h = lane >> 5;
    const float dt = expf(log_dt[g]);
    float are[2], aim[2];
    bf16x8 bfr[4];
#pragma unroll
    for (int i = 0; i < 2; ++i) {
        const int p = r + 32 * i; const float lr = lam_re[g * NP + p], li = lam_im[g * NP + p];
        const float mag = expf(lr * dt), ar = mag * cosf(li * dt), ai = mag * sinf(li * dt);
        const float den = lr * lr + li * li, nr = ar - 1.0f, ni = ai;
        const float cr = (nr * lr + ni * li) / den, ci = (ni * lr - nr * li) / den;
        are[i] = ar; aim[i] = ai;
        const float* br = b_re + ((size_t)(g * NP + p)) * 16 + 8 * h; const float* bi = b_im + ((size_t)(g * NP + p)) * 16 + 8 * h;
        float fre[8], fim[8];
#pragma unroll
        for (int j = 0; j < 8; ++j) { fre[j] = cr * br[j] - ci * bi[j]; fim[j] = cr * bi[j] + ci * br[j]; }
        bfr[i] = pack8(fre); bfr[2 + i] = pack8(fim);
    }
    const int cch = lane & 15, kg = lane >> 4;
    bf16x8 cfr[4], dfr;
#pragma unroll
    for (int s = 0; s < 4; ++s) {
        const int p0 = 8 * s + 2 * kg; const float* cr = c_re + ((size_t)(g * 16 + cch)) * NP; const float* ci = c_im + ((size_t)(g * 16 + cch)) * NP;
        float f[8] = {cr[p0], -ci[p0], cr[p0 + 32], -ci[p0 + 32], cr[p0 + 1], -ci[p0 + 1], cr[p0 + 33], -ci[p0 + 33]};
        cfr[s] = pack8(f);
    }
    { float f[8];
#pragma unroll
      for (int j = 0; j < 8; ++j) f[j] = (kg < 2 && (8 * kg + j) == cch) ? dsk[g * 16 + cch] : 0.f;
      dfr = pack8(f); }
    const int b0 = 2 * bp;
    const int beta_r = (r >> 2) & 1, tok_r = 4 * (r >> 3) + (r & 3);
    const bf16* ua = proj + ((size_t)(b0 + beta_r) * T + tok_r) * INW + g * 16 + 8 * h;
    const bf16* ud = proj + ((size_t)b0 * T + cch) * INW + g * 16 + 8 * (kg & 1);
    bf16* zo = zb + ((size_t)b0 * T + 4 * kg) * D + g * 16 + cch;
    float sr[2] = {0.f, 0.f}, si[2] = {0.f, 0.f};
    LAS unsigned char* wrow = wl + (16 * h) * 272 + 8 * r;
    const LAS unsigned char* rrow = wl + cch * 272 + 16 * kg;
    bf16x8 af = *(const bf16x8*)(ua);
    for (int t0 = 0; t0 < T; t0 += 16) {
        const bf16x8 afc = af;
        if (t0 + 16 < T) af = *(const bf16x8*)(ua + (size_t)(t0 + 16) * INW);
        bf16x8 u0 = {0, 0, 0, 0, 0, 0, 0, 0}, u1 = {0, 0, 0, 0, 0, 0, 0, 0};
        if (kg < 2) { u0 = *(const bf16x8*)(ud + (size_t)t0 * INW); u1 = *(const bf16x8*)(ud + (size_t)(T + t0) * INW); }
        const f32x16 zz = {0.f, 0.f, 0.f, 0.f, 0.f, 0.f, 0.f, 0.f, 0.f, 0.f, 0.f, 0.f, 0.f, 0.f, 0.f, 0.f};
        const f32x16 bre0 = __builtin_amdgcn_mfma_f32_32x32x16_bf16(afc, bfr[0], zz, 0, 0, 0);
        const f32x16 bre1 = __builtin_amdgcn_mfma_f32_32x32x16_bf16(afc, bfr[1], zz, 0, 0, 0);
        const f32x16 bim0 = __builtin_amdgcn_mfma_f32_32x32x16_bf16(afc, bfr[2], zz, 0, 0, 0);
        const f32x16 bim1 = __builtin_amdgcn_mfma_f32_32x32x16_bf16(afc, bfr[3], zz, 0, 0, 0);
#pragma unroll
        for (int t = 0; t < 16; ++t) {
            const float nr0 = are[0] * sr[0] - aim[0] * si[0] + bre0[t], ni0 = are[0] * si[0] + aim[0] * sr[0] + bim0[t];
            const float nr1 = are[1] * sr[1] - aim[1] * si[1] + bre1[t], ni1 = are[1] * si[1] + aim[1] * sr[1] + bim1[t];
            sr[0] = nr0; si[0] = ni0; sr[1] = nr1; si[1] = ni1;
            v2u w; w.x = pk2(nr0, ni0); w.y = pk2(nr1, ni1);
            *(LAS v2u*)(wrow + t * 272) = w;
        }
        LDS_WAIT(); asm volatile("" ::: "memory");
#pragma unroll
        for (int be = 0; be < 2; ++be) {
            f32x4 y = {0.f, 0.f, 0.f, 0.f};
#pragma unroll
            for (int s = 0; s < 4; ++s) { const bf16x8 sa = *(const LAS bf16x8*)(rrow + be * 16 * 272 + 64 * s); y = __builtin_amdgcn_mfma_f32_16x16x32_bf16(sa, cfr[s], y, 0, 0, 0); }
            y = __builtin_amdgcn_mfma_f32_16x16x32_bf16(be ? u1 : u0, dfr, y, 0, 0, 0);
#pragma unroll
            for (int q = 0; q < 4; ++q) zo[((size_t)be * T + t0 + q) * D] = (bf16)pk2(gelu_tanh(y[q]), 0.f);
        }
        LDS_WAIT(); asm volatile("" ::: "memory");
    }
}

struct YRow { v4u a0, a1, b0, b1; };
__device__ __forceinline__ void yatt_load(const bf16* orow, int lane, YRow& r) {
    const int hh = lane >> 3, e0 = (lane & 7) * 16;
    const bf16* p1 = orow + (4 * hh + (e0 >> 6)) * 64 + (e0 & 63);
    r.a0 = *(const v4u*)(p1); r.a1 = *(const v4u*)(p1 + 8); r.b0 = *(const v4u*)(p1 + 128); r.b1 = *(const v4u*)(p1 + 136);
}
__device__ __forceinline__ void yatt_fin(const YRow& r, bf16* yrow, const float (&sg)[16], float lam, int lane) {
    const int hh = lane >> 3, e0 = (lane & 7) * 16;
    float o[16];
#pragma unroll
    for (int i = 0; i < 2; ++i) { const v4u a = i ? r.a1 : r.a0, b = i ? r.b1 : r.b0;
        o[8 * i + 0] = bfl(a.x) - lam * bfl(b.x); o[8 * i + 1] = bfh(a.x) - lam * bfh(b.x); o[8 * i + 2] = bfl(a.y) - lam * bfl(b.y); o[8 * i + 3] = bfh(a.y) - lam * bfh(b.y);
        o[8 * i + 4] = bfl(a.z) - lam * bfl(b.z); o[8 * i + 5] = bfh(a.z) - lam * bfh(b.z); o[8 * i + 6] = bfl(a.w) - lam * bfl(b.w); o[8 * i + 7] = bfh(a.w) - lam * bfh(b.w); }
    float ss = 0.f;
#pragma unroll
    for (int j = 0; j < 16; ++j) ss += o[j] * o[j];
    ss += __shfl_xor(ss, 1); ss += __shfl_xor(ss, 2); ss += __shfl_xor(ss, 4);
    const float rs = 1.f / sqrtf(ss * (1.f / 128.f) + RMS_EPS) * (1.0f - LAMBDA_INIT);
    float y[16];
#pragma unroll
    for (int j = 0; j < 16; ++j) y[j] = o[j] * rs * sg[j];
    v4u w0, w1; w0.x = pk2(y[0], y[1]); w0.y = pk2(y[2], y[3]); w0.z = pk2(y[4], y[5]); w0.w = pk2(y[6], y[7]); w1.x = pk2(y[8], y[9]); w1.y = pk2(y[10], y[11]); w1.z = pk2(y[12], y[13]); w1.w = pk2(y[14], y[15]);
    *(v4u*)(yrow + hh * 128 + e0) = w0; *(v4u*)(yrow + hh * 128 + e0 + 8) = w1;
}
__device__ __forceinline__ void yatt_pass(const bf16* OBp, bf16* PROJp, const float* subg, float lam, int gw, int NGW, int lane) {
    float sg[16];
#pragma unroll
    for (int j = 0; j < 16; ++j) sg[j] = subg[(lane & 7) * 16 + j];
    YRow c0, c1, c2, c3, n0, n1, n2, n3;
    int m = gw;
    if (m < M) { yatt_load(OBp + (size_t)m * 2048, lane, c0); yatt_load(OBp + (size_t)(m + NGW) * 2048, lane, c1); yatt_load(OBp + (size_t)(m + 2 * NGW) * 2048, lane, c2); yatt_load(OBp + (size_t)(m + 3 * NGW) * 2048, lane, c3); }
    for (; m < M; m += 4 * NGW) {
        const int mn = m + 4 * NGW;
        if (mn < M) { yatt_load(OBp + (size_t)mn * 2048, lane, n0); yatt_load(OBp + (size_t)(mn + NGW) * 2048, lane, n1); yatt_load(OBp + (size_t)(mn + 2 * NGW) * 2048, lane, n2); yatt_load(OBp + (size_t)(mn + 3 * NGW) * 2048, lane, n3); }
        yatt_fin(c0, PROJp + (size_t)m * INW + 1024, sg, lam, lane); yatt_fin(c1, PROJp + (size_t)(m + NGW) * INW + 1024, sg, lam, lane);
        yatt_fin(c2, PROJp + (size_t)(m + 2 * NGW) * INW + 1024, sg, lam, lane); yatt_fin(c3, PROJp + (size_t)(m + 3 * NGW) * INW + 1024, sg, lam, lane);
        c0 = n0; c1 = n1; c2 = n2; c3 = n3;
    }
}

__device__ __forceinline__ void up8(const v4u p, float (&f)[8]) { f[0] = bfl(p.x); f[1] = bfh(p.x); f[2] = bfl(p.y); f[3] = bfh(p.y); f[4] = bfl(p.z); f[5] = bfh(p.z); f[6] = bfl(p.w); f[7] = bfh(p.w); }
__device__ __forceinline__ void conv_item(bf16* proj, const float* cw, const float* cb, int item) {
    const int cc = item % (FF / 8), rr = item / (FF / 8), f0 = cc * 8, t0 = rr * 8;
    bf16* base = proj + (size_t)t0 * INW + f0;
    v4u pa[10], pv[8];
    const bool first = (t0 & (T - 1)) == 0;
    const v4u zero4 = {0u, 0u, 0u, 0u};
    pa[0] = first ? zero4 : *(const v4u*)(base - 2 * (size_t)INW); pa[1] = first ? zero4 : *(const v4u*)(base - (size_t)INW);
#pragma unroll
    for (int i = 0; i < 8; ++i) { pa[2 + i] = *(const v4u*)(base + (size_t)i * INW); pv[i] = *(const v4u*)(base + (size_t)i * INW + FF); }
    float w0[8], w1[8], w2[8], bb[8];
#pragma unroll
    for (int j = 0; j < 8; ++j) { w0[j] = cw[f0 + j]; w1[j] = cw[FF + f0 + j]; w2[j] = cw[2 * FF + f0 + j]; bb[j] = cb[f0 + j]; }
    float am2[8], am1[8];
    up8(pa[0], am2); up8(pa[1], am1);
#pragma unroll
    for (int i = 0; i < 8; ++i) {
        float a0[8], vv[8], o[8]; up8(pa[2 + i], a0); up8(pv[i], vv);
#pragma unroll
        for (int j = 0; j < 8; ++j) { const float cv = w0[j] * am2[j] + w1[j] * am1[j] + w2[j] * a0[j] + bb[j]; o[j] = cv * __builtin_amdgcn_rcpf(1.0f + __expf(-cv)) * vv[j]; am2[j] = am1[j]; am1[j] = a0[j]; }
        v4u w; w.x = pk2(o[0], o[1]); w.y = pk2(o[2], o[3]); w.z = pk2(o[4], o[5]); w.w = pk2(o[6], o[7]);
        *(v4u*)(base + (size_t)i * INW + FF) = w;
    }
}

__device__ __forceinline__ void convfix_item(bf16* Gb, const bf16* S0, const bf16* S1, const bf16* S2, const float* cw, const float* cb, int item) {
    const int cc = item % (FF / 8), sj = item / (FF / 8), j = sj & 1, s = sj >> 1, f0 = cc * 8;
    const bool first = (s & 63) == 0;
    const v4u z4 = {0u, 0u, 0u, 0u};
    const v4u l62 = first ? z4 : *(const v4u*)(S2 + ((size_t)(s - 1) * 2 + 0) * FF + f0), l63 = first ? z4 : *(const v4u*)(S2 + ((size_t)(s - 1) * 2 + 1) * FF + f0);
    const v4u a0 = *(const v4u*)(S0 + ((size_t)s * 2 + 0) * FF + f0), a1 = *(const v4u*)(S0 + ((size_t)s * 2 + 1) * FF + f0);
    const v4u vv = *(const v4u*)(S1 + ((size_t)s * 2 + j) * FF + f0);
    float pm2[8], pm1[8], ac[8], vf[8], o[8];
    if (j == 0) { up8(l62, pm2); up8(l63, pm1); up8(a0, ac); } else { up8(l63, pm2); up8(a0, pm1); up8(a1, ac); }
    up8(vv, vf);
#pragma unroll
    for (int q = 0; q < 8; ++q) { const float cv = cw[f0 + q] * pm2[q] + cw[FF + f0 + q] * pm1[q] + cw[2 * FF + f0 + q] * ac[q] + cb[f0 + q]; o[q] = cv * __builtin_amdgcn_rcpf(1.0f + __expf(-cv)) * vf[q]; }
    v4u w; w.x = pk2(o[0], o[1]); w.y = pk2(o[2], o[3]); w.z = pk2(o[4], o[5]); w.w = pk2(o[6], o[7]);
    *(v4u*)(Gb + ((size_t)s * 64 + j) * FF + f0) = w;
}

__global__ void __launch_bounds__(NTHREADS, 2) mk_fwd(Args args) {
    extern __shared__ __attribute__((aligned(16))) unsigned char lds[];
    cg::grid_group grid = cg::this_grid();
    LAS unsigned char* L = (LAS unsigned char*)lds;
    const int tid = threadIdx.x, lane = tid & 63, wave = __builtin_amdgcn_readfirstlane(tid >> 6);
    const int G = gridDim.x, bx = blockIdx.x;
    const int vcu = (G % 8 == 0) ? (bx % 8) * (G / 8) + bx / 8 : bx;
    const int gw = vcu * NWAVES + wave, NGW = G * NWAVES;
    unsigned char* ws = kargs()->ws;
    bf16* WinT = (bf16*)(ws + WS_WIN); bf16* WgluT = (bf16*)(ws + WS_WGLU); bf16* WbsT = (bf16*)(ws + WS_WBS); bf16* WbaT = (bf16*)(ws + WS_WBA);
    bf16* WoutT = (bf16*)(ws + WS_WOUT); bf16* WupT = (bf16*)(ws + WS_WUP); bf16* WdownT = (bf16*)(ws + WS_WDOWN);
    bf16* PROJ = (bf16*)(ws + WS_PROJ); bf16* HB = (bf16*)(ws + WS_HB);
    float* MODP = (float*)(ws + WS_MODP); float* MOD = (float*)(ws + WS_MOD);
    float* OUT = kargs()->out; bf16* OB = (bf16*)kargs()->out;
#define LND(x) ({ int l_ = (x); asm volatile("" : "+v"(l_)); l_; })
#define GSYNC_CG() do { __builtin_amdgcn_fence(__ATOMIC_RELEASE, "agent"); grid.sync(); __builtin_amdgcn_fence(__ATOMIC_ACQUIRE, "agent"); } while (0)
#define GSYNC() xcd_barrier(bar)
    for (int u = tid; u < (LDS_BYTES - LDSCTL_OFF) / 4; u += NTHREADS) ((LAS unsigned*)(L + LDSCTL_OFF))[u] = 0u;
    __syncthreads();
    const XcdBarrier bar = xcd_barrier_post((unsigned*)(ws + WS_CTL) + CW_BAR, (volatile LAS unsigned*)(L + MISC_OFF) + 8);

    {
        LAS float* scr = (LAS float*)(L + wave * 16384);
        constexpr int I_IN = (D / 64) * (INW / 32), I_SQ = (D / 64) * (D / 32), I_UP = (D / 64) * (2 * FF / 32), I_DN = (FF / 64) * (D / 32);
        constexpr int NITEMS = I_IN + 4 * I_SQ + I_UP + I_DN;
        for (int it = gw; it < NITEMS; it += NGW) {
            int r = it;
            if (r < I_IN) { p0_transpose_item(kargs()->in[4], D, INW, WinT, scr, r, LND(lane)); continue; } r -= I_IN;
            if (r < I_SQ) { p0_transpose_item(kargs()->in[13], D, D, WgluT, scr, r, LND(lane)); continue; } r -= I_SQ;
            if (r < I_SQ) { p0_transpose_item(kargs()->in[20], D, D, WbsT, scr, r, LND(lane)); continue; } r -= I_SQ;
            if (r < I_SQ) { p0_transpose_item(kargs()->in[21], D, D, WbaT, scr, r, LND(lane)); continue; } r -= I_SQ;
            if (r < I_SQ) { p0_transpose_item(kargs()->in[22], D, D, WoutT, scr, r, LND(lane)); continue; } r -= I_SQ;
            if (r < I_UP) { p0_transpose_item<true>(kargs()->in[25], D, 2 * FF, WupT, scr, r, LND(lane)); continue; } r -= I_UP;
            p0_transpose_item(kargs()->in[28], FF, D, WdownT, scr, r, LND(lane));
        }
        for (int it = gw; it < 96 * 16; it += NGW) p0_mod_item(kargs()->in[1], kargs()->in[2], kargs()->in[3], MODP, it, LND(lane));
    }
    GSYNC_CG();
    for (int i = bx * NTHREADS + LND(tid); i < 16 * INW; i += G * NTHREADS) { float s = 0.f;
#pragma unroll
        for (int ks = 0; ks < 16; ++ks) s += MODP[(size_t)ks * 16 * INW + i];
        MOD[i] = s; }
    GSYNC();
    ln_pass<0>(kargs()->in[0], nullptr, HB, nullptr, nullptr, MOD, 0, D, gw, NGW, LND(lane));
    GSYNC();
    {
        pg8::Gemm g{HB, WinT, D, D, D}; pg8::StaticOrder S; S.init(M, INW, G, bx);
        pg8::Epi<pg8::EP_PROJ> E{}; E.O = PROJ; E.ldo = INW; E.qscale = attn_body::C2;
        pg8::gemm_phase<pg8::Epi<pg8::EP_PROJ>, pg8::StaticOrder, true, true>(L, g, S, E);
    }
    GSYNC();
    {
        if (bx < 64) {
            ssm_item(kargs(), (bx * 8 + wave) >> 3, (bx * 8 + wave) & 7, L + wave * 16384, LND(lane));
            __syncthreads();
        }
        unsigned* qctr = (unsigned*)(ws + WS_CTL) + CW_QUEUE;
        volatile LAS unsigned* qw = (volatile LAS unsigned*)(L + MISC_OFF) + 16;
        const int xcc = (int)(xb_xcc_id() & 7u);
        for (int s = 0; s < 8; ++s) {
            const int xq = (xcc + s) & 7;
            for (;;) {
                if (tid == 0) qw[0] = __hip_atomic_fetch_add(qctr + 64 * xq, 1u, __ATOMIC_RELAXED, __HIP_MEMORY_SCOPE_AGENT);
                __syncthreads();
                const int idx = __builtin_amdgcn_readfirstlane((int)qw[0]);
                __syncthreads();
                if (idx >= 512) break;
                const int jj = idx >> 5, within = idx & 31, qb = 15 - (within >> 1), map = within & 1;
                const int hg = xq + 8 * jj, b = hg >> 3, head = hg & 7, hm = 2 * head + map;
                attn_body::attn_unit<8>(b, hm, 2 * head, 2 * hm, qb, (const attn_body::bf16*)(PROJ + 1024), (const attn_body::bf16*)(PROJ + 2048), (const attn_body::bf16*)(PROJ + 3072), (attn_body::bf16*)OB, (char*)lds);
            }
        }
    }
    GSYNC();
    {
        float lam;
        { const float v1 = kargs()->in[15][lane] * kargs()->in[16][lane], v2 = kargs()->in[17][lane] * kargs()->in[18][lane];
          lam = expf(wave_sum(v1)) - expf(wave_sum(v2)) + LAMBDA_INIT; }
        yatt_pass(OB, PROJ, kargs()->in[19], lam, gw, NGW, LND(lane));
        pg8::Gemm g{HB, WgluT, D, D, D}; pg8::StaticOrder S; S.init(M, D, G, bx);
        pg8::Epi<pg8::EP_GLU> E{}; E.O = PROJ; E.ldo = INW; E.X1 = HB; E.ldx1 = D; E.bias = kargs()->in[14];
        pg8::gemm_phase<pg8::Epi<pg8::EP_GLU>, pg8::StaticOrder, true, true>(L, g, S, E);
    }
    GSYNC();
    {
        pg8::Gemm g{PROJ, WbsT, INW, D, D}; pg8::StaticOrder S; S.init(M, D, G, bx);
        pg8::Epi<pg8::EP_BS> E{}; E.O = PROJ + 2048; E.ldo = INW; E.X1 = PROJ + 4096; E.ldx1 = INW;
        pg8::gemm_phase<pg8::Epi<pg8::EP_BS>, pg8::StaticOrder, true, true>(L, g, S, E);
    }
    {
        pg8::Gemm g{PROJ + 1024, WbaT, INW, D, D}; pg8::StaticOrder S; S.init(M, D, G, bx);
        pg8::Epi<pg8::EP_BA> E{}; E.O = PROJ + 3072; E.ldo = INW; E.X1 = PROJ + 5120; E.ldx1 = INW; E.X2 = PROJ + 2048; E.ldx2 = INW;
        pg8::gemm_phase<pg8::Epi<pg8::EP_BA>, pg8::StaticOrder, true, true>(L, g, S, E);
    }
    GSYNC();
    {
        pg8::Gemm g{PROJ + 3072, WoutT, INW, D, D}; pg8::StaticOrder S; S.init(M, D, G, bx);
        pg8::Epi<pg8::EP_OUT> E{}; E.F = OUT; E.R = kargs()->in[0]; E.gate = MOD + 2 * D; E.alpha = DN_ALPHA;
        pg8::gemm_phase<pg8::Epi<pg8::EP_OUT>, pg8::StaticOrder, true, true>(L, g, S, E);
    }
    GSYNC();
    ln_pass<1>(OUT, OUT, HB, kargs()->in[23], kargs()->in[24], MOD, 3 * D, 4 * D, gw, NGW, LND(lane));
    GSYNC();
    bf16* GB = PROJ; bf16* SB0 = (bf16*)(ws + WS_PROJ + 416 * MiB); bf16* SB1 = (bf16*)(ws + WS_PROJ + 432 * MiB); bf16* SB2 = (bf16*)(ws + WS_PROJ + 448 * MiB);
    {
        pg8::Gemm g{HB, WupT, D, D, D}; pg8::StaticOrder S; S.init(M, 2 * FF, G, bx);
        pg8::Epi<pg8::EP_UPC> E{}; E.O = GB; E.ldo = FF; E.S0 = SB0; E.S1 = SB1; E.S2 = SB2; E.cw = kargs()->in[26]; E.cb = kargs()->in[27];
        pg8::gemm_phase<pg8::Epi<pg8::EP_UPC>, pg8::StaticOrder, true, true>(L, g, S, E);
    }
    GSYNC();
    for (int it = bx * NTHREADS + LND(tid); it < (M / 64) * 2 * (FF / 8); it += G * NTHREADS) convfix_item(GB, SB0, SB1, SB2, kargs()->in[26], kargs()->in[27], it);
    GSYNC();
    {
        pg8::Gemm g{GB, WdownT, FF, FF, FF}; pg8::StaticOrder S; S.init(M, D, G, bx);
        pg8::Epi<pg8::EP_DOWN> E{}; E.F = OUT; E.R = OUT; E.gate = MOD + 5 * D; E.alpha = DN_ALPHA;
        pg8::gemm_phase<pg8::Epi<pg8::EP_DOWN>, pg8::StaticOrder, true, true>(L, g, S, E);
    }
    GSYNC();
    ln_pass<2>(OUT, OUT, nullptr, kargs()->in[29], kargs()->in[30], nullptr, 0, 0, gw, NGW, LND(lane));
}

extern "C" void kernel_launch(void* const* d_in, const int* in_sizes, int n_in, void* d_out, int out_size, void* d_ws, size_t ws_size, hipStream_t stream) {
    static int grid = 0;
    if (grid == 0) {
        if (n_in != 31 || in_sizes[0] != M * D || out_size != M * D || ws_size < WS_END) { fprintf(stderr, "kernel_launch: unexpected shapes (n_in %d, in0 %d, out %d, ws %zu); nothing launched\n", n_in, n_in > 0 ? in_sizes[0] : -1, out_size, ws_size); grid = -1; return; }
        int dev = 0, cus = 0, per_cu = 0;
        if (hipGetDevice(&dev) != hipSuccess || hipDeviceGetAttribute(&cus, hipDeviceAttributeMultiprocessorCount, dev) != hipSuccess) { grid = -1; return; }
        if (hipFuncSetAttribute((const void*)mk_fwd, hipFuncAttributeMaxDynamicSharedMemorySize, LDS_BYTES) != hipSuccess) { fprintf(stderr, "kernel_launch: hipFuncSetAttribute failed\n"); grid = -1; return; }
        if (hipOccupancyMaxActiveBlocksPerMultiprocessor(&per_cu, (const void*)mk_fwd, NTHREADS, LDS_BYTES) != hipSuccess || per_cu < 1) { fprintf(stderr, "kernel_launch: occupancy query says %d\n", per_cu); per_cu = 1; }
        (void)hipGetLastError();
        grid = cus * per_cu;
    }
    if (grid < 0) return;
    if (hipMemsetAsync((char*)d_ws + WS_CTL, 0, CTL_ZERO_BYTES, stream) != hipSuccess) { fprintf(stderr, "kernel_launch: memset failed\n"); return; }
    Args a{};
    for (int i = 0; i < 31; ++i) a.in[i] = (const float*)d_in[i];
    a.out = (float*)d_out; a.ws = (unsigned char*)d_ws;
    void* kargs[] = {&a};
    hipError_t e = hipLaunchCooperativeKernel((const void*)mk_fwd, dim3(grid), dim3(NTHREADS), kargs, LDS_BYTES, stream);
    if (e != hipSuccess) fprintf(stderr, "kernel_launch: cooperative launch failed: %s (grid %d)\n", hipGetErrorString(e), grid);
}
```

```cpp
#include <hip/hip_runtime.h>
#include <hip/hip_cooperative_groups.h>
#include <cstdio>
#include <cstdint>
namespace cg = cooperative_groups;
namespace pg8 {
#define PG8_LAS __attribute__((address_space(3)))
typedef unsigned short bf16_t;
typedef short bf16x8 __attribute__((ext_vector_type(8)));
typedef float f32x4 __attribute__((ext_vector_type(4)));
typedef unsigned u32x4 __attribute__((ext_vector_type(4)));
constexpr int BM = 256, BK = 64, HALF = 128, HTB = HALF * BK * 2  , STAGE_BYTES = 8 * HTB, NXCD = 8, WGM = 8;

__host__ __device__ __forceinline__ int lds_byte(int r, int c) { const int st = (r >> 4) * 2 + (c >> 5), rr = r & 15, cc = c & 31, ob = rr * 64 + cc * 2; return st * 1024 + (ob ^ (((ob >> 9) & 1) << 5)); }
__host__ __device__ __forceinline__ void stage_rc(int b, int& R, int& C) { const int st = b / 1024, sb = b % 1024, swz = sb ^ (((sb >> 9) & 1) << 5); R = (st >> 1) * 16 + swz / 64; C = (st & 1) * 32 + (swz % 64) / 2; }
__host__ __device__ __forceinline__ int perm32(int rho) { const int n = rho >> 4, i = rho & 15; return 8 * (i >> 2) + 4 * n + (i & 3); }

struct Unit { int pm, pn; };
struct Gemm { const bf16_t* A; const bf16_t* Bt; int lda, ldb, K; };

struct StaticOrder {
    int nM, nN, nwg, G, c;
    __host__ __device__ void init(int M, int N, int G_, int c_) { nM = M / BM; nN = N / BM; nwg = nM * nN; G = G_; c = c_; }
    __host__ __device__ bool next(int i, Unit& u) const {
        const long L = (long)i * G + c; if (L >= nwg) return false;
        int wgid = (int)L; { const int q = nwg / NXCD, r = nwg % NXCD, xcd = wgid % NXCD, off = wgid / NXCD; wgid = (xcd < r ? xcd * (q + 1) : r * (q + 1) + (xcd - r) * q) + off; }
        const int nig = WGM * nN, gid = wgid / nig, fm = gid * WGM, gsz = (nM - fm) < WGM ? (nM - fm) : WGM;
        u.pm = fm + ((wgid % nig) % gsz); u.pn = (wgid % nig) / gsz; return true;
    }
    __device__ __forceinline__ void a_ready(const Unit&) const {}
    __device__ __forceinline__ void done(const Unit&) const {}
};

__device__ __forceinline__ unsigned cvt_pk_bf16(float lo, float hi) { unsigned r; asm volatile("v_cvt_pk_bf16_f32 %0, %1, %2" : "=v"(r) : "v"(lo), "v"(hi)); return r; }

__device__ __forceinline__ float bf_lo(unsigned u) { return __uint_as_float(u << 16); }
__device__ __forceinline__ float bf_hi(unsigned u) { return __uint_as_float(u & 0xffff0000u); }
__device__ __forceinline__ float sigmoidf_fast(float x) { return __builtin_amdgcn_rcpf(1.0f + __expf(-x)); }
__device__ __forceinline__ void unpack8(const u32x4 w, float (&f)[8]) { f[0] = bf_lo(w.x); f[1] = bf_hi(w.x); f[2] = bf_lo(w.y); f[3] = bf_hi(w.y); f[4] = bf_lo(w.z); f[5] = bf_hi(w.z); f[6] = bf_lo(w.w); f[7] = bf_hi(w.w); }
enum { EP_PROJ = 0, EP_GLU = 1, EP_BS = 2, EP_BA = 3, EP_OUT = 4, EP_UP = 5, EP_DOWN = 6, EP_UPC = 7 };
template <int MODE> struct Epi {
    static constexpr bool PERM = (MODE != EP_OUT && MODE != EP_DOWN), AFTER_DRAIN = false;
    bf16_t* O; int ldo;
    const bf16_t* X1; int ldx1;
    const bf16_t* X2; int ldx2;
    const float* bias;
    float* F; const float* R; const float* gate; float alpha;
    float qscale;
    bf16_t* S0; bf16_t* S1; bf16_t* S2; const float* cw; const float* cb;
    __device__ __forceinline__ void operator()(const f32x4 (&acc)[2][2][4][2], const Unit& u, int wr, int wc, int fr, int fq) const {
        if constexpr (MODE == EP_UPC) {
            constexpr int FFc = 2816;
            const int lane_ = (int)(threadIdx.x & 63);
            const int src1 = (lane_ & 48) | ((fr + 15) & 15), src2 = (lane_ & 48) | ((fr + 14) & 15);
            const int row0 = u.pm * BM + wr * 64 + fr, fb0 = u.pn * 128 + wc * 16 + 4 * fq;
            f32x4 w0v[2], w1v[2], w2v[2], cbv[2];
#pragma unroll
            for (int bj = 0; bj < 2; ++bj) { w0v[bj] = *(const f32x4*)(cw + fb0 + bj * 64); w1v[bj] = *(const f32x4*)(cw + FFc + fb0 + bj * 64); w2v[bj] = *(const f32x4*)(cw + 2 * FFc + fb0 + bj * 64); cbv[bj] = *(const f32x4*)(cb + fb0 + bj * 64); }
#pragma unroll
            for (int ai = 0; ai < 2; ++ai)
#pragma unroll
                for (int m = 0; m < 4; ++m) {
                    const int row = row0 + ai * HALF + m * 16; const int strip = row >> 6;
#pragma unroll
                    for (int bj = 0; bj < 2; ++bj) {
                        const int fb = fb0 + bj * 64;
                        const f32x4 A = acc[ai][bj][m][0], V = acc[ai][bj][m][1];
                        const f32x4 Ap = acc[ai][bj][m > 0 ? m - 1 : 0][0];
                        float g[4];
#pragma unroll
                        for (int i = 0; i < 4; ++i) {
                            const float c1 = __shfl(A[i], src1), c2 = __shfl(A[i], src2);
                            float p1 = c1, p2 = c2;
                            if (m > 0) { const float d1 = __shfl(Ap[i], src1), d2 = __shfl(Ap[i], src2); p1 = (fr >= 1) ? c1 : d1; p2 = (fr >= 2) ? c2 : d2; }
                            const float cv = w0v[bj][i] * p2 + w1v[bj][i] * p1 + w2v[bj][i] * A[i] + cbv[bj][i];
                            g[i] = cv * sigmoidf_fast(cv) * V[i];
                        }
                        typedef unsigned u32x2 __attribute__((ext_vector_type(2)));
                        if (m == 0 && fr < 2) {
                            u32x2 wa; wa.x = cvt_pk_bf16(A[0], A[1]); wa.y = cvt_pk_bf16(A[2], A[3]);
                            u32x2 wv; wv.x = cvt_pk_bf16(V[0], V[1]); wv.y = cvt_pk_bf16(V[2], V[3]);
                            *(u32x2*)(S0 + ((size_t)strip * 2 + fr) * FFc + fb) = wa; *(u32x2*)(S1 + ((size_t)strip * 2 + fr) * FFc + fb) = wv;
                        } else {
                            u32x2 wg; wg.x = cvt_pk_bf16(g[0], g[1]); wg.y = cvt_pk_bf16(g[2], g[3]);
                            *(u32x2*)(O + (size_t)row * ldo + fb) = wg;
                        }
                        if (m == 3 && fr >= 14) { u32x2 wa; wa.x = cvt_pk_bf16(A[0], A[1]); wa.y = cvt_pk_bf16(A[2], A[3]); *(u32x2*)(S2 + ((size_t)strip * 2 + (fr - 14)) * FFc + fb) = wa; }
                    }
                    asm volatile("" ::: "memory");
                }
        } else
        if constexpr (PERM) {
            const int row0 = u.pm * BM + wr * 64 + fr, col0 = u.pn * BM + wc * 32 + 8 * fq;
            float sc = 1.f; if (MODE == EP_PROJ) { const int colt = u.pn * BM; if (colt >= 1024 && colt < 2048) sc = qscale; }
            float bv[2][8];
            if (MODE == EP_GLU) {
#pragma unroll
                for (int bj = 0; bj < 2; ++bj) { const f32x4 b0 = *(const f32x4*)(bias + col0 + bj * HALF), b1 = *(const f32x4*)(bias + col0 + bj * HALF + 4);
                    bv[bj][0] = b0[0]; bv[bj][1] = b0[1]; bv[bj][2] = b0[2]; bv[bj][3] = b0[3]; bv[bj][4] = b1[0]; bv[bj][5] = b1[1]; bv[bj][6] = b1[2]; bv[bj][7] = b1[3]; }
            }
#pragma unroll
            for (int ai = 0; ai < 2; ++ai)
#pragma unroll
                for (int m = 0; m < 4; ++m) {
                    const size_t row = (size_t)(row0 + ai * HALF + m * 16);
#pragma unroll
                    for (int bj = 0; bj < 2; ++bj) {
                        const int col = col0 + bj * HALF;
                        float v[8];
#pragma unroll
                        for (int j = 0; j < 4; ++j) { v[j] = acc[ai][bj][m][0][j]; v[4 + j] = acc[ai][bj][m][1][j]; }
                        if (MODE == EP_PROJ) {
#pragma unroll
                            for (int j = 0; j < 8; ++j) v[j] *= sc;
                        }
                        if (MODE == EP_GLU) {
                            float z[8]; unpack8(*(const u32x4*)(X1 + row * ldx1 + col), z);
#pragma unroll
                            for (int j = 0; j < 8; ++j) v[j] = z[j] * sigmoidf_fast(v[j] + bv[bj][j]);
                        }
                        if (MODE == EP_BS) {
                            float gt[8]; unpack8(*(const u32x4*)(X1 + row * ldx1 + col), gt);
#pragma unroll
                            for (int j = 0; j < 8; ++j) v[j] = sigmoidf_fast(gt[j]) * v[j];
                        }
                        if (MODE == EP_BA) {
                            float gt[8], m1[8]; unpack8(*(const u32x4*)(X1 + row * ldx1 + col), gt); unpack8(*(const u32x4*)(X2 + row * ldx2 + col), m1);
#pragma unroll
                            for (int j = 0; j < 8; ++j) v[j] = m1[j] + sigmoidf_fast(gt[j]) * v[j];
                        }
                        u32x4 w; w.x = cvt_pk_bf16(v[0], v[1]); w.y = cvt_pk_bf16(v[2], v[3]); w.z = cvt_pk_bf16(v[4], v[5]); w.w = cvt_pk_bf16(v[6], v[7]);
                        *(u32x4*)(O + row * ldo + col) = w;
                    }
                    asm volatile("" ::: "memory");
                }
        } else {
            const int row0 = u.pm * BM + wr * 64 + fr, col0 = u.pn * BM + wc * 32 + 4 * fq;
            const float* gp = gate + (size_t)((u.pm * BM) >> 12) * 6144;
            f32x4 gv[2][2];
#pragma unroll
            for (int bj = 0; bj < 2; ++bj)
#pragma unroll
                for (int n = 0; n < 2; ++n) gv[bj][n] = *(const f32x4*)(gp + col0 + bj * HALF + n * 16);
#pragma unroll
            for (int ai = 0; ai < 2; ++ai)
#pragma unroll
                for (int m = 0; m < 4; ++m) {
                    const size_t off = (size_t)(row0 + ai * HALF + m * 16) * 1024 + col0;
#pragma unroll
                    for (int bj = 0; bj < 2; ++bj)
#pragma unroll
                        for (int n = 0; n < 2; ++n) { const f32x4 rs = *(const f32x4*)(R + off + bj * HALF + n * 16);
                            *(f32x4*)(F + off + bj * HALF + n * 16) = rs * alpha + gv[bj][n] * acc[ai][bj][m][n]; }
                    asm volatile("" ::: "memory");
                }
        }
    }
};

template <class Epi, class Sched, bool ALIGN_EPI = false, bool SP2 = false>
__device__ __forceinline__ void gemm_phase(PG8_LAS unsigned char* lds, const Gemm g, const Sched& S, const Epi& E) {
    int tid_ = threadIdx.x; asm volatile("" : "+v"(tid_)); const int tid = tid_, wid = __builtin_amdgcn_readfirstlane(tid >> 6), lane = tid & 63, wr = wid >> 2, wc = wid & 3, fr = lane & 15, fq = lane >> 4;
    const int K = g.K, nt = K / BK;
    unsigned voffA[2], voffB[2];
#pragma unroll
    for (int i = 0; i < 2; ++i) { int R, C; stage_rc(tid * 16 + i * 8192, R, C); const int Rb = Epi::PERM ? ((R & ~31) + perm32(R & 31)) : R;
        voffA[i] = (unsigned)(R * g.lda + C) * 2u; voffB[i] = (unsigned)(Rb * g.ldb + C) * 2u; }
    const size_t kstep = (size_t)(BK * 2);
    const size_t hstepA = (size_t)HALF * g.lda * 2, hstepB = (size_t)HALF * g.ldb * 2;
    const size_t tstepA = 2 * hstepA, tstepB = 2 * hstepB;
    const unsigned ldsw = (unsigned)wid * 1024u;
    const int aoff = lds_byte(wr * 64 + fr, fq * 8), boff = lds_byte(wc * 32 + fr, fq * 8);
#define PG8_SA(b, h) (((b) * 2 + (h)) * HTB)
#define PG8_SB(b, h) ((4 + (b) * 2 + (h)) * HTB)
#define PG8_STAGE(bufoff, gbase, voff) do { _Pragma("unroll") for (int _i = 0; _i < 2; ++_i) \
        __builtin_amdgcn_global_load_lds((const unsigned*)((const char*)(gbase) + (voff)[_i]), (PG8_LAS unsigned*)(lds + (bufoff) + ldsw + _i * 8192), 16, 0, 0); } while (0)
#define PG8_LDA(dst, b, h) do { _Pragma("unroll") for (int m = 0; m < 4; ++m) _Pragma("unroll") for (int k = 0; k < 2; ++k) dst[m][k] = *(const PG8_LAS bf16x8*)(lds + PG8_SA(b, h) + aoff + m * 2048 + k * 1024); } while (0)
#define PG8_LDB(dst, b, h) do { _Pragma("unroll") for (int n = 0; n < 2; ++n) _Pragma("unroll") for (int k = 0; k < 2; ++k) dst[n][k] = *(const PG8_LAS bf16x8*)(lds + PG8_SB(b, h) + boff + n * 2048 + k * 1024); } while (0)
#define PG8_MMA(ai, bj, At, Bt) do { __builtin_amdgcn_s_setprio(1); _Pragma("unroll") for (int m = 0; m < 4; ++m) _Pragma("unroll") for (int n = 0; n < 2; ++n) _Pragma("unroll") for (int k = 0; k < 2; ++k) \
        acc[ai][bj][m][n] = __builtin_amdgcn_mfma_f32_16x16x32_bf16(Bt[n][k], At[m][k], acc[ai][bj][m][n], 0, 0, 0); __builtin_amdgcn_s_setprio(0); } while (0)
#define PG8_WAIT_V(n) asm volatile("s_waitcnt vmcnt(" #n ")" ::: "memory")
#define PG8_WAIT_L(n) asm volatile("s_waitcnt lgkmcnt(" #n ")" ::: "memory")
#define PG8_BAR __builtin_amdgcn_s_barrier()
#define PG8_SCHED __builtin_amdgcn_sched_barrier(0)
    Unit cur, nxt; int ui = 0;
    if (!S.next(0, cur)) return;
    f32x4 acc[2][2][4][2];
#pragma unroll
    for (int a = 0; a < 2; ++a)
#pragma unroll
        for (int b = 0; b < 2; ++b)
#pragma unroll
            for (int m = 0; m < 4; ++m)
#pragma unroll
                for (int n = 0; n < 2; ++n) acc[a][b][m][n] = (f32x4){0.f, 0.f, 0.f, 0.f};
    bf16x8 At[4][2], B0[2][2], B1[2][2];
    const char* cA = (const char*)g.A + (size_t)cur.pm * tstepA; const char* cB = (const char*)g.Bt + (size_t)cur.pn * tstepB;
    S.a_ready(cur);
    if constexpr (SP2) {
        PG8_STAGE(PG8_SB(0, 0), cB, voffB); PG8_STAGE(PG8_SB(0, 1), cB + hstepB, voffB); PG8_STAGE(PG8_SA(0, 0), cA, voffA); PG8_STAGE(PG8_SA(0, 1), cA + hstepA, voffA);
        if (wr == 1) PG8_BAR;
        PG8_WAIT_V(2); PG8_BAR;
        PG8_STAGE(PG8_SB(1, 0), cB + kstep, voffB); PG8_STAGE(PG8_SA(1, 0), cA + kstep, voffA); PG8_STAGE(PG8_SB(1, 1), cB + hstepB + kstep, voffB);
        PG8_WAIT_V(6); PG8_BAR;
    } else {
        PG8_STAGE(PG8_SB(0, 0), cB, voffB); PG8_STAGE(PG8_SA(0, 0), cA, voffA); PG8_STAGE(PG8_SB(0, 1), cB + hstepB, voffB); PG8_STAGE(PG8_SA(0, 1), cA + hstepA, voffA);
        if (wr == 1) PG8_BAR;
        PG8_WAIT_V(4); PG8_BAR;
        PG8_STAGE(PG8_SB(1, 0), cB + kstep, voffB); PG8_STAGE(PG8_SA(1, 0), cA + kstep, voffA); PG8_STAGE(PG8_SB(1, 1), cB + hstepB + kstep, voffB);
        PG8_WAIT_V(6); PG8_BAR;
    }
    for (;;) {
        const bool has_next = S.next(ui + 1, nxt);
        const char* nA = has_next ? (const char*)g.A + (size_t)nxt.pm * tstepA : cA; const char* nB = has_next ? (const char*)g.Bt + (size_t)nxt.pn * tstepB : cB;
        for (int t = 0; t < nt; t += 2) {
            const bool last = (t == nt - 2);
            const char* a1 = cA + (size_t)(t + 1) * kstep;
            const char* a2 = last ? nA : cA + (size_t)(t + 2) * kstep; const char* b2 = last ? nB : cB + (size_t)(t + 2) * kstep;
            const char* a3 = a2 + kstep; const char* b3 = b2 + kstep;
            if (last && has_next) S.a_ready(nxt);
            if constexpr (SP2) {
            PG8_LDB(B0, 0, 0); PG8_LDB(B1, 0, 1); PG8_SCHED; PG8_LDA(At, 0, 0); PG8_STAGE(PG8_SA(1, 1), a1 + hstepA, voffA);
            PG8_WAIT_V(8); PG8_WAIT_L(0); PG8_BAR; PG8_MMA(0, 0, At, B0); PG8_MMA(0, 1, At, B1); PG8_BAR; PG8_SCHED;
            PG8_LDA(At, 0, 1); PG8_STAGE(PG8_SB(0, 0), b2, voffB); PG8_STAGE(PG8_SB(0, 1), b2 + hstepB, voffB); PG8_STAGE(PG8_SA(0, 0), a2, voffA);
            PG8_WAIT_V(8); PG8_WAIT_L(0); PG8_BAR; PG8_MMA(1, 0, At, B0); PG8_MMA(1, 1, At, B1); PG8_BAR; PG8_SCHED;
            PG8_LDB(B0, 1, 0); PG8_LDB(B1, 1, 1); PG8_SCHED; PG8_LDA(At, 1, 0); PG8_STAGE(PG8_SA(0, 1), a2 + hstepA, voffA);
            PG8_WAIT_V(8); PG8_WAIT_L(0); PG8_BAR; PG8_MMA(0, 0, At, B0); PG8_MMA(0, 1, At, B1); PG8_BAR; PG8_SCHED;
            PG8_LDA(At, 1, 1); PG8_STAGE(PG8_SB(1, 0), b3, voffB); PG8_STAGE(PG8_SB(1, 1), b3 + hstepB, voffB); PG8_STAGE(PG8_SA(1, 0), a3, voffA);
            PG8_WAIT_V(8); PG8_WAIT_L(0); PG8_BAR; PG8_MMA(1, 0, At, B0); PG8_MMA(1, 1, At, B1); PG8_BAR; PG8_SCHED;
            } else {
            PG8_LDB(B0, 0, 0); PG8_SCHED; PG8_LDA(At, 0, 0); PG8_STAGE(PG8_SA(1, 1), a1 + hstepA, voffA);
            PG8_WAIT_L(8); PG8_BAR; PG8_WAIT_L(0); PG8_MMA(0, 0, At, B0); PG8_BAR; PG8_SCHED;
            PG8_LDB(B1, 0, 1); PG8_STAGE(PG8_SB(0, 0), b2, voffB);
            PG8_BAR; PG8_WAIT_L(0); PG8_MMA(0, 1, At, B1); PG8_BAR;
            PG8_LDA(At, 0, 1); PG8_STAGE(PG8_SA(0, 0), a2, voffA);
            PG8_BAR; PG8_WAIT_L(0); PG8_MMA(1, 0, At, B0); PG8_BAR; PG8_SCHED;
            PG8_STAGE(PG8_SB(0, 1), b2 + hstepB, voffB);
            PG8_WAIT_V(6); PG8_BAR; PG8_MMA(1, 1, At, B1); PG8_BAR;
            PG8_LDB(B0, 1, 0); PG8_SCHED; PG8_LDA(At, 1, 0); PG8_STAGE(PG8_SA(0, 1), a2 + hstepA, voffA);
            PG8_WAIT_L(8); PG8_BAR; PG8_WAIT_L(0); PG8_MMA(0, 0, At, B0); PG8_BAR; PG8_SCHED;
            PG8_LDB(B1, 1, 1); PG8_STAGE(PG8_SB(1, 0), b3, voffB);
            PG8_BAR; PG8_WAIT_L(0); PG8_MMA(0, 1, At, B1); PG8_BAR;
            PG8_LDA(At, 1, 1); PG8_STAGE(PG8_SA(1, 0), a3, voffA);
            PG8_BAR; PG8_WAIT_L(0); PG8_MMA(1, 0, At, B0); PG8_BAR; PG8_SCHED;
            PG8_STAGE(PG8_SB(1, 1), b3 + hstepB, voffB);
            PG8_WAIT_V(6); PG8_BAR; PG8_MMA(1, 1, At, B1); PG8_BAR;
            }
        }
        if constexpr (ALIGN_EPI) { if (wr == 0) PG8_BAR; }
        if constexpr (!Epi::AFTER_DRAIN) { E(acc, cur, wr, wc, fr, fq); S.done(cur); }
        if (!has_next) break;
#pragma unroll
        for (int a = 0; a < 2; ++a)
#pragma unroll
            for (int b = 0; b < 2; ++b)
#pragma unroll
                for (int m = 0; m < 4; ++m)
#pragma unroll
                    for (int n = 0; n < 2; ++n) acc[a][b][m][n] = (f32x4){0.f, 0.f, 0.f, 0.f};
        cur = nxt; cA = nA; cB = nB; ++ui;
        if constexpr (ALIGN_EPI) { if (wr == 1) PG8_BAR; }
    }
    PG8_WAIT_V(0);
    if constexpr (!ALIGN_EPI) { if (wr == 0) PG8_BAR; }
    PG8_BAR;
    if constexpr (Epi::AFTER_DRAIN) { E.fused(acc, cur, wr, wc, fr, fq, lds, wid, lane); S.done(cur); }
#undef PG8_SA
#undef PG8_SB
#undef PG8_STAGE
#undef PG8_LDA
#undef PG8_LDB
#undef PG8_MMA
#undef PG8_WAIT_V
#undef PG8_WAIT_L
#undef PG8_BAR
#undef PG8_SCHED
}
}

#include <hip/hip_bf16.h>
#include <cmath>
namespace attn_body {
using bf16=__hip_bfloat16;
using bf16x8=__attribute__((ext_vector_type(8)))short;
using s16x4=__attribute__((ext_vector_type(4)))short;
using f32x16=__attribute__((ext_vector_type(16)))float;
using u32x4=__attribute__((ext_vector_type(4)))unsigned;
constexpr int SEQ=4096,D=64,DM=6144,OP=2048;
constexpr int NW=8,QBLK=32,QB=QBLK*NW,KVBLK=64,NQB=SEQ/QB;
constexpr int ATTN_PITCH=DM, ATTN_UNIT_ROWS=QB;
__device__ __forceinline__ int crow(int r,int hi){return (r&3)+8*(r>>2)+4*hi;}
#define SBAR() __builtin_amdgcn_sched_barrier(0)
__device__ __forceinline__ void cmask(f32x16&p0,f32x16&p1,int jb,int qrel,int hi){
  const float NEG=-INFINITY;
  if(jb>(qrel>>6)){
  #pragma unroll
  for(int r=0;r<16;++r){p0[r]=NEG;p1[r]=NEG;}}
}

constexpr int NSLOT=3, SLOTB=8192;
constexpr int LDS_K=0, LDS_V=NSLOT*SLOTB, LDS_WS=LDS_V+NSLOT*2*SLOTB, LDS_OST=LDS_WS+NW*64*4, LDS_BYTES=LDS_OST+NW*4096;
constexpr float C2=0.125f*1.4426950408889634f;
__device__ __forceinline__ void glds16(const void*gsrc,unsigned lds_dst){unsigned keep;
  asm volatile("s_mov_b32 %0, m0\n\ts_mov_b32 m0, %2\n\ts_nop 0\n\tglobal_load_lds_dwordx4 %1, off\n\ts_mov_b32 m0, %0":"=&s"(keep):"v"(gsrc),"s"(lds_dst):"memory");}
__device__ __forceinline__ float max3f(float a,float b,float c){float r;asm("v_max3_f32 %0, %1, %2, %3":"=v"(r):"v"(a),"v"(b),"v"(c));return r;}
__device__ __forceinline__ float max2f(float a,float b){float r;asm("v_max_f32_e32 %0, %1, %2":"=v"(r):"v"(a),"v"(b));return r;}
__device__ __forceinline__ float fadd_s(float a,float b){float r;asm("v_add_f32_e32 %0, %1, %2":"=v"(r):"v"(a),"v"(b));return r;}
__device__ __forceinline__ float fsub_s(float a,float b){float r;asm("v_sub_f32_e32 %0, %1, %2":"=v"(r):"v"(a),"v"(b));return r;}
typedef float f32x2_t __attribute__((ext_vector_type(2))); typedef __bf16 bf16x2_t __attribute__((ext_vector_type(2)));
__device__ __forceinline__ unsigned cvtpk_s(float lo,float hi){f32x2_t v={lo,hi};bf16x2_t b=__builtin_convertvector(v,bf16x2_t);return __builtin_bit_cast(unsigned,b);}
#define WAIT_BAR(N) asm volatile("s_waitcnt vmcnt(" #N ") lgkmcnt(0)\n\ts_barrier":::"memory")

__device__ __forceinline__ void qkt(f32x16&p0,f32x16&p1,const char*Kslot,const bf16x8*qr,const f32x16&negm,int r32,int hi){
  const char*kb=Kslot+hi*1024+r32*16;
  #pragma unroll
  for(int d0=0;d0<4;++d0){
    const bf16x8 b0=*reinterpret_cast<const bf16x8*>(kb+d0*2048);
    const bf16x8 b1=*reinterpret_cast<const bf16x8*>(kb+d0*2048+512);
    if(d0==0){p0=__builtin_amdgcn_mfma_f32_32x32x16_bf16(b0,qr[0],negm,0,0,0);p1=__builtin_amdgcn_mfma_f32_32x32x16_bf16(b1,qr[0],negm,0,0,0);}
    else{p0=__builtin_amdgcn_mfma_f32_32x32x16_bf16(b0,qr[d0],p0,0,0,0);p1=__builtin_amdgcn_mfma_f32_32x32x16_bf16(b1,qr[d0],p1,0,0,0);}}
}
typedef __attribute__((address_space(3))) const char* lds_cptr;
typedef short v4i16_t __attribute__((ext_vector_type(4)));
__device__ __forceinline__ void kload8(bf16x8*kf,lds_cptr kp){
  kf[0]=*(const __attribute__((address_space(3))) bf16x8*)(kp);      kf[1]=*(const __attribute__((address_space(3))) bf16x8*)(kp+512);
  kf[2]=*(const __attribute__((address_space(3))) bf16x8*)(kp+2048); kf[3]=*(const __attribute__((address_space(3))) bf16x8*)(kp+2560);
  kf[4]=*(const __attribute__((address_space(3))) bf16x8*)(kp+4096); kf[5]=*(const __attribute__((address_space(3))) bf16x8*)(kp+4608);
  kf[6]=*(const __attribute__((address_space(3))) bf16x8*)(kp+6144); kf[7]=*(const __attribute__((address_space(3))) bf16x8*)(kp+6656);
}
__device__ __forceinline__ void kload2(bf16x8*kf,lds_cptr kp,int j){ kf[2*j]=*(const __attribute__((address_space(3))) bf16x8*)(kp+j*2048); kf[2*j+1]=*(const __attribute__((address_space(3))) bf16x8*)(kp+j*2048+512); }
__device__ __forceinline__ s16x4 vtr(lds_cptr p){ return __builtin_bit_cast(s16x4,__builtin_amdgcn_ds_read_tr16_b64_v4i16((__attribute__((address_space(3))) v4i16_t*)p)); }
__device__ __forceinline__ float rowmax(const f32x16&p0,const f32x16&p1){
  float a=max3f(p0[0],p0[1],p1[0]),b=max3f(p0[2],p0[3],p1[1]);a=max3f(a,p1[2],p1[3]);
  #pragma unroll
  for(int r=4;r<16;r+=4){a=max3f(a,p0[r],p0[r+1]);b=max3f(b,p0[r+2],p0[r+3]);a=max3f(a,p1[r],p1[r+1]);b=max3f(b,p1[r+2],p1[r+3]);}
  const float m=max2f(a,b);
  auto rr=__builtin_amdgcn_permlane32_swap(__float_as_uint(m),__float_as_uint(m),false,false);
  return max2f(__uint_as_float(rr[0]),__uint_as_float(rr[1]));
}
__device__ __forceinline__ void pv(f32x16*o,int vb,bf16x8 pa0,bf16x8 pa1,bf16x8 pa2,bf16x8 pa3){
  #pragma unroll
  for(int d0=0;d0<4;++d0){s16x4 lo[4],hi[4];
    #pragma unroll
    for(int ks=0;ks<4;++ks){
      asm volatile("ds_read_b64_tr_b16 %0,%1 offset:%c2":"=&v"(lo[ks]):"v"(vb),"i"(d0*4096+ks*1024):"memory");
      asm volatile("ds_read_b64_tr_b16 %0,%1 offset:%c2":"=&v"(hi[ks]):"v"(vb),"i"(d0*4096+ks*1024+512):"memory");}
    asm volatile("s_waitcnt lgkmcnt(0)":::"memory");SBAR();
    #define PK(k) (bf16x8){lo[k][0],lo[k][1],lo[k][2],lo[k][3],hi[k][0],hi[k][1],hi[k][2],hi[k][3]}
    o[d0]=__builtin_amdgcn_mfma_f32_32x32x16_bf16(pa0,PK(0),o[d0],0,0,0);
    o[d0]=__builtin_amdgcn_mfma_f32_32x32x16_bf16(pa1,PK(1),o[d0],0,0,0);
    o[d0]=__builtin_amdgcn_mfma_f32_32x32x16_bf16(pa2,PK(2),o[d0],0,0,0);
    o[d0]=__builtin_amdgcn_mfma_f32_32x32x16_bf16(pa3,PK(3),o[d0],0,0,0);
    #undef PK
  }
}

#ifndef ATTN_STORE16
#define ATTN_STORE16(p,v) (*(u32x4*)(p)=(v))
#endif
template<int THRL> __device__ __forceinline__ void attn_unit(int b,int h,int hv,int os,int qb,const bf16*Q,const bf16*__restrict__ K,const bf16*__restrict__ V,bf16*O,char*shm){
  int tid_=threadIdx.x; asm volatile("":"+v"(tid_)); const int tid=tid_,lane=tid&63,r32=lane&31,hi=lane>>5; const int wid=__builtin_amdgcn_readfirstlane(tid>>6);
  const long rowbase=(long)b*SEQ; const int q0=qb*QB;
  const bf16*Qw=Q+(rowbase+q0+wid*QBLK)*DM+h*D;
  const bf16*Kh=K+rowbase*DM+h*D,*Vh=V+rowbase*DM+hv*D;
  const unsigned lds0=(unsigned)(uintptr_t)shm;
  float*wsf=(float*)(shm+LDS_WS)+wid*64;
  const bf16*ksrc=Kh+(long)lane*DM+wid*8;
  const bf16*vsrc=Vh+(long)(16*(wid&3)+(lane>>2))*DM+(wid>>2)*32+(lane&3)*8;
  const unsigned kdst=lds0+LDS_K+wid*1024, vdst=lds0+LDS_V+wid*1024;
  #define DMA_K(t,slot) glds16(ksrc+(long)(t)*KVBLK*DM,(unsigned)__builtin_amdgcn_readfirstlane(kdst+(slot)))
  #define DMA_V(t,slot) do{ glds16(vsrc+(long)(t)*KVBLK*DM,(unsigned)__builtin_amdgcn_readfirstlane(vdst+2*(slot))); glds16(vsrc+64+(long)(t)*KVBLK*DM,(unsigned)__builtin_amdgcn_readfirstlane(vdst+2*(slot)+8192)); }while(0)
  const int vb0=(int)(lds0+LDS_V)+((lane>>4)&1)*32+(lane&3)*8+(4*hi+((lane&15)>>2))*64;
  const char*Kbase=shm+LDS_K; bf16x8 kf[8];
  const lds_cptr shm3=(lds_cptr)shm; const lds_cptr kp0=shm3+LDS_K+hi*1024+r32*16; const lds_cptr vp0=shm3+LDS_V+((lane>>4)&1)*32+(lane&3)*8+(4*hi+((lane&15)>>2))*64;
  const int NT=(q0+QB)/KVBLK;
  DMA_K(0,0);DMA_V(0,0);DMA_K(1,SLOTB);
  bf16x8 qr[4];
  #pragma unroll
  for(int d0=0;d0<4;++d0)qr[d0]=*reinterpret_cast<const bf16x8*>(&Qw[(long)r32*DM+d0*16+hi*8]);
  float mhat=0.f,l_reg=0.f;f32x16 o[4];o[0]=f32x16{};o[1]=f32x16{};o[2]=f32x16{};o[3]=f32x16{};const f32x16 negm=f32x16{};
  const int qrel=wid*QBLK+r32;
  #define CMASK(P0,P1,t) do{int jb_=(t)-(NT-4); if(jb_>=0)cmask(P0,P1,jb_,qrel,hi);}while(0)
  bool resc=false;
  #define START(P0,P1) do{ const float rm=rowmax(P0,P1); resc=false; \
    { const float dl=rm; mhat=fadd_s(mhat,dl); \
      _Pragma("unroll") for(int r=0;r<16;++r){P0[r]=fsub_s(P0[r],dl);P1[r]=fsub_s(P1[r],dl);} \
      } \
    _Pragma("unroll") for(int r=0;r<16;++r)P0[r]=__builtin_amdgcn_exp2f(P0[r]); }while(0)
  #define RESC() do{ if(resc){ asm volatile("s_waitcnt lgkmcnt(0)":::"memory"); \
      _Pragma("unroll") for(int d_=0;d_<4;++d_) _Pragma("unroll") for(int r=0;r<16;++r)o[d_][r]*=wsf[crow(r,hi)]; } }while(0)
  f32x16 pA0,pA1,pB0,pB1;
  int sl_prev=0,sl_cur=0,sl_next=SLOTB;
  #define ROT() do{sl_prev=sl_cur;sl_cur=sl_next;sl_next=(sl_next==(NSLOT-1)*SLOTB)?0:sl_next+SLOTB;}while(0)
  DMA_K(2,2*SLOTB);
  WAIT_BAR(4);
  qkt(pA0,pA1,Kbase,qr,negm,r32,hi);asm volatile("s_nop 15\n\ts_nop 7":"+v"(pA0),"+v"(pA1));CMASK(pA0,pA1,0);
  START(pA0,pA1);
  _Pragma("unroll") for(int r=0;r<16;++r)pA1[r]=__builtin_amdgcn_exp2f(pA1[r]);
  WAIT_BAR(0);
  DMA_K(3,0);DMA_V(1,SLOTB);
  ROT();
  kload8(kf,kp0+sl_cur);
  WAIT_BAR(3);
  s16x4 vlo[8],vhi[8]; u32x4 pw0,pw1,pw2,pw3;
  #define PKW(P,B) cvtpk_s(P[B],P[B+1])
  #define PAF(k) __builtin_bit_cast(bf16x8,pw##k)
  #define VFR(i) (bf16x8){vlo[i][0],vlo[i][1],vlo[i][2],vlo[i][3],vhi[i][0],vhi[i][1],vhi[i][2],vhi[i][3]}
  #define PIN(x) asm volatile("":"+v"(x))
  #define MX3(a,b,c) __builtin_fmaxf(__builtin_fmaxf((a),(b)),(c))
  #define GAPA(MF,A0,A1,A2,A3,W0,W1,PW) do{ MF; sacc+=A0; sacc+=A1; sacc+=A2; sacc+=A3; PIN(sacc); W0; W1; PIN(PW); SBAR(); }while(0)
  #define EX(v) __builtin_amdgcn_exp2f(v)
  #define GAPB(MF,X,B) do{ MF; X[B]=EX(X[B]); X[B+1]=EX(X[B+1]); X[B+2]=EX(X[B+2]); X[B+3]=EX(X[B+3]); PIN(X); SBAR(); }while(0)
  #define GAPB2(MF,X,B) do{ MF; X[B]=EX(X[B]); X[B+1]=EX(X[B+1]); PIN(X); SBAR(); }while(0)
  #define VRD2(i) do{ vlo[i]=vtr(vp_+(8192+((i)>>2)*4096+((i)&3)*1024)); vhi[i]=vtr(vp_+(8192+((i)>>2)*4096+((i)&3)*1024+512)); }while(0)
  #define VRD(i) do{ vlo[i]=vtr(vp_+(((i)>>2)*4096+((i)&3)*1024)); vhi[i]=vtr(vp_+(((i)>>2)*4096+((i)&3)*1024+512)); }while(0)
  #define KRD(G,j) do{ if(G){ kload2(kf,kp0+sl_next,j); SBAR(); } }while(0)
  #define STEP(C0,C1,P0,P1,t,GK,GV,GL) do{ SBAR(); \
    const lds_cptr vp_=vp0+2*sl_prev; \
    VRD(0); SBAR(); float sacc=(P0[0]+P0[1]); \
    GAPA(C0=__builtin_amdgcn_mfma_f32_32x32x16_bf16(kf[0],qr[0],negm,0,0,0), P0[2],P0[3],P0[4],P0[5],     pw0[0]=PKW(P0,0), pw0[1]=PKW(P0,2), pw0); \
    VRD(4); SBAR(); GAPA(C1=__builtin_amdgcn_mfma_f32_32x32x16_bf16(kf[1],qr[0],negm,0,0,0), P0[6],P0[7],P0[8],P0[9],     pw0[2]=PKW(P0,4), pw0[3]=PKW(P0,6), pw0); \
    VRD(1); SBAR(); GAPA(C0=__builtin_amdgcn_mfma_f32_32x32x16_bf16(kf[2],qr[1],C0,0,0,0),   P0[10],P0[11],P0[12],P0[13], pw1[0]=PKW(P0,8), pw1[1]=PKW(P0,10), pw1); \
    VRD(5); SBAR(); GAPA(C1=__builtin_amdgcn_mfma_f32_32x32x16_bf16(kf[3],qr[1],C1,0,0,0),   P0[14],P0[15],P1[0],P1[1],   pw1[2]=PKW(P0,12),pw1[3]=PKW(P0,14), pw1); \
    VRD(2); SBAR(); GAPA(C0=__builtin_amdgcn_mfma_f32_32x32x16_bf16(kf[4],qr[2],C0,0,0,0),   P1[2],P1[3],P1[4],P1[5],     pw2[0]=PKW(P1,0), pw2[1]=PKW(P1,2), pw2); \
    VRD(6); SBAR(); GAPA(C1=__builtin_amdgcn_mfma_f32_32x32x16_bf16(kf[5],qr[2],C1,0,0,0),   P1[6],P1[7],P1[8],P1[9],     pw2[2]=PKW(P1,4), pw2[3]=PKW(P1,6), pw2); \
    VRD(3); SBAR(); GAPA(C0=__builtin_amdgcn_mfma_f32_32x32x16_bf16(kf[6],qr[3],C0,0,0,0),   P1[10],P1[11],P1[12],P1[13], pw3[0]=PKW(P1,8), pw3[1]=PKW(P1,10), pw3); \
    VRD(7); SBAR(); GAPA(C1=__builtin_amdgcn_mfma_f32_32x32x16_bf16(kf[7],qr[3],C1,0,0,0),   P1[14],P1[15],0.f,0.f,       pw3[2]=PKW(P1,12),pw3[3]=PKW(P1,14), pw3); \
    l_reg+=sacc; \
    if(GK){DMA_K((t)+3,sl_cur);} if(GV){DMA_V((t)+1,sl_next);} \
    _Pragma("unroll") for(int r=0;r<16;++r){C0[r]-=mhat;C1[r]-=mhat;} \
    CMASK(C0,C1,t); \
    { float a=MX3(C0[0],C0[1],C1[0]),b=MX3(C0[2],C0[3],C1[1]); a=MX3(a,C1[2],C1[3]); \
      _Pragma("unroll") for(int r=4;r<16;r+=4){a=MX3(a,C0[r],C0[r+1]);b=MX3(b,C0[r+2],C0[r+3]);a=MX3(a,C1[r],C1[r+1]);b=MX3(b,C1[r+2],C1[r+3]);} \
      float rm=__builtin_fmaxf(a,b); { auto rr=__builtin_amdgcn_permlane32_swap(__float_as_uint(rm),__float_as_uint(rm),false,false); rm=__builtin_fmaxf(__uint_as_float(rr[0]),__uint_as_float(rr[1])); } \
      resc=false; \
      if(__builtin_expect(__any(rm>(float)THRL),0)){ const float dl=__builtin_fmaxf(rm,0.f); mhat+=dl; \
        _Pragma("unroll") for(int r=0;r<16;++r){C0[r]-=dl;C1[r]-=dl;} \
        const float f=__builtin_amdgcn_exp2f(-dl); l_reg*=f; if(hi==0)wsf[r32]=f; resc=true; } } \
    SBAR(); \
    GAPB2(o[0]=__builtin_amdgcn_mfma_f32_32x32x16_bf16(PAF(0),VFR(0),o[0],0,0,0), C0,0); VRD2(0); SBAR(); \
    GAPB2(o[1]=__builtin_amdgcn_mfma_f32_32x32x16_bf16(PAF(0),VFR(4),o[1],0,0,0), C0,2); VRD2(4); SBAR(); \
    KRD(GL,0); GAPB2(o[0]=__builtin_amdgcn_mfma_f32_32x32x16_bf16(PAF(1),VFR(1),o[0],0,0,0), C0,4); VRD2(1); SBAR(); \
    KRD(GL,1); GAPB2(o[1]=__builtin_amdgcn_mfma_f32_32x32x16_bf16(PAF(1),VFR(5),o[1],0,0,0), C0,6); VRD2(5); SBAR(); \
    KRD(GL,2); GAPB2(o[0]=__builtin_amdgcn_mfma_f32_32x32x16_bf16(PAF(2),VFR(2),o[0],0,0,0), C0,8); VRD2(2); SBAR(); \
    KRD(GL,3); GAPB2(o[1]=__builtin_amdgcn_mfma_f32_32x32x16_bf16(PAF(2),VFR(6),o[1],0,0,0), C0,10); VRD2(6); SBAR(); \
    GAPB2(o[0]=__builtin_amdgcn_mfma_f32_32x32x16_bf16(PAF(3),VFR(3),o[0],0,0,0), C0,12); VRD2(3); SBAR(); \
    GAPB2(o[1]=__builtin_amdgcn_mfma_f32_32x32x16_bf16(PAF(3),VFR(7),o[1],0,0,0), C0,14); VRD2(7); SBAR(); \
    GAPB2(o[2]=__builtin_amdgcn_mfma_f32_32x32x16_bf16(PAF(0),VFR(0),o[2],0,0,0), C1,0); \
    GAPB2(o[3]=__builtin_amdgcn_mfma_f32_32x32x16_bf16(PAF(0),VFR(4),o[3],0,0,0), C1,2); \
    GAPB2(o[2]=__builtin_amdgcn_mfma_f32_32x32x16_bf16(PAF(1),VFR(1),o[2],0,0,0), C1,4); \
    GAPB2(o[3]=__builtin_amdgcn_mfma_f32_32x32x16_bf16(PAF(1),VFR(5),o[3],0,0,0), C1,6); \
    GAPB2(o[2]=__builtin_amdgcn_mfma_f32_32x32x16_bf16(PAF(2),VFR(2),o[2],0,0,0), C1,8); \
    GAPB2(o[3]=__builtin_amdgcn_mfma_f32_32x32x16_bf16(PAF(2),VFR(6),o[3],0,0,0), C1,10); \
    GAPB2(o[2]=__builtin_amdgcn_mfma_f32_32x32x16_bf16(PAF(3),VFR(3),o[2],0,0,0), C1,12); \
    GAPB2(o[3]=__builtin_amdgcn_mfma_f32_32x32x16_bf16(PAF(3),VFR(7),o[3],0,0,0), C1,14); \
    }while(0)
  int t=1;
  #undef CMASK
  #define CMASK(P0,P1,t) do{}while(0)
  for(;t+5<NT;t+=2){
    STEP(pB0,pB1,pA0,pA1,t,true,true,true);     WAIT_BAR(3); RESC(); ROT();
    STEP(pA0,pA1,pB0,pB1,t+1,true,true,true);   WAIT_BAR(3); RESC(); ROT();
  }
  #undef CMASK
  #define CMASK(P0,P1,t) do{int jb_=(t)-(NT-4); if(jb_>=0)cmask(P0,P1,jb_,qrel,hi);}while(0)
  #define ENDW(tt) do{ if((tt)+3<NT){WAIT_BAR(3);} else if((tt)+2<NT){WAIT_BAR(2);} else {WAIT_BAR(0);} }while(0)
  for(;t+1<NT;t+=2){
    STEP(pB0,pB1,pA0,pA1,t,(t+3<NT),(t+1<NT),(t+1<NT));       ENDW(t);   RESC(); ROT();
    STEP(pA0,pA1,pB0,pB1,t+1,(t+4<NT),(t+2<NT),(t+2<NT));     ENDW(t+1); RESC(); ROT();
  }
  STEP(pB0,pB1,pA0,pA1,NT-1,false,false,false); RESC();
  { float sacc=pB0[0]+pB0[1]; _Pragma("unroll") for(int r=2;r<16;++r)sacc+=pB0[r]; _Pragma("unroll") for(int r=0;r<16;++r)sacc+=pB1[r]; l_reg+=sacc;
    pw0=(u32x4){PKW(pB0,0),PKW(pB0,2),PKW(pB0,4),PKW(pB0,6)};pw1=(u32x4){PKW(pB0,8),PKW(pB0,10),PKW(pB0,12),PKW(pB0,14)};pw2=(u32x4){PKW(pB1,0),PKW(pB1,2),PKW(pB1,4),PKW(pB1,6)};pw3=(u32x4){PKW(pB1,8),PKW(pB1,10),PKW(pB1,12),PKW(pB1,14)};
    SBAR(); pv(o,vb0+2*sl_cur,PAF(0),PAF(1),PAF(2),PAF(3)); }
  #undef PKW
  #undef PAF
  #undef VFR
  #undef PIN
  #undef MX3
  #undef GAPA
  #undef GAPB
  #undef EX
  #undef VRD
  #undef VRD2
  #undef GAPB2
  #undef KRD
  #undef STEP
  #undef ENDW
  {auto rr=__builtin_amdgcn_permlane32_swap(__float_as_uint(l_reg),__float_as_uint(l_reg),false,false);l_reg=__uint_as_float(rr[0])+__uint_as_float(rr[1]);}
  if(hi==0)wsf[32+r32]=l_reg;asm volatile("s_waitcnt lgkmcnt(0)":::"memory");
  float rli[16];
  #pragma unroll
  for(int r=0;r<16;++r)rli[r]=__builtin_amdgcn_rcpf(wsf[32+crow(r,hi)]);
  bf16*Ow=O+(rowbase+q0+wid*QBLK)*OP+os*D;
  { bf16*stg=(bf16*)(shm+LDS_OST)+wid*2048;
    #pragma unroll
    for(int hh=0;hh<2;++hh){
    #pragma unroll
    for(int r=0;r<16;++r){const int orow=crow(r,hi);
      #pragma unroll
      for(int d0=0;d0<2;++d0)stg[orow*64+d0*32+r32]=__float2bfloat16(o[2*hh+d0][r]*rli[r]);}
    asm volatile("s_waitcnt lgkmcnt(0)":::"memory");
    #pragma unroll
    for(int i=0;i<4;++i){const int row=i*8+(lane>>3),ch=lane&7; const u32x4 v=*(const u32x4*)(stg+row*64+ch*8); ATTN_STORE16(Ow+(long)row*OP+hh*64+ch*8,v);}
    asm volatile("s_waitcnt lgkmcnt(0)":::"memory"); } }
  asm volatile("s_waitcnt lgkmcnt(0)\n\ts_barrier":::"memory");
  #undef DMA_K
  #undef DMA_V
  #undef CMASK
  #undef START
  #undef RESC
  #undef ROT
}
constexpr int ATTN_LDS_BYTES=LDS_BYTES;
#undef SBAR
#undef WAIT_BAR
}


constexpr int NB = 16, T = 4096, D = 1024, M = NB * T, INW = 6144, FF = 2816, NG = 64, NP = 64;
constexpr float LN_EPS = 1e-5f, RMS_EPS = 1e-5f;
constexpr float DN_ALPHA = 1.189207115002721f;
constexpr float LAMBDA_INIT = 0.2f;
constexpr int NWAVES = 8, NTHREADS = 512;
constexpr size_t MiB = 1u << 20;
constexpr size_t WS_MODP = 0;
constexpr size_t WS_MOD = 6 * MiB;
constexpr size_t WS_WIN = 8 * MiB, WS_WGLU = 20 * MiB, WS_WBS = 22 * MiB, WS_WBA = 24 * MiB, WS_WOUT = 26 * MiB, WS_WUP = 28 * MiB, WS_WDOWN = 40 * MiB;
constexpr size_t WS_PROJ = 64 * MiB;
constexpr size_t WS_HB = 832 * MiB;
constexpr size_t WS_END = 960 * MiB;
constexpr int LDS_BYTES = 147456;
constexpr size_t WS_CTL = 7 * MiB, CTL_ZERO_BYTES = 64 * 1024;
constexpr int CW_BAR = 1024, CW_QUEUE = 8192;
constexpr int LDSCTL_OFF = 131072, MISC_OFF = LDSCTL_OFF + 320;

#define GAS __attribute__((address_space(1)))
#define LAS __attribute__((address_space(3)))
typedef unsigned short bf16;
typedef unsigned v4u __attribute__((ext_vector_type(4)));
typedef unsigned v2u __attribute__((ext_vector_type(2)));
typedef float f32x4 __attribute__((ext_vector_type(4)));
typedef float f32x16 __attribute__((ext_vector_type(16)));
typedef short bf16x8 __attribute__((ext_vector_type(8)));
#define LDS_WAIT() asm volatile("s_waitcnt lgkmcnt(0)" ::: "memory")
__device__ __forceinline__ unsigned f2bf(float f) { unsigned u = __builtin_bit_cast(unsigned, f); return (u + 0x7fffu + ((u >> 16) & 1u)) >> 16; }
typedef float f32x2_t __attribute__((ext_vector_type(2))); typedef __bf16 bf16x2_t __attribute__((ext_vector_type(2)));
__device__ __forceinline__ unsigned pk2(float lo, float hi) { f32x2_t v = {lo, hi}; bf16x2_t b = __builtin_convertvector(v, bf16x2_t); return __builtin_bit_cast(unsigned, b); }
__device__ __forceinline__ float bfl(unsigned u) { return __uint_as_float(u << 16); }
__device__ __forceinline__ float bfh(unsigned u) { return __uint_as_float(u & 0xffff0000u); }
__device__ __forceinline__ float wave_sum(float v) {
#pragma unroll
    for (int o = 1; o < 64; o <<= 1) v += __shfl_xor(v, o);
    return v;
}
__device__ __forceinline__ float sigm(float x) { return 1.0f / (1.0f + __expf(-x)); }

struct Args { const float* in[31]; float* out; unsigned char* ws; };
typedef const Args __attribute__((address_space(4)))* KArgs;
__device__ __forceinline__ KArgs kargs() { unsigned long long p = (unsigned long long)__builtin_amdgcn_kernarg_segment_ptr(); asm volatile("" : "+s"(p)); return (KArgs)p; }

typedef GAS unsigned gu32;
#define XB_TMO      128
#define XB_XCNT(j)  (256  + 64 * (j))
#define XB_XSUB(j)  (1280 + 64 * (j))
#define XB_XGEN(j)  (2304 + 64 * (j))
#define XB_TOP      3328
#define XB_TOPGEN   3392
#define XCD_BAR_WORDS 3456
#define XB_SPIN_CAP (1u << 18)

__device__ __forceinline__ unsigned xb_ld(unsigned* p)              { return __hip_atomic_load(p, __ATOMIC_RELAXED, __HIP_MEMORY_SCOPE_AGENT); }
__device__ __forceinline__ unsigned xb_add(unsigned* p, unsigned v) { return __hip_atomic_fetch_add(p, v, __ATOMIC_RELAXED, __HIP_MEMORY_SCOPE_AGENT); }
__device__ __forceinline__ unsigned xb_xcc_id() { return (unsigned)__builtin_amdgcn_s_getreg((3 << 11) | 20) & 0xFu; }
#define XB_SPIN(cond, bar) do { unsigned _sp = 0; while (cond) { __builtin_amdgcn_s_sleep(1); \
    if ((++_sp & 255u) == 0u) { if (xb_ld(&(bar)[XB_TMO])) break; if (_sp > XB_SPIN_CAP) { atomicAdd(&(bar)[XB_TMO], 1u); break; } } } } while (0)

struct XcdBarrier {
    unsigned* bar; unsigned x;
    volatile LAS unsigned* st;
};

__device__ __forceinline__ XcdBarrier xcd_barrier_post(unsigned* bar, volatile LAS unsigned* st) {
    XcdBarrier b; b.bar = bar; b.x = xb_xcc_id(); b.st = st;
    if (threadIdx.x == 0) (void)xb_add(&bar[XB_XCNT(b.x)], 1u);
    return b;
}
__device__ __forceinline__ void xcd_barrier_complete(unsigned* bar, unsigned x, unsigned& nloc, unsigned& nx) {
    const unsigned G = gridDim.x * gridDim.y * gridDim.z;
    unsigned sum, cnt, mine, sp = 0u;
    for (;;) {
        sum = 0u; cnt = 0u; mine = 0u;
#pragma unroll
        for (unsigned j = 0; j < 16; ++j) { const unsigned c = xb_ld(&bar[XB_XCNT(j)]); sum += c; cnt += (c > 0u) ? 1u : 0u; mine = (j == x) ? c : mine; }
        if (sum == G) break;
        __builtin_amdgcn_s_sleep(1);
        if ((++sp & 255u) == 0u) { if (xb_ld(&bar[XB_TMO])) break; if (sp > XB_SPIN_CAP) { atomicAdd(&bar[XB_TMO], 1u); break; } }
    }
    nloc = mine > 0u ? mine : 1u; nx = cnt > 0u ? cnt : 1u;
}

__device__ __forceinline__ void xcd_barrier(const XcdBarrier& b) {
    asm volatile("s_waitcnt vmcnt(0)" ::: "memory");
    __syncthreads();
    if (threadIdx.x == 0) {
        unsigned* bar = b.bar;
        __builtin_amdgcn_s_waitcnt(0);
        unsigned nloc = b.st[0], nx = b.st[1];
        if (nloc == 0u) { xcd_barrier_complete(bar, b.x, nloc, nx); b.st[0] = nloc; b.st[1] = nx; }
        const unsigned old = xb_add(&bar[XB_XSUB(b.x)], 1u);
        const unsigned gen = old / nloc;
        if (old + 1u == (gen + 1u) * nloc) {
            __builtin_amdgcn_fence(__ATOMIC_RELEASE, "agent");
            asm volatile("s_waitcnt vmcnt(0)" ::: "memory");
            const unsigned og = xb_add(&bar[XB_TOP], 1u);
            const unsigned tg = og / nx;
            if (og + 1u == (tg + 1u) * nx) xb_add(&bar[XB_TOPGEN], 1u);
            else XB_SPIN(xb_ld(&bar[XB_TOPGEN]) == tg, bar);
            __builtin_amdgcn_fence(__ATOMIC_ACQUIRE, "agent");
            xb_add(&bar[XB_XGEN(b.x)], 1u);
            asm volatile("s_waitcnt vmcnt(0)" ::: "memory");
        } else {
            XB_SPIN(xb_ld(&bar[XB_XGEN(b.x)]) == gen, bar);
            __builtin_amdgcn_fence(__ATOMIC_ACQUIRE, "agent");
            asm volatile("s_waitcnt vmcnt(0)" ::: "memory");
        }
    }
    __syncthreads();
}


template <bool UPPERM = false> __device__ __forceinline__ void p0_transpose_item(const float* W, int K, int N, bf16* WT, LAS float* scr, int item, int lane) {
    const int nblk = N / 32, kb = item / nblk, nb = item % nblk, k0 = 64 * kb, n0 = 32 * nb;
#pragma unroll 8
    for (int i = 0; i < 32; ++i) { const int kk = 2 * i + (lane >> 5); scr[kk * 33 + (lane & 31)] = W[(size_t)(k0 + kk) * N + n0 + (lane & 31)]; }
    LDS_WAIT(); asm volatile("" ::: "memory");
    const int c = lane & 7;
#pragma unroll
    for (int j = 0; j < 4; ++j) { const int n = (lane >> 3) + 8 * j; const LAS float* s = scr + (8 * c) * 33 + n;
        v4u o; o.x = pk2(s[0 * 33], s[1 * 33]); o.y = pk2(s[2 * 33], s[3 * 33]); o.z = pk2(s[4 * 33], s[5 * 33]); o.w = pk2(s[6 * 33], s[7 * 33]);
        int dr = n0 + n; if (UPPERM) { const int f = dr >= FF ? dr - FF : dr; dr = 8 * (f >> 2) + (dr >= FF ? 4 : 0) + (f & 3); }
        *(v4u*)(WT + (size_t)dr * K + k0 + 8 * c) = o; }
    LDS_WAIT(); asm volatile("" ::: "memory");
}

__device__ __forceinline__ void p0_mod_item(const float* c, const float* w_mod, const float* b_mod, float* part, LAS float* scr, int item, int lane) {
    const int cgp = item % 96, ks = item / 96, col = cgp * 64 + lane;
#pragma unroll
    for (int b = 0; b < 16; ++b) { const float cv = c[b * D + ks * 64 + lane]; scr[b * 64 + lane] = cv * sigm(cv); }
    LDS_WAIT(); asm volatile("" ::: "memory");
    float acc[16];
#pragma unroll
    for (int b = 0; b < 16; ++b) acc[b] = 0.f;
    const float* wp = w_mod + (size_t)(ks * 64) * INW + col;
#pragma unroll 1
    for (int k0 = 0; k0 < 64; k0 += 16) {
        float w[16];
#pragma unroll
        for (int kk = 0; kk < 16; ++kk) w[kk] = wp[(size_t)(k0 + kk) * INW];
#pragma unroll
        for (int kk = 0; kk < 16; kk += 4) {
#pragma unroll
            for (int b = 0; b < 16; ++b) { const f32x4 s4 = *(const LAS f32x4*)(scr + b * 64 + k0 + kk); acc[b] += s4.x * w[kk] + s4.y * w[kk + 1] + s4.z * w[kk + 2] + s4.w * w[kk + 3]; }
            asm volatile("" ::: "memory");
        }
    }
    const float bm = (ks == 0) ? b_mod[col] : 0.f;
#pragma unroll
    for (int b = 0; b < 16; ++b) part[((size_t)ks * 16 + b) * INW + col] = acc[b] + bm;
    LDS_WAIT(); asm volatile("" ::: "memory");
}

__device__ __forceinline__ void ldrow(const float* p, int lane, f32x4 (&v)[4]) { const f32x4* xr = (const f32x4*)p + lane;
#pragma unroll
    for (int j = 0; j < 4; ++j) v[j] = xr[64 * j]; }
__device__ __forceinline__ void row_stats2(const f32x4 (&a)[4], const f32x4 (&b)[4], float& ma, float& ra, float& mb, float& rb) {
    float sa = 0.f, qa = 0.f, sb = 0.f, qb = 0.f;
#pragma unroll
    for (int j = 0; j < 4; ++j) { sa += (a[j].x + a[j].y) + (a[j].z + a[j].w); qa += (a[j].x * a[j].x + a[j].y * a[j].y) + (a[j].z * a[j].z + a[j].w * a[j].w);
                                  sb += (b[j].x + b[j].y) + (b[j].z + b[j].w); qb += (b[j].x * b[j].x + b[j].y * b[j].y) + (b[j].z * b[j].z + b[j].w * b[j].w); }
#pragma unroll
    for (int o = 1; o < 64; o <<= 1) { sa += __shfl_xor(sa, o); qa += __shfl_xor(qa, o); sb += __shfl_xor(sb, o); qb += __shfl_xor(qb, o); }
    ma = sa * (1.f / D); mb = sb * (1.f / D);
    ra = 1.f / sqrtf(fmaxf(qa * (1.f / D) - ma * ma, 0.f) + LN_EPS); rb = 1.f / sqrtf(fmaxf(qb * (1.f / D) - mb * mb, 0.f) + LN_EPS);
}
__device__ __forceinline__ void st_bf16row(bf16* orow, int lane, const f32x4 (&y)[4]) { v2u* o8 = (v2u*)orow + lane;
#pragma unroll
    for (int j = 0; j < 4; ++j) { v2u w; w.x = pk2(y[j].x, y[j].y); w.y = pk2(y[j].z, y[j].w); o8[64 * j] = w; } }
template <int MODE> __device__ __forceinline__ void ln_pass(const float* src, float* dstf, bf16* dsth, const float* g, const float* bta, const float* mod, int sh_off, int sc_off, int gw, int NGW, int lane) {
    f32x4 ca[4], cb[4], na[4], nb[4];
    int m = gw;
    if (m < M) { ldrow(src + (size_t)m * D, lane, ca); ldrow(src + (size_t)(m + NGW) * D, lane, cb); }
    for (; m < M; m += 2 * NGW) {
        const int mn = m + 2 * NGW;
        if (mn < M) { ldrow(src + (size_t)mn * D, lane, na); ldrow(src + (size_t)(mn + NGW) * D, lane, nb); }
        float ma, ra, mb, rb; row_stats2(ca, cb, ma, ra, mb, rb);
        if (MODE == 0) {
            const float* moda = mod + (size_t)(m >> 12) * INW; const float* modb = mod + (size_t)((m + NGW) >> 12) * INW;
#pragma unroll
            for (int j = 0; j < 4; ++j) { const f32x4 sca = ((const f32x4*)(moda + sc_off))[lane + 64 * j], sha = ((const f32x4*)(moda + sh_off))[lane + 64 * j];
                                          const f32x4 scb = ((const f32x4*)(modb + sc_off))[lane + 64 * j], shb = ((const f32x4*)(modb + sh_off))[lane + 64 * j];
                ca[j] = (ca[j] - ma) * ra * (sca + 1.0f) + sha; cb[j] = (cb[j] - mb) * rb * (scb + 1.0f) + shb; }
            st_bf16row(dsth + (size_t)m * D, lane, ca); st_bf16row(dsth + (size_t)(m + NGW) * D, lane, cb);
        } else {
#pragma unroll
            for (int j = 0; j < 4; ++j) { const f32x4 gg = ((const f32x4*)g)[lane + 64 * j], bb = ((const f32x4*)bta)[lane + 64 * j];
                ca[j] = (ca[j] - ma) * ra * gg + bb; cb[j] = (cb[j] - mb) * rb * gg + bb;
                ((f32x4*)(dstf + (size_t)m * D))[lane + 64 * j] = ca[j]; ((f32x4*)(dstf + (size_t)(m + NGW) * D))[lane + 64 * j] = cb[j]; }
            if (MODE == 1) {
                row_stats2(ca, cb, ma, ra, mb, rb);
                const float* moda = mod + (size_t)(m >> 12) * INW; const float* modb = mod + (size_t)((m + NGW) >> 12) * INW;
#pragma unroll
                for (int j = 0; j < 4; ++j) { const f32x4 sca = ((const f32x4*)(moda + sc_off))[lane + 64 * j], sha = ((const f32x4*)(moda + sh_off))[lane + 64 * j];
                                              const f32x4 scb = ((const f32x4*)(modb + sc_off))[lane + 64 * j], shb = ((const f32x4*)(modb + sh_off))[lane + 64 * j];
                    ca[j] = (ca[j] - ma) * ra * (sca + 1.0f) + sha; cb[j] = (cb[j] - mb) * rb * (scb + 1.0f) + shb; }
                st_bf16row(dsth + (size_t)m * D, lane, ca); st_bf16row(dsth + (size_t)(m + NGW) * D, lane, cb);
            }
        }
#pragma unroll
        for (int j = 0; j < 4; ++j) { ca[j] = na[j]; cb[j] = nb[j]; }
    }
}

__device__ __forceinline__ float gelu_tanh(float x) {
    const float u = 0.7978845608028654f * (x + 0.044715f * x * x * x);
    return x * __builtin_amdgcn_rcpf(1.0f + __expf(-2.0f * u));
}
__device__ __forceinline__ bf16x8 pack8(const float (&f)[8]) {
    v4u w; w.x = pk2(f[0], f[1]); w.y = pk2(f[2], f[3]); w.z = pk2(f[4], f[5]); w.w = pk2(f[6], f[7]); return __builtin_bit_cast(bf16x8, w);
}

__device__ __forceinline__ void ssm_item(KArgs a, int g, int bp, LAS unsigned char* wl, int lane) {
    const float* lam_re = a->in[5]; const float* lam_im = a->in[6]; const float* log_dt = a->in[7];
    const float* b_re = a->in[8]; const float* b_im = a->in[9]; const float* c_re = a->in[10]; const float* c_im = a->in[11]; const float* dsk = a->in[12];
    const bf16* proj = (const bf16*)(a->ws + WS_PROJ); bf16* zb = (bf16*)(a->ws + WS_HB);
    const int r = lane & 31, h = lane >> 5;
    const float dt = expf(log_dt[g]);
    float are[2], aim[2];
    bf16x8 bfr[4];
#pragma unroll
    for (int i = 0; i < 2; ++i) {
        const int p = r + 32 * i; const float lr = lam_re[g * NP + p], li = lam_im[g * NP + p];
        const float mag = expf(lr * dt), ar = mag * cosf(li * dt), ai = mag * sinf(li * dt);
        const float den = lr * lr + li * li, nr = ar - 1.0f, ni = ai;
        const float cr = (nr * lr + ni * li) / den, ci = (ni * lr - nr * li) / den;
        are[i] = ar; aim[i] = ai;
        const float* br = b_re + ((size_t)(g * NP + p)) * 16 + 8 * h; const float* bi = b_im + ((size_t)(g * NP + p)) * 16 + 8 * h;
        float fre[8], fim[8];
#pragma unroll
        for (int j = 0; j < 8; ++j) { fre[j] = cr * br[j] - ci * bi[j]; fim[j] = cr * bi[j] + ci * br[j]; }
        bfr[i] = pack8(fre); bfr[2 + i] = pack8(fim);
    }
    const int cch = lane & 15, kg = lane >> 4;
    bf16x8 cfr[4], dfr;
#pragma unroll
    for (int s = 0; s < 4; ++s) {
        const int p0 = 8 * s + 2 * kg; const float* cr = c_re + ((size_t)(g * 16 + cch)) * NP; const float* ci = c_im + ((size_t)(g * 16 + cch)) * NP;
        float f[8] = {cr[p0], -ci[p0], cr[p0 + 32], -ci[p0 + 32], cr[p0 + 1], -ci[p0 + 1], cr[p0 + 33], -ci[p0 + 33]};
        cfr[s] = pack8(f);
    }
    { float f[8];
#pragma unroll
      for (int j = 0; j < 8; ++j) f[j] = (kg < 2 && (8 * kg + j) == cch) ? dsk[g * 16 + cch] : 0.f;
      dfr = pack8(f); }
    const int b0 = 2 * bp;
    const int beta_r = (r >> 2) & 1, tok_r = 4 * (r >> 3) + (r & 3);
    const bf16* ua = proj + ((size_t)(b0 + beta_r) * T + tok_r) * INW + g * 16 + 8 * h;
    const bf16* ud = proj + ((size_t)b0 * T + cch) * INW + g * 16 + 8 * (kg & 1);
    bf16* zo = zb + ((size_t)b0 * T + 4 * kg) * D + g * 16 + cch;
    float sr[2] = {0.f, 0.f}, si[2] = {0.f, 0.f};
    LAS unsigned char* wrow = wl + (16 * h) * 272 + 8 * r;
    const LAS unsigned char* rrow = wl + cch * 272 + 16 * kg;
    bf16x8 af = *(const bf16x8*)(ua);
    for (int t0 = 0; t0 < T; t0 += 16) {
        const bf16x8 afc = af;
        if (t0 + 16 < T) af = *(const bf16x8*)(ua + (size_t)(t0 + 16) * INW);
        bf16x8 u0 = {0, 0, 0, 0, 0, 0, 0, 0}, u1 = {0, 0, 0, 0, 0, 0, 0, 0};
        if (kg < 2) { u0 = *(const bf16x8*)(ud + (size_t)t0 * INW); u1 = *(const bf16x8*)(ud + (size_t)(T + t0) * INW); }
        const f32x16 zz = {0.f, 0.f, 0.f, 0.f, 0.f, 0.f, 0.f, 0.f, 0.f, 0.f, 0.f, 0.f, 0.f, 0.f, 0.f, 0.f};
        const f32x16 bre0 = __builtin_amdgcn_mfma_f32_32x32x16_bf16(afc, bfr[0], zz, 0, 0, 0);
        const f32x16 bre1 = __builtin_amdgcn_mfma_f32_32x32x16_bf16(afc, bfr[1], zz, 0, 0, 0);
        const f32x16 bim0 = __builtin_amdgcn_mfma_f32_32x32x16_bf16(afc, bfr[2], zz, 0, 0, 0);
        const f32x16 bim1 = __builtin_amdgcn_mfma_f32_32x32x16_bf16(afc, bfr[3], zz, 0, 0, 0);
#pragma unroll
        for (int t = 0; t < 16; ++t) {
            const float nr0 = are[0] * sr[0] - aim[0] * si[0] + bre0[t], ni0 = are[0] * si[0] + aim[0] * sr[0] + bim0[t];
            const float nr1 = are[1] * sr[1] - aim[1] * si[1] + bre1[t], ni1 = are[1] * si[1] + aim[1] * sr[1] + bim1[t];
            sr[0] = nr0; si[0] = ni0; sr[1] = nr1; si[1] = ni1;
            v2u w; w.x = pk2(nr0, ni0); w.y = pk2(nr1, ni1);
            *(LAS v2u*)(wrow + t * 272) = w;
        }
        LDS_WAIT(); asm volatile("" ::: "memory");
#pragma unroll
        for (int be = 0; be < 2; ++be) {
            f32x4 y = {0.f, 0.f, 0.f, 0.f};
#pragma unroll
            for (int s = 0; s < 4; ++s) { const bf16x8 sa = *(const LAS bf16x8*)(rrow + be * 16 * 272 + 64 * s); y = __builtin_amdgcn_mfma_f32_16x16x32_bf16(sa, cfr[s], y, 0, 0, 0); }
            y = __builtin_amdgcn_mfma_f32_16x16x32_bf16(be ? u1 : u0, dfr, y, 0, 0, 0);
#pragma unroll
            for (int q = 0; q < 4; ++q) zo[((size_t)be * T + t0 + q) * D] = (bf16)pk2(gelu_tanh(y[q]), 0.f);
        }
        LDS_WAIT(); asm volatile("" ::: "memory");
    }
}

struct YRow { v4u a0, a1, b0, b1; };
__device__ __forceinline__ void yatt_load(const bf16* orow, int lane, YRow& r) {
    const int hh = lane >> 3, e0 = (lane & 7) * 16;
    const bf16* p1 = orow + (4 * hh + (e0 >> 6)) * 64 + (e0 & 63);
    r.a0 = *(const v4u*)(p1); r.a1 = *(const v4u*)(p1 + 8); r.b0 = *(const v4u*)(p1 + 128); r.b1 = *(const v4u*)(p1 + 136);
}
__device__ __forceinline__ void yatt_fin(const YRow& r, bf16* yrow, const float (&sg)[16], float lam, int lane) {
    const int hh = lane >> 3, e0 = (lane & 7) * 16;
    float o[16];
#pragma unroll
    for (int i = 0; i < 2; ++i) { const v4u a = i ? r.a1 : r.a0, b = i ? r.b1 : r.b0;
        o[8 * i + 0] = bfl(a.x) - lam * bfl(b.x); o[8 * i + 1] = bfh(a.x) - lam * bfh(b.x); o[8 * i + 2] = bfl(a.y) - lam * bfl(b.y); o[8 * i + 3] = bfh(a.y) - lam * bfh(b.y);
        o[8 * i + 4] = bfl(a.z) - lam * bfl(b.z); o[8 * i + 5] = bfh(a.z) - lam * bfh(b.z); o[8 * i + 6] = bfl(a.w) - lam * bfl(b.w); o[8 * i + 7] = bfh(a.w) - lam * bfh(b.w); }
    float ss = 0.f;
#pragma unroll
    for (int j = 0; j < 16; ++j) ss += o[j] * o[j];
    ss += __shfl_xor(ss, 1); ss += __shfl_xor(ss, 2); ss += __shfl_xor(ss, 4);
    const float rs = 1.f / sqrtf(ss * (1.f / 128.f) + RMS_EPS) * (1.0f - LAMBDA_INIT);
    float y[16];
#pragma unroll
    for (int j = 0; j < 16; ++j) y[j] = o[j] * rs * sg[j];
    v4u w0, w1; w0.x = pk2(y[0], y[1]); w0.y = pk2(y[2], y[3]); w0.z = pk2(y[4], y[5]); w0.w = pk2(y[6], y[7]); w1.x = pk2(y[8], y[9]); w1.y = pk2(y[10], y[11]); w1.z = pk2(y[12], y[13]); w1.w = pk2(y[14], y[15]);
    *(v4u*)(yrow + hh * 128 + e0) = w0; *(v4u*)(yrow + hh * 128 + e0 + 8) = w1;
}
__device__ __forceinline__ void yatt_pass(const bf16* OBp, bf16* PROJp, const float* subg, float lam, int gw, int NGW, int lane) {
    float sg[16];
#pragma unroll
    for (int j = 0; j < 16; ++j) sg[j] = subg[(lane & 7) * 16 + j];
    YRow c0, c1, c2, c3, n0, n1, n2, n3;
    int m = gw;
    if (m < M) { yatt_load(OBp + (size_t)m * 2048, lane, c0); yatt_load(OBp + (size_t)(m + NGW) * 2048, lane, c1); yatt_load(OBp + (size_t)(m + 2 * NGW) * 2048, lane, c2); yatt_load(OBp + (size_t)(m + 3 * NGW) * 2048, lane, c3); }
    for (; m < M; m += 4 * NGW) {
        const int mn = m + 4 * NGW;
        if (mn < M) { yatt_load(OBp + (size_t)mn * 2048, lane, n0); yatt_load(OBp + (size_t)(mn + NGW) * 2048, lane, n1); yatt_load(OBp + (size_t)(mn + 2 * NGW) * 2048, lane, n2); yatt_load(OBp + (size_t)(mn + 3 * NGW) * 2048, lane, n3); }
        yatt_fin(c0, PROJp + (size_t)m * INW + 1024, sg, lam, lane); yatt_fin(c1, PROJp + (size_t)(m + NGW) * INW + 1024, sg, lam, lane);
        yatt_fin(c2, PROJp + (size_t)(m + 2 * NGW) * INW + 1024, sg, lam, lane); yatt_fin(c3, PROJp + (size_t)(m + 3 * NGW) * INW + 1024, sg, lam, lane);
        c0 = n0; c1 = n1; c2 = n2; c3 = n3;
    }
}

__device__ __forceinline__ void up8(const v4u p, float (&f)[8]) { f[0] = bfl(p.x); f[1] = bfh(p.x); f[2] = bfl(p.y); f[3] = bfh(p.y); f[4] = bfl(p.z); f[5] = bfh(p.z); f[6] = bfl(p.w); f[7] = bfh(p.w); }
__device__ __forceinline__ void conv_item(bf16* proj, const float* cw, const float* cb, int item) {
    const int cc = item % (FF / 8), rr = item / (FF / 8), f0 = cc * 8, t0 = rr * 8;
    bf16* base = proj + (size_t)t0 * INW + f0;
    v4u pa[10], pv[8];
    const bool first = (t0 & (T - 1)) == 0;
    const v4u zero4 = {0u, 0u, 0u, 0u};
    pa[0] = first ? zero4 : *(const v4u*)(base - 2 * (size_t)INW); pa[1] = first ? zero4 : *(const v4u*)(base - (size_t)INW);
#pragma unroll
    for (int i = 0; i < 8; ++i) { pa[2 + i] = *(const v4u*)(base + (size_t)i * INW); pv[i] = *(const v4u*)(base + (size_t)i * INW + FF); }
    float w0[8], w1[8], w2[8], bb[8];
#pragma unroll
    for (int j = 0; j < 8; ++j) { w0[j] = cw[f0 + j]; w1[j] = cw[FF + f0 + j]; w2[j] = cw[2 * FF + f0 + j]; bb[j] = cb[f0 + j]; }
    float am2[8], am1[8];
    up8(pa[0], am2); up8(pa[1], am1);
#pragma unroll
    for (int i = 0; i < 8; ++i) {
        float a0[8], vv[8], o[8]; up8(pa[2 + i], a0); up8(pv[i], vv);
#pragma unroll
        for (int j = 0; j < 8; ++j) { const float cv = w0[j] * am2[j] + w1[j] * am1[j] + w2[j] * a0[j] + bb[j]; o[j] = cv * __builtin_amdgcn_rcpf(1.0f + __expf(-cv)) * vv[j]; am2[j] = am1[j]; am1[j] = a0[j]; }
        v4u w; w.x = pk2(o[0], o[1]); w.y = pk2(o[2], o[3]); w.z = pk2(o[4], o[5]); w.w = pk2(o[6], o[7]);
        *(v4u*)(base + (size_t)i * INW + FF) = w;
    }
}

__device__ __forceinline__ void convfix_item(bf16* Gb, const bf16* S0, const bf16* S1, const bf16* S2, const float* cw, const float* cb, int item) {
    const int cc = item % (FF / 8), sj = item / (FF / 8), j = sj & 1, s = sj >> 1, f0 = cc * 8;
    const bool first = (s & 63) == 0;
    const v4u z4 = {0u, 0u, 0u, 0u};
    const v4u l62 = first ? z4 : *(const v4u*)(S2 + ((size_t)(s - 1) * 2 + 0) * FF + f0), l63 = first ? z4 : *(const v4u*)(S2 + ((size_t)(s - 1) * 2 + 1) * FF + f0);
    const v4u a0 = *(const v4u*)(S0 + ((size_t)s * 2 + 0) * FF + f0), a1 = *(const v4u*)(S0 + ((size_t)s * 2 + 1) * FF + f0);
    const v4u vv = *(const v4u*)(S1 + ((size_t)s * 2 + j) * FF + f0);
    float pm2[8], pm1[8], ac[8], vf[8], o[8];
    if (j == 0) { up8(l62, pm2); up8(l63, pm1); up8(a0, ac); } else { up8(l63, pm2); up8(a0, pm1); up8(a1, ac); }
    up8(vv, vf);
#pragma unroll
    for (int q = 0; q < 8; ++q) { const float cv = cw[f0 + q] * pm2[q] + cw[FF + f0 + q] * pm1[q] + cw[2 * FF + f0 + q] * ac[q] + cb[f0 + q]; o[q] = cv * __builtin_amdgcn_rcpf(1.0f + __expf(-cv)) * vf[q]; }
    v4u w; w.x = pk2(o[0], o[1]); w.y = pk2(o[2], o[3]); w.z = pk2(o[4], o[5]); w.w = pk2(o[6], o[7]);
    *(v4u*)(Gb + ((size_t)s * 64 + j) * FF + f0) = w;
}

__global__ void __launch_bounds__(NTHREADS, 2) mk_fwd(Args args) {
    extern __shared__ __attribute__((aligned(16))) unsigned char lds[];
    cg::grid_group grid = cg::this_grid();
    LAS unsigned char* L = (LAS unsigned char*)lds;
    const int tid = threadIdx.x, lane = tid & 63, wave = __builtin_amdgcn_readfirstlane(tid >> 6);
    const int G = gridDim.x, bx = blockIdx.x;
    const int vcu = (G % 8 == 0) ? (bx % 8) * (G / 8) + bx / 8 : bx;
    const int gw = vcu * NWAVES + wave, NGW = G * NWAVES;
    unsigned char* ws = kargs()->ws;
    bf16* WinT = (bf16*)(ws + WS_WIN); bf16* WgluT = (bf16*)(ws + WS_WGLU); bf16* WbsT = (bf16*)(ws + WS_WBS); bf16* WbaT = (bf16*)(ws + WS_WBA);
    bf16* WoutT = (bf16*)(ws + WS_WOUT); bf16* WupT = (bf16*)(ws + WS_WUP); bf16* WdownT = (bf16*)(ws + WS_WDOWN);
    bf16* PROJ = (bf16*)(ws + WS_PROJ); bf16* HB = (bf16*)(ws + WS_HB);
    float* MODP = (float*)(ws + WS_MODP); float* MOD = (float*)(ws + WS_MOD);
    float* OUT = kargs()->out; bf16* OB = (bf16*)kargs()->out;
#define LND(x) ({ int l_ = (x); asm volatile("" : "+v"(l_)); l_; })
#define GSYNC_CG() do { __builtin_amdgcn_fence(__ATOMIC_RELEASE, "agent"); grid.sync(); __builtin_amdgcn_fence(__ATOMIC_ACQUIRE, "agent"); } while (0)
#define GSYNC() xcd_barrier(bar)
    for (int u = tid; u < (LDS_BYTES - LDSCTL_OFF) / 4; u += NTHREADS) ((LAS unsigned*)(L + LDSCTL_OFF))[u] = 0u;
    __syncthreads();
    const XcdBarrier bar = xcd_barrier_post((unsigned*)(ws + WS_CTL) + CW_BAR, (volatile LAS unsigned*)(L + MISC_OFF) + 8);

    {
        LAS float* scr = (LAS float*)(L + wave * 16384);
        constexpr int I_IN = (D / 64) * (INW / 32), I_SQ = (D / 64) * (D / 32), I_UP = (D / 64) * (2 * FF / 32), I_DN = (FF / 64) * (D / 32);
        constexpr int NITEMS = I_IN + 4 * I_SQ + I_UP + I_DN;
        for (int it = gw; it < NITEMS; it += NGW) {
            int r = it;
            if (r < I_IN) { p0_transpose_item(kargs()->in[4], D, INW, WinT, scr, r, LND(lane)); continue; } r -= I_IN;
            if (r < I_SQ) { p0_transpose_item(kargs()->in[13], D, D, WgluT, scr, r, LND(lane)); continue; } r -= I_SQ;
            if (r < I_SQ) { p0_transpose_item(kargs()->in[20], D, D, WbsT, scr, r, LND(lane)); continue; } r -= I_SQ;
            if (r < I_SQ) { p0_transpose_item(kargs()->in[21], D, D, WbaT, scr, r, LND(lane)); continue; } r -= I_SQ;
            if (r < I_SQ) { p0_transpose_item(kargs()->in[22], D, D, WoutT, scr, r, LND(lane)); continue; } r -= I_SQ;
            if (r < I_UP) { p0_transpose_item<true>(kargs()->in[25], D, 2 * FF, WupT, scr, r, LND(lane)); continue; } r -= I_UP;
            p0_transpose_item(kargs()->in[28], FF, D, WdownT, scr, r, LND(lane));
        }
        for (int it = gw; it < 96 * 16; it += NGW) p0_mod_item(kargs()->in[1], kargs()->in[2], kargs()->in[3], MODP, scr, it, LND(lane));
    }
    if (__builtin_expect(kargs()->ws == nullptr, 0)) GSYNC_CG();
    GSYNC();
    for (int i = bx * NTHREADS + LND(tid); i < 16 * INW; i += G * NTHREADS) { float s = 0.f;
#pragma unroll
        for (int ks = 0; ks < 16; ++ks) s += MODP[(size_t)ks * 16 * INW + i];
        MOD[i] = s; }
    GSYNC();
    ln_pass<0>(kargs()->in[0], nullptr, HB, nullptr, nullptr, MOD, 0, D, gw, NGW, LND(lane));
    GSYNC();
    {
        pg8::Gemm g{HB, WinT, D, D, D}; pg8::StaticOrder S; S.init(M, INW, G, bx);
        pg8::Epi<pg8::EP_PROJ> E{}; E.O = PROJ; E.ldo = INW; E.qscale = attn_body::C2;
        pg8::gemm_phase<pg8::Epi<pg8::EP_PROJ>, pg8::StaticOrder, true, true>(L, g, S, E);
    }
    GSYNC();
    {
        if (bx < 64) {
            ssm_item(kargs(), (bx * 8 + wave) >> 3, (bx * 8 + wave) & 7, L + wave * 16384, LND(lane));
            __syncthreads();
        }
        unsigned* qctr = (unsigned*)(ws + WS_CTL) + CW_QUEUE;
        volatile LAS unsigned* qw = (volatile LAS unsigned*)(L + MISC_OFF) + 16;
        const int xcc = (int)(xb_xcc_id() & 7u);
        for (int s = 0; s < 8; ++s) {
            const int xq = (xcc + s) & 7;
            for (;;) {
                if (tid == 0) qw[0] = __hip_atomic_fetch_add(qctr + 64 * xq, 1u, __ATOMIC_RELAXED, __HIP_MEMORY_SCOPE_AGENT);
                __syncthreads();
                const int idx = __builtin_amdgcn_readfirstlane((int)qw[0]);
                __syncthreads();
                if (idx >= 512) break;
                const int jj = idx >> 5, within = idx & 31, qb = 15 - (within >> 1), map = within & 1;
                const int hg = xq + 8 * jj, b = hg >> 3, head = hg & 7, hm = 2 * head + map;
                attn_body::attn_unit<8>(b, hm, 2 * head, 2 * hm, qb, (const attn_body::bf16*)(PROJ + 1024), (const attn_body::bf16*)(PROJ + 2048), (const attn_body::bf16*)(PROJ + 3072), (attn_body::bf16*)OB, (char*)lds);
            }
        }
    }
    GSYNC();
    {
        float lam;
        { const float v1 = kargs()->in[15][lane] * kargs()->in[16][lane], v2 = kargs()->in[17][lane] * kargs()->in[18][lane];
          lam = expf(wave_sum(v1)) - expf(wave_sum(v2)) + LAMBDA_INIT; }
        yatt_pass(OB, PROJ, kargs()->in[19], lam, gw, NGW, LND(lane));
        pg8::Gemm g{HB, WgluT, D, D, D}; pg8::StaticOrder S; S.init(M, D, G, bx);
        pg8::Epi<pg8::EP_GLU> E{}; E.O = PROJ; E.ldo = INW; E.X1 = HB; E.ldx1 = D; E.bias = kargs()->in[14];
        pg8::gemm_phase<pg8::Epi<pg8::EP_GLU>, pg8::StaticOrder, true, true>(L, g, S, E);
    }
    GSYNC();
    {
        pg8::Gemm g{PROJ, WbsT, INW, D, D}; pg8::StaticOrder S; S.init(M, D, G, bx);
        pg8::Epi<pg8::EP_BS> E{}; E.O = PROJ + 2048; E.ldo = INW; E.X1 = PROJ + 4096; E.ldx1 = INW;
        pg8::gemm_phase<pg8::Epi<pg8::EP_BS>, pg8::StaticOrder, true, true>(L, g, S, E);
    }
    {
        pg8::Gemm g{PROJ + 1024, WbaT, INW, D, D}; pg8::StaticOrder S; S.init(M, D, G, bx);
        pg8::Epi<pg8::EP_BA> E{}; E.O = PROJ + 3072; E.ldo = INW; E.X1 = PROJ + 5120; E.ldx1 = INW; E.X2 = PROJ + 2048; E.ldx2 = INW;
        pg8::gemm_phase<pg8::Epi<pg8::EP_BA>, pg8::StaticOrder, true, true>(L, g, S, E);
    }
    GSYNC();
    {
        pg8::Gemm g{PROJ + 3072, WoutT, INW, D, D}; pg8::StaticOrder S; S.init(M, D, G, bx);
        pg8::Epi<pg8::EP_OUT> E{}; E.F = OUT; E.R = kargs()->in[0]; E.gate = MOD + 2 * D; E.alpha = DN_ALPHA;
        pg8::gemm_phase<pg8::Epi<pg8::EP_OUT>, pg8::StaticOrder, true, true>(L, g, S, E);
    }
    GSYNC();
    ln_pass<1>(OUT, OUT, HB, kargs()->in[23], kargs()->in[24], MOD, 3 * D, 4 * D, gw, NGW, LND(lane));
    GSYNC();
    bf16* GB = PROJ; bf16* SB0 = (bf16*)(ws + WS_PROJ + 416 * MiB); bf16* SB1 = (bf16*)(ws + WS_PROJ + 432 * MiB); bf16* SB2 = (bf16*)(ws + WS_PROJ + 448 * MiB);
    {
        pg8::Gemm g{HB, WupT, D, D, D}; pg8::StaticOrder S; S.init(M, 2 * FF, G, bx);
        pg8::Epi<pg8::EP_UPC> E{}; E.O = GB; E.ldo = FF; E.S0 = SB0; E.S1 = SB1; E.S2 = SB2; E.cw = kargs()->in[26]; E.cb = kargs()->in[27];
        pg8::gemm_phase<pg8::Epi<pg8::EP_UPC>, pg8::StaticOrder, true, true>(L, g, S, E);
    }
    GSYNC();
    for (int it = bx * NTHREADS + LND(tid); it < (M / 64) * 2 * (FF / 8); it += G * NTHREADS) convfix_item(GB, SB0, SB1, SB2, kargs()->in[26], kargs()->in[27], it);
    GSYNC();
    {
        pg8::Gemm g{GB, WdownT, FF, FF, FF}; pg8::StaticOrder S; S.init(M, D, G, bx);
        pg8::Epi<pg8::EP_DOWN> E{}; E.F = OUT; E.R = OUT; E.gate = MOD + 5 * D; E.alpha = DN_ALPHA;
        pg8::gemm_phase<pg8::Epi<pg8::EP_DOWN>, pg8::StaticOrder, true, true>(L, g, S, E);
    }
    GSYNC();
    ln_pass<2>(OUT, OUT, nullptr, kargs()->in[29], kargs()->in[30], nullptr, 0, 0, gw, NGW, LND(lane));
}

extern "C" void kernel_launch(void* const* d_in, const int* in_sizes, int n_in, void* d_out, int out_size, void* d_ws, size_t ws_size, hipStream_t stream) {
    static int grid = 0;
    if (grid == 0) {
        if (n_in != 31 || in_sizes[0] != M * D || out_size != M * D || ws_size < WS_END) { fprintf(stderr, "kernel_launch: unexpected shapes (n_in %d, in0 %d, out %d, ws %zu); nothing launched\n", n_in, n_in > 0 ? in_sizes[0] : -1, out_size, ws_size); grid = -1; return; }
        int dev = 0, cus = 0, per_cu = 0;
        if (hipGetDevice(&dev) != hipSuccess || hipDeviceGetAttribute(&cus, hipDeviceAttributeMultiprocessorCount, dev) != hipSuccess) { grid = -1; return; }
        if (hipFuncSetAttribute((const void*)mk_fwd, hipFuncAttributeMaxDynamicSharedMemorySize, LDS_BYTES) != hipSuccess) { fprintf(stderr, "kernel_launch: hipFuncSetAttribute failed\n"); grid = -1; return; }
        if (hipOccupancyMaxActiveBlocksPerMultiprocessor(&per_cu, (const void*)mk_fwd, NTHREADS, LDS_BYTES) != hipSuccess || per_cu < 1) { fprintf(stderr, "kernel_launch: occupancy query says %d\n", per_cu); per_cu = 1; }
        (void)hipGetLastError();
        grid = cus * per_cu;
    }
    if (grid < 0) return;
    if (hipMemsetAsync((char*)d_ws + WS_CTL, 0, CTL_ZERO_BYTES, stream) != hipSuccess) { fprintf(stderr, "kernel_launch: memset failed\n"); return; }
    Args a{};
    for (int i = 0; i < 31; ++i) a.in[i] = (const float*)d_in[i];
    a.out = (float*)d_out; a.ws = (unsigned char*)d_ws;
    void* kargs[] = {&a};
    hipError_t e = hipLaunchCooperativeKernel((const void*)mk_fwd, dim3(grid), dim3(NTHREADS), kargs, LDS_BYTES, stream);
    if (e != hipSuccess) fprintf(stderr, "kernel_launch: cooperative launch failed: %s (grid %d)\n", hipGetErrorString(e), grid);
}
```

```cpp
#include <hip/hip_runtime.h>
#include <hip/hip_cooperative_groups.h>
#include <cstdio>
#include <cstdint>
namespace cg = cooperative_groups;

template <int K> __device__ __forceinline__ float sx_xor(float v) { return __int_as_float(__builtin_amdgcn_ds_swizzle(__float_as_int(v), (K << 10) | 0x1f)); }
__device__ __forceinline__ float sx_add32(float v) { auto rr = __builtin_amdgcn_permlane32_swap(__float_as_uint(v), __float_as_uint(v), false, false); return __uint_as_float(rr[0]) + __uint_as_float(rr[1]); }
__device__ __forceinline__ float sx_wave_sum(float v) { v += sx_xor<1>(v); v += sx_xor<2>(v); v += sx_xor<4>(v); v += sx_xor<8>(v); v += sx_xor<16>(v); return sx_add32(v); }
namespace pg8 {
#define PG8_LAS __attribute__((address_space(3)))
typedef unsigned short bf16_t;
typedef short bf16x8 __attribute__((ext_vector_type(8)));
typedef float f32x4 __attribute__((ext_vector_type(4)));
typedef unsigned u32x4 __attribute__((ext_vector_type(4)));
constexpr int BM = 256, BK = 64, HALF = 128, HTB = HALF * BK * 2  , STAGE_BYTES = 8 * HTB, NXCD = 8, WGM = 8;

__host__ __device__ __forceinline__ int lds_byte(int r, int c) { const int st = (r >> 4) * 2 + (c >> 5), rr = r & 15, cc = c & 31, ob = rr * 64 + cc * 2; return st * 1024 + (ob ^ (((ob >> 9) & 1) << 5)); }
__host__ __device__ __forceinline__ void stage_rc(int b, int& R, int& C) { const int st = b / 1024, sb = b % 1024, swz = sb ^ (((sb >> 9) & 1) << 5); R = (st >> 1) * 16 + swz / 64; C = (st & 1) * 32 + (swz % 64) / 2; }
__host__ __device__ __forceinline__ int perm32(int rho) { const int n = rho >> 4, i = rho & 15; return 8 * (i >> 2) + 4 * n + (i & 3); }

struct Unit { int pm, pn; };
struct Gemm { const bf16_t* A; const bf16_t* Bt; int lda, ldb, K; };

struct StaticOrder {
    int nM, nN, nwg, G, c;
    __host__ __device__ void init(int M, int N, int G_, int c_) { nM = M / BM; nN = N / BM; nwg = nM * nN; G = G_; c = c_; }
    __host__ __device__ bool next(int i, Unit& u) const {
        const long L = (long)i * G + c; if (L >= nwg) return false;
        int wgid = (int)L; { const int q = nwg / NXCD, r = nwg % NXCD, xcd = wgid % NXCD, off = wgid / NXCD; wgid = (xcd < r ? xcd * (q + 1) : r * (q + 1) + (xcd - r) * q) + off; }
        const int nig = WGM * nN, gid = wgid / nig, fm = gid * WGM, gsz = (nM - fm) < WGM ? (nM - fm) : WGM;
        u.pm = fm + ((wgid % nig) % gsz); u.pn = (wgid % nig) / gsz; return true;
    }
    __device__ __forceinline__ void a_ready(const Unit&) const {}
    __device__ __forceinline__ void done(const Unit&) const {}
};

__device__ __forceinline__ unsigned cvt_pk_bf16(float lo, float hi) { unsigned r; asm volatile("v_cvt_pk_bf16_f32 %0, %1, %2" : "=v"(r) : "v"(lo), "v"(hi)); return r; }

__device__ __forceinline__ float bf_lo(unsigned u) { return __uint_as_float(u << 16); }
__device__ __forceinline__ float bf_hi(unsigned u) { return __uint_as_float(u & 0xffff0000u); }
__device__ __forceinline__ float sigmoidf_fast(float x) { return __builtin_amdgcn_rcpf(1.0f + __expf(-x)); }
__device__ __forceinline__ void unpack8(const u32x4 w, float (&f)[8]) { f[0] = bf_lo(w.x); f[1] = bf_hi(w.x); f[2] = bf_lo(w.y); f[3] = bf_hi(w.y); f[4] = bf_lo(w.z); f[5] = bf_hi(w.z); f[6] = bf_lo(w.w); f[7] = bf_hi(w.w); }
enum { EP_PROJ = 0, EP_GLU = 1, EP_BS = 2, EP_BA = 3, EP_OUT = 4, EP_UP = 5, EP_DOWN = 6, EP_UPC = 7 };
template <int MODE> struct Epi {
    static constexpr bool PERM = (MODE != EP_OUT && MODE != EP_DOWN), AFTER_DRAIN = false;
    bf16_t* O; int ldo;
    const bf16_t* X1; int ldx1;
    const bf16_t* X2; int ldx2;
    const float* bias;
    float* F; const float* R; const float* gate; float alpha;
    float qscale;
    bf16_t* S0; bf16_t* S1; bf16_t* S2; const float* cw; const float* cb;
    __device__ __forceinline__ void operator()(const f32x4 (&acc)[2][2][4][2], const Unit& u, int wr, int wc, int fr, int fq) const {
        if constexpr (MODE == EP_UPC) {
            constexpr int FFc = 2816;
            int lane_ = (int)(threadIdx.x & 63); asm volatile("" : "+v"(lane_));
            const int src1 = (lane_ & 48) | ((fr + 15) & 15), src2 = (lane_ & 48) | ((fr + 14) & 15);
            const int row0 = u.pm * BM + wr * 64 + fr, fb0 = u.pn * 128 + wc * 16 + 4 * fq;
            f32x4 w0v[2], w1v[2], w2v[2], cbv[2];
#pragma unroll
            for (int bj = 0; bj < 2; ++bj) { w0v[bj] = *(const f32x4*)(cw + fb0 + bj * 64); w1v[bj] = *(const f32x4*)(cw + FFc + fb0 + bj * 64); w2v[bj] = *(const f32x4*)(cw + 2 * FFc + fb0 + bj * 64); cbv[bj] = *(const f32x4*)(cb + fb0 + bj * 64); }
#pragma unroll
            for (int ai = 0; ai < 2; ++ai)
#pragma unroll
                for (int m = 0; m < 4; ++m) {
                    const int row = row0 + ai * HALF + m * 16; const int strip = row >> 6;
#pragma unroll
                    for (int bj = 0; bj < 2; ++bj) {
                        const int fb = fb0 + bj * 64;
                        const f32x4 A = acc[ai][bj][m][0], V = acc[ai][bj][m][1];
                        const f32x4 Ap = acc[ai][bj][m > 0 ? m - 1 : 0][0];
                        float g[4];
#pragma unroll
                        for (int i = 0; i < 4; ++i) {
                            const float c1 = __shfl(A[i], src1), c2 = __shfl(A[i], src2);
                            float p1 = c1, p2 = c2;
                            if (m > 0) { const float d1 = __shfl(Ap[i], src1), d2 = __shfl(Ap[i], src2); p1 = (fr >= 1) ? c1 : d1; p2 = (fr >= 2) ? c2 : d2; }
                            const float cv = w0v[bj][i] * p2 + w1v[bj][i] * p1 + w2v[bj][i] * A[i] + cbv[bj][i];
                            g[i] = cv * sigmoidf_fast(cv) * V[i];
                        }
                        typedef unsigned u32x2 __attribute__((ext_vector_type(2)));
                        if (m == 0 && fr < 2) {
                            u32x2 wa; wa.x = cvt_pk_bf16(A[0], A[1]); wa.y = cvt_pk_bf16(A[2], A[3]);
                            u32x2 wv; wv.x = cvt_pk_bf16(V[0], V[1]); wv.y = cvt_pk_bf16(V[2], V[3]);
                            *(u32x2*)(S0 + ((size_t)strip * 2 + fr) * FFc + fb) = wa; *(u32x2*)(S1 + ((size_t)strip * 2 + fr) * FFc + fb) = wv;
                        } else {
                            u32x2 wg; wg.x = cvt_pk_bf16(g[0], g[1]); wg.y = cvt_pk_bf16(g[2], g[3]);
                            *(u32x2*)(O + (size_t)row * ldo + fb) = wg;
                        }
                        if (m == 3 && fr >= 14) { u32x2 wa; wa.x = cvt_pk_bf16(A[0], A[1]); wa.y = cvt_pk_bf16(A[2], A[3]); *(u32x2*)(S2 + ((size_t)strip * 2 + (fr - 14)) * FFc + fb) = wa; }
                    }
                    asm volatile("" ::: "memory");
                }
        } else
        if constexpr (PERM) {
            const int row0 = u.pm * BM + wr * 64 + fr, col0 = u.pn * BM + wc * 32 + 8 * fq;
            float sc = 1.f; if (MODE == EP_PROJ) { const int colt = u.pn * BM; if (colt >= 1024 && colt < 2048) sc = qscale; }
            float bv[2][8];
            if (MODE == EP_GLU) {
#pragma unroll
                for (int bj = 0; bj < 2; ++bj) { const f32x4 b0 = *(const f32x4*)(bias + col0 + bj * HALF), b1 = *(const f32x4*)(bias + col0 + bj * HALF + 4);
                    bv[bj][0] = b0[0]; bv[bj][1] = b0[1]; bv[bj][2] = b0[2]; bv[bj][3] = b0[3]; bv[bj][4] = b1[0]; bv[bj][5] = b1[1]; bv[bj][6] = b1[2]; bv[bj][7] = b1[3]; }
            }
#pragma unroll
            for (int ai = 0; ai < 2; ++ai) {
                u32x4 x1v[4][2], x2v[4][2];
                if (MODE == EP_GLU || MODE == EP_BS || MODE == EP_BA) {
#pragma unroll
                    for (int m = 0; m < 4; ++m)
#pragma unroll
                        for (int bj = 0; bj < 2; ++bj) x1v[m][bj] = *(const u32x4*)(X1 + (size_t)(row0 + ai * HALF + m * 16) * ldx1 + col0 + bj * HALF);
                }
                if (MODE == EP_BA) {
#pragma unroll
                    for (int m = 0; m < 4; ++m)
#pragma unroll
                        for (int bj = 0; bj < 2; ++bj) x2v[m][bj] = *(const u32x4*)(X2 + (size_t)(row0 + ai * HALF + m * 16) * ldx2 + col0 + bj * HALF);
                }
#pragma unroll
                for (int m = 0; m < 4; ++m) {
                    const size_t row = (size_t)(row0 + ai * HALF + m * 16);
#pragma unroll
                    for (int bj = 0; bj < 2; ++bj) {
                        const int col = col0 + bj * HALF;
                        float v[8];
#pragma unroll
                        for (int j = 0; j < 4; ++j) { v[j] = acc[ai][bj][m][0][j]; v[4 + j] = acc[ai][bj][m][1][j]; }
                        if (MODE == EP_PROJ) {
#pragma unroll
                            for (int j = 0; j < 8; ++j) v[j] *= sc;
                        }
                        if (MODE == EP_GLU) {
                            float z[8]; unpack8(x1v[m][bj], z);
#pragma unroll
                            for (int j = 0; j < 8; ++j) v[j] = z[j] * sigmoidf_fast(v[j] + bv[bj][j]);
                        }
                        if (MODE == EP_BS) {
                            float gt[8]; unpack8(x1v[m][bj], gt);
#pragma unroll
                            for (int j = 0; j < 8; ++j) v[j] = sigmoidf_fast(gt[j]) * v[j];
                        }
                        if (MODE == EP_BA) {
                            float gt[8], m1[8]; unpack8(x1v[m][bj], gt); unpack8(x2v[m][bj], m1);
#pragma unroll
                            for (int j = 0; j < 8; ++j) v[j] = m1[j] + sigmoidf_fast(gt[j]) * v[j];
                        }
                        u32x4 w; w.x = cvt_pk_bf16(v[0], v[1]); w.y = cvt_pk_bf16(v[2], v[3]); w.z = cvt_pk_bf16(v[4], v[5]); w.w = cvt_pk_bf16(v[6], v[7]);
                        *(u32x4*)(O + row * ldo + col) = w;
                    }
                }
                asm volatile("" ::: "memory");
            }
        } else {
            const int row0 = u.pm * BM + wr * 64 + fr, col0 = u.pn * BM + wc * 32 + 4 * fq;
            const float* gp = gate + (size_t)((u.pm * BM) >> 12) * 6144;
            f32x4 gv[2][2];
#pragma unroll
            for (int bj = 0; bj < 2; ++bj)
#pragma unroll
                for (int n = 0; n < 2; ++n) gv[bj][n] = *(const f32x4*)(gp + col0 + bj * HALF + n * 16);
#pragma unroll
            for (int ai = 0; ai < 2; ++ai)
#pragma unroll
                for (int mh = 0; mh < 2; ++mh) {
                    f32x4 rs[2][2][2];
#pragma unroll
                    for (int mm = 0; mm < 2; ++mm)
#pragma unroll
                        for (int bj = 0; bj < 2; ++bj)
#pragma unroll
                            for (int n = 0; n < 2; ++n) rs[mm][bj][n] = *(const f32x4*)(R + (size_t)(row0 + ai * HALF + (2 * mh + mm) * 16) * 1024 + col0 + bj * HALF + n * 16);
#pragma unroll
                    for (int mm = 0; mm < 2; ++mm)
#pragma unroll
                        for (int bj = 0; bj < 2; ++bj)
#pragma unroll
                            for (int n = 0; n < 2; ++n) *(f32x4*)(F + (size_t)(row0 + ai * HALF + (2 * mh + mm) * 16) * 1024 + col0 + bj * HALF + n * 16) = rs[mm][bj][n] * alpha + gv[bj][n] * acc[ai][bj][2 * mh + mm][n];
                    asm volatile("" ::: "memory");
                }
        }
    }
};

struct PanelStats {
    unsigned* xbuf;
    unsigned* cnt;
    unsigned* tmo;
    int ntn; float eps;
    unsigned code;
    __device__ __forceinline__ bool run(const f32x4 (&v)[2][2][4][2], const Unit& u, int wr, int wc, int fr, int fq, PG8_LAS unsigned char* lds, int wid, int lane) const {
        typedef float f32x2v __attribute__((ext_vector_type(2)));
        PG8_LAS f32x2v* P = (PG8_LAS f32x2v*)lds;
        PG8_LAS f32x2v* S = (PG8_LAS f32x2v*)(lds + 8192);
        PG8_LAS unsigned* flag = (PG8_LAS unsigned*)(lds + 8192 + 2048);
#pragma unroll
        for (int ai = 0; ai < 2; ++ai)
#pragma unroll
            for (int m = 0; m < 4; ++m) {
                float s = 0.f;
#pragma unroll
                for (int bj = 0; bj < 2; ++bj)
#pragma unroll
                    for (int n = 0; n < 2; ++n) { const f32x4 x = v[ai][bj][m][n]; s += (x[0] + x[1]) + (x[2] + x[3]); }
                s += sx_xor<16>(s); s = sx_add32(s);
                const float mw = s * (1.0f / 64.0f); float q = 0.f;
#pragma unroll
                for (int bj = 0; bj < 2; ++bj)
#pragma unroll
                    for (int n = 0; n < 2; ++n) { const f32x4 d = v[ai][bj][m][n] - mw; q += (d[0] * d[0] + d[1] * d[1]) + (d[2] * d[2] + d[3] * d[3]); }
                q += sx_xor<16>(q); q = sx_add32(q);
                if (fq == 0) P[(ai * HALF + wr * 64 + m * 16 + fr) * 4 + wc] = (f32x2v){mw, q};
            }
        asm volatile("s_waitcnt lgkmcnt(0)" ::: "memory"); __builtin_amdgcn_s_barrier(); asm volatile("" ::: "memory");
#if defined(BROKEN_EXCHANGE_NO_WAIT)
#warning BROKEN CONTROL BUILD: the row-statistics exchange does not wait; results are wrong by design
        if (blockIdx.x >= 64) { const long long t0_ = clock64(); while (clock64() - t0_ < 60000) __builtin_amdgcn_s_sleep(8); }
#endif
        const int row = wid * 32 + (lane & 31);
        if (lane < 32) {
            const f32x2v a = P[row * 4 + 0], b = P[row * 4 + 1], c = P[row * 4 + 2], d = P[row * 4 + 3];
            const float mt = (a.x + b.x + c.x + d.x) * 0.25f;
            const float da = a.x - mt, db = b.x - mt, dc = c.x - mt, dd = d.x - mt;
            const float m2 = (a.y + b.y) + (c.y + d.y) + 64.0f * ((da * da + db * db) + (dc * dc + dd * dd));
            unsigned long long* slot = (unsigned long long*)xbuf + ((size_t)(u.pm * BM + row) * 4 + u.pn);
            __hip_atomic_store(slot, ((unsigned long long)__float_as_uint(m2) << 32) | __float_as_uint(mt), __ATOMIC_RELAXED, __HIP_MEMORY_SCOPE_AGENT);
        }
        asm volatile("s_waitcnt vmcnt(0)" ::: "memory");
        if (lane == 0) __hip_atomic_fetch_add(cnt + 64 * u.pm, 1u, __ATOMIC_RELAXED, __HIP_MEMORY_SCOPE_AGENT);
        if (wid == 0) {
            bool dead = false; const unsigned long long t0 = __builtin_amdgcn_s_memrealtime(); const unsigned want = 8u * (unsigned)ntn;
            for (;;) {
#if defined(BROKEN_EXCHANGE_NO_WAIT)
                break;
#endif
                if ((unsigned)__builtin_amdgcn_readfirstlane(__hip_atomic_load(cnt + 64 * u.pm, __ATOMIC_RELAXED, __HIP_MEMORY_SCOPE_AGENT)) >= want) break;
                if (__builtin_amdgcn_s_memrealtime() - t0 > 2000000ull) {
                    if (lane == 0) { unsigned expect = 0u; __hip_atomic_compare_exchange_strong(tmo + 1, &expect, code | (unsigned)(u.pm & 0xff), __ATOMIC_RELAXED, __ATOMIC_RELAXED, __HIP_MEMORY_SCOPE_AGENT);
                                     __hip_atomic_store(tmo, 1u, __ATOMIC_RELAXED, __HIP_MEMORY_SCOPE_AGENT); }
                    dead = true; break; }
                __builtin_amdgcn_s_sleep(2);
            }
            __builtin_amdgcn_fence(__ATOMIC_ACQUIRE, "agent");
            if (lane == 0) flag[0] = dead ? 1u : 0u;
        }
        asm volatile("s_waitcnt vmcnt(0) lgkmcnt(0)" ::: "memory"); __builtin_amdgcn_s_barrier(); asm volatile("" ::: "memory");
        const bool bad = flag[0] != 0u;
        if (lane < 32) {
            const unsigned long long* slot = (const unsigned long long*)xbuf + (size_t)(u.pm * BM + row) * 4; float mt[4], m2[4]; float ms = 0.f;
#pragma unroll
            for (int t = 0; t < 4; ++t) { if (t < ntn) { const unsigned long long w = __hip_atomic_load(slot + t, __ATOMIC_RELAXED, __HIP_MEMORY_SCOPE_AGENT); mt[t] = __uint_as_float((unsigned)w); m2[t] = __uint_as_float((unsigned)(w >> 32)); } else { mt[t] = 0.f; m2[t] = 0.f; } ms += mt[t]; }
            const float mean = ms / (float)ntn; float q = 0.f;
#pragma unroll
            for (int t = 0; t < 4; ++t) if (t < ntn) { const float dm = mt[t] - mean; q += m2[t] + 256.0f * dm * dm; }
            S[row] = (f32x2v){mean, 1.0f / sqrtf(q / (256.0f * (float)ntn) + eps)};
        }
        asm volatile("s_waitcnt lgkmcnt(0)" ::: "memory"); __builtin_amdgcn_s_barrier(); asm volatile("" ::: "memory");
        return bad;
    }
};

template <bool TWO> struct EpiLnFused {
    static constexpr bool PERM = false, AFTER_DRAIN = true;
    const float* R; float* F; bf16_t* H; const float* gate; const float* lg; const float* lb; const float* sh; const float* sc; float alpha; PanelStats st1, st2;
    __device__ __forceinline__ void fused(f32x4 (&acc)[2][2][4][2], const Unit& u, int wr, int wc, int fr, int fq, PG8_LAS unsigned char* lds, int wid, int lane) const {
        typedef float f32x2v __attribute__((ext_vector_type(2))); typedef unsigned u32x2v __attribute__((ext_vector_type(2)));
        const PG8_LAS f32x2v* S = (const PG8_LAS f32x2v*)(lds + 8192);
        const int col0 = u.pn * BM + wc * 32 + 4 * fq; const size_t boff = (size_t)((u.pm * BM) >> 12) * 6144;
        const size_t rowoff = (size_t)(u.pm * BM + wr * 64 + fr) * 1024 + col0;
        f32x4 gv[2][2];
#pragma unroll
        for (int bj = 0; bj < 2; ++bj)
#pragma unroll
            for (int n = 0; n < 2; ++n) gv[bj][n] = *(const f32x4*)(gate + boff + col0 + bj * HALF + n * 16);
#pragma unroll
        for (int ai = 0; ai < 2; ++ai)
#pragma unroll
            for (int bj = 0; bj < 2; ++bj) {
                f32x4 rs[2][4];
#pragma unroll
                for (int n = 0; n < 2; ++n)
#pragma unroll
                    for (int m = 0; m < 4; ++m) rs[n][m] = *(const f32x4*)(R + rowoff + (size_t)(ai * HALF + m * 16) * 1024 + bj * HALF + n * 16);
#pragma unroll
                for (int n = 0; n < 2; ++n)
#pragma unroll
                    for (int m = 0; m < 4; ++m) acc[ai][bj][m][n] = rs[n][m] * alpha + gv[bj][n] * acc[ai][bj][m][n];
                asm volatile("" ::: "memory");
            }
        bool bad = st1.run(acc, u, wr, wc, fr, fq, lds, wid, lane);
        const float qnan = __builtin_nanf("");
        const PG8_LAS f32x2v* Sr = S + wr * 64 + fr;
#pragma unroll
        for (int bj = 0; bj < 2; ++bj)
#pragma unroll
            for (int n = 0; n < 2; ++n) { const f32x4 g4 = *(const f32x4*)(lg + col0 + bj * HALF + n * 16), b4 = *(const f32x4*)(lb + col0 + bj * HALF + n * 16);
#pragma unroll
                for (int ai = 0; ai < 2; ++ai)
#pragma unroll
                    for (int m = 0; m < 4; ++m) { const f32x2v s2 = Sr[ai * HALF + m * 16]; f32x4 x1 = (acc[ai][bj][m][n] - s2.x) * s2.y * g4 + b4; if (bad) x1 = (f32x4){qnan, qnan, qnan, qnan};
                        acc[ai][bj][m][n] = x1; *(f32x4*)(F + rowoff + (size_t)(ai * HALF + m * 16) * 1024 + bj * HALF + n * 16) = x1; }
                asm volatile("" ::: "memory"); }
        if constexpr (TWO) {
            bad = st2.run(acc, u, wr, wc, fr, fq, lds, wid, lane) || bad;
#pragma unroll
            for (int bj = 0; bj < 2; ++bj)
#pragma unroll
                for (int n = 0; n < 2; ++n) { const f32x4 c4 = *(const f32x4*)(sc + boff + col0 + bj * HALF + n * 16) + 1.0f, h4 = *(const f32x4*)(sh + boff + col0 + bj * HALF + n * 16);
#pragma unroll
                    for (int ai = 0; ai < 2; ++ai)
#pragma unroll
                        for (int m = 0; m < 4; ++m) { const f32x2v s2 = Sr[ai * HALF + m * 16]; const f32x4 o = (acc[ai][bj][m][n] - s2.x) * s2.y * c4 + h4;
                            u32x2v w; w.x = cvt_pk_bf16(o[0], o[1]); w.y = cvt_pk_bf16(o[2], o[3]); if (bad) { w.x = 0x7fc07fc0u; w.y = 0x7fc07fc0u; }
                            *(u32x2v*)(H + rowoff + (size_t)(ai * HALF + m * 16) * 1024 + bj * HALF + n * 16) = w; }
                    asm volatile("" ::: "memory"); }
        }
        asm volatile("s_waitcnt lgkmcnt(0)" ::: "memory"); __builtin_amdgcn_s_barrier(); asm volatile("" ::: "memory");
    }
};
struct OneUnit { int pm, pn;
    __device__ __forceinline__ bool next(int i, Unit& u) const { if (i != 0) return false; u.pm = pm; u.pn = pn; return true; }
    __device__ __forceinline__ void a_ready(const Unit&) const {}
    __device__ __forceinline__ void done(const Unit&) const {} };

template <class Epi, class Sched, bool ALIGN_EPI = false, bool SP2 = false>
__device__ __forceinline__ void gemm_phase(PG8_LAS unsigned char* lds, const Gemm g, const Sched& S, const Epi& E) {
    int tid_ = threadIdx.x; asm volatile("" : "+v"(tid_)); const int tid = tid_, wid = __builtin_amdgcn_readfirstlane(tid >> 6), lane = tid & 63, wr = wid >> 2, wc = wid & 3, fr = lane & 15, fq = lane >> 4;
    const int K = g.K, nt = K / BK;
    unsigned voffA[2], voffB[2];
#pragma unroll
    for (int i = 0; i < 2; ++i) { int R, C; stage_rc(tid * 16 + i * 8192, R, C); const int Rb = Epi::PERM ? ((R & ~31) + perm32(R & 31)) : R;
        voffA[i] = (unsigned)(R * g.lda + C) * 2u; voffB[i] = (unsigned)(Rb * g.ldb + C) * 2u; }
    const size_t kstep = (size_t)(BK * 2);
    const size_t hstepA = (size_t)HALF * g.lda * 2, hstepB = (size_t)HALF * g.ldb * 2;
    const size_t tstepA = 2 * hstepA, tstepB = 2 * hstepB;
    const unsigned ldsw = (unsigned)wid * 1024u;
    const int aoff = lds_byte(wr * 64 + fr, fq * 8), boff = lds_byte(wc * 32 + fr, fq * 8);
#define PG8_SA(b, h) (((b) * 2 + (h)) * HTB)
#define PG8_SB(b, h) ((4 + (b) * 2 + (h)) * HTB)
#define PG8_STAGE(bufoff, gbase, voff) do { _Pragma("unroll") for (int _i = 0; _i < 2; ++_i) \
        __builtin_amdgcn_global_load_lds((const unsigned*)((const char*)(gbase) + (voff)[_i]), (PG8_LAS unsigned*)(lds + (bufoff) + ldsw + _i * 8192), 16, 0, 0); } while (0)
#define PG8_LDA(dst, b, h) do { _Pragma("unroll") for (int m = 0; m < 4; ++m) _Pragma("unroll") for (int k = 0; k < 2; ++k) dst[m][k] = *(const PG8_LAS bf16x8*)(lds + PG8_SA(b, h) + aoff + m * 2048 + k * 1024); } while (0)
#define PG8_LDB(dst, b, h) do { _Pragma("unroll") for (int n = 0; n < 2; ++n) _Pragma("unroll") for (int k = 0; k < 2; ++k) dst[n][k] = *(const PG8_LAS bf16x8*)(lds + PG8_SB(b, h) + boff + n * 2048 + k * 1024); } while (0)
#define PG8_MMA(ai, bj, At, Bt) do { __builtin_amdgcn_s_setprio(1); _Pragma("unroll") for (int m = 0; m < 4; ++m) _Pragma("unroll") for (int n = 0; n < 2; ++n) _Pragma("unroll") for (int k = 0; k < 2; ++k) \
        acc[ai][bj][m][n] = __builtin_amdgcn_mfma_f32_16x16x32_bf16(Bt[n][k], At[m][k], acc[ai][bj][m][n], 0, 0, 0); __builtin_amdgcn_s_setprio(0); } while (0)
#define PG8_WAIT_V(n) asm volatile("s_waitcnt vmcnt(" #n ")" ::: "memory")
#define PG8_WAIT_L(n) asm volatile("s_waitcnt lgkmcnt(" #n ")" ::: "memory")
#define PG8_BAR __builtin_amdgcn_s_barrier()
#define PG8_SCHED __builtin_amdgcn_sched_barrier(0)
    Unit cur, nxt; int ui = 0;
    if (!S.next(0, cur)) return;
    f32x4 acc[2][2][4][2];
#pragma unroll
    for (int a = 0; a < 2; ++a)
#pragma unroll
        for (int b = 0; b < 2; ++b)
#pragma unroll
            for (int m = 0; m < 4; ++m)
#pragma unroll
                for (int n = 0; n < 2; ++n) acc[a][b][m][n] = (f32x4){0.f, 0.f, 0.f, 0.f};
    bf16x8 At[4][2], B0[2][2], B1[2][2];
    const char* cA = (const char*)g.A + (size_t)cur.pm * tstepA; const char* cB = (const char*)g.Bt + (size_t)cur.pn * tstepB;
    S.a_ready(cur);
    if constexpr (SP2) {
        PG8_STAGE(PG8_SB(0, 0), cB, voffB); PG8_STAGE(PG8_SB(0, 1), cB + hstepB, voffB); PG8_STAGE(PG8_SA(0, 0), cA, voffA); PG8_STAGE(PG8_SA(0, 1), cA + hstepA, voffA);
        if (wr == 1) PG8_BAR;
        PG8_WAIT_V(2); PG8_BAR;
        PG8_STAGE(PG8_SB(1, 0), cB + kstep, voffB); PG8_STAGE(PG8_SA(1, 0), cA + kstep, voffA); PG8_STAGE(PG8_SB(1, 1), cB + hstepB + kstep, voffB);
        PG8_WAIT_V(6); PG8_BAR;
    } else {
        PG8_STAGE(PG8_SB(0, 0), cB, voffB); PG8_STAGE(PG8_SA(0, 0), cA, voffA); PG8_STAGE(PG8_SB(0, 1), cB + hstepB, voffB); PG8_STAGE(PG8_SA(0, 1), cA + hstepA, voffA);
        if (wr == 1) PG8_BAR;
        PG8_WAIT_V(4); PG8_BAR;
        PG8_STAGE(PG8_SB(1, 0), cB + kstep, voffB); PG8_STAGE(PG8_SA(1, 0), cA + kstep, voffA); PG8_STAGE(PG8_SB(1, 1), cB + hstepB + kstep, voffB);
        PG8_WAIT_V(6); PG8_BAR;
    }
    for (;;) {
        const bool has_next = S.next(ui + 1, nxt);
        const char* nA = has_next ? (const char*)g.A + (size_t)nxt.pm * tstepA : cA; const char* nB = has_next ? (const char*)g.Bt + (size_t)nxt.pn * tstepB : cB;
        for (int t = 0; t < nt; t += 2) {
            const bool last = (t == nt - 2);
            const char* a1 = cA + (size_t)(t + 1) * kstep;
            const char* a2 = last ? nA : cA + (size_t)(t + 2) * kstep; const char* b2 = last ? nB : cB + (size_t)(t + 2) * kstep;
            const char* a3 = a2 + kstep; const char* b3 = b2 + kstep;
            if (last && has_next) S.a_ready(nxt);
            if constexpr (SP2) {
            PG8_LDB(B0, 0, 0); PG8_LDB(B1, 0, 1); PG8_SCHED; PG8_LDA(At, 0, 0); PG8_STAGE(PG8_SA(1, 1), a1 + hstepA, voffA);
            PG8_WAIT_V(8); PG8_WAIT_L(0); PG8_BAR; PG8_MMA(0, 0, At, B0); PG8_MMA(0, 1, At, B1); PG8_BAR; PG8_SCHED;
            PG8_LDA(At, 0, 1); PG8_STAGE(PG8_SB(0, 0), b2, voffB); PG8_STAGE(PG8_SB(0, 1), b2 + hstepB, voffB); PG8_STAGE(PG8_SA(0, 0), a2, voffA);
            PG8_WAIT_V(8); PG8_WAIT_L(0); PG8_BAR; PG8_MMA(1, 0, At, B0); PG8_MMA(1, 1, At, B1); PG8_BAR; PG8_SCHED;
            PG8_LDB(B0, 1, 0); PG8_LDB(B1, 1, 1); PG8_SCHED; PG8_LDA(At, 1, 0); PG8_STAGE(PG8_SA(0, 1), a2 + hstepA, voffA);
            PG8_WAIT_V(8); PG8_WAIT_L(0); PG8_BAR; PG8_MMA(0, 0, At, B0); PG8_MMA(0, 1, At, B1); PG8_BAR; PG8_SCHED;
            PG8_LDA(At, 1, 1); PG8_STAGE(PG8_SB(1, 0), b3, voffB); PG8_STAGE(PG8_SB(1, 1), b3 + hstepB, voffB); PG8_STAGE(PG8_SA(1, 0), a3, voffA);
            PG8_WAIT_V(8); PG8_WAIT_L(0); PG8_BAR; PG8_MMA(1, 0, At, B0); PG8_MMA(1, 1, At, B1); PG8_BAR; PG8_SCHED;
            } else {
            PG8_LDB(B0, 0, 0); PG8_SCHED; PG8_LDA(At, 0, 0); PG8_STAGE(PG8_SA(1, 1), a1 + hstepA, voffA);
            PG8_WAIT_L(8); PG8_BAR; PG8_WAIT_L(0); PG8_MMA(0, 0, At, B0); PG8_BAR; PG8_SCHED;
            PG8_LDB(B1, 0, 1); PG8_STAGE(PG8_SB(0, 0), b2, voffB);
            PG8_BAR; PG8_WAIT_L(0); PG8_MMA(0, 1, At, B1); PG8_BAR;
            PG8_LDA(At, 0, 1); PG8_STAGE(PG8_SA(0, 0), a2, voffA);
            PG8_BAR; PG8_WAIT_L(0); PG8_MMA(1, 0, At, B0); PG8_BAR; PG8_SCHED;
            PG8_STAGE(PG8_SB(0, 1), b2 + hstepB, voffB);
            PG8_WAIT_V(6); PG8_BAR; PG8_MMA(1, 1, At, B1); PG8_BAR;
            PG8_LDB(B0, 1, 0); PG8_SCHED; PG8_LDA(At, 1, 0); PG8_STAGE(PG8_SA(0, 1), a2 + hstepA, voffA);
            PG8_WAIT_L(8); PG8_BAR; PG8_WAIT_L(0); PG8_MMA(0, 0, At, B0); PG8_BAR; PG8_SCHED;
            PG8_LDB(B1, 1, 1); PG8_STAGE(PG8_SB(1, 0), b3, voffB);
            PG8_BAR; PG8_WAIT_L(0); PG8_MMA(0, 1, At, B1); PG8_BAR;
            PG8_LDA(At, 1, 1); PG8_STAGE(PG8_SA(1, 0), a3, voffA);
            PG8_BAR; PG8_WAIT_L(0); PG8_MMA(1, 0, At, B0); PG8_BAR; PG8_SCHED;
            PG8_STAGE(PG8_SB(1, 1), b3 + hstepB, voffB);
            PG8_WAIT_V(6); PG8_BAR; PG8_MMA(1, 1, At, B1); PG8_BAR;
            }
        }
        if constexpr (ALIGN_EPI) { if (wr == 0) PG8_BAR; }
        if constexpr (!Epi::AFTER_DRAIN) { E(acc, cur, wr, wc, fr, fq); S.done(cur); }
        if (!has_next) break;
#pragma unroll
        for (int a = 0; a < 2; ++a)
#pragma unroll
            for (int b = 0; b < 2; ++b)
#pragma unroll
                for (int m = 0; m < 4; ++m)
#pragma unroll
                    for (int n = 0; n < 2; ++n) acc[a][b][m][n] = (f32x4){0.f, 0.f, 0.f, 0.f};
        cur = nxt; cA = nA; cB = nB; ++ui;
        if constexpr (ALIGN_EPI) { if (wr == 1) PG8_BAR; }
    }
    PG8_WAIT_V(0);
    if constexpr (!ALIGN_EPI) { if (wr == 0) PG8_BAR; }
    PG8_BAR;
    if constexpr (Epi::AFTER_DRAIN) { E.fused(acc, cur, wr, wc, fr, fq, lds, wid, lane); S.done(cur); }
#undef PG8_SA
#undef PG8_SB
#undef PG8_STAGE
#undef PG8_LDA
#undef PG8_LDB
#undef PG8_MMA
#undef PG8_WAIT_V
#undef PG8_WAIT_L
#undef PG8_BAR
#undef PG8_SCHED
}
}

#include <hip/hip_bf16.h>
#include <cmath>
namespace attn_body {
using bf16=__hip_bfloat16;
using bf16x8=__attribute__((ext_vector_type(8)))short;
using s16x4=__attribute__((ext_vector_type(4)))short;
using f32x16=__attribute__((ext_vector_type(16)))float;
using u32x4=__attribute__((ext_vector_type(4)))unsigned;
constexpr int SEQ=4096,D=64,DM=6144,OP=2048;
constexpr int NW=8,QBLK=32,QB=QBLK*NW,KVBLK=64,NQB=SEQ/QB;
constexpr int ATTN_PITCH=DM, ATTN_UNIT_ROWS=QB;
__device__ __forceinline__ int crow(int r,int hi){return (r&3)+8*(r>>2)+4*hi;}
#define SBAR() __builtin_amdgcn_sched_barrier(0)
__device__ __forceinline__ void cmask(f32x16&p0,f32x16&p1,int jb,int qrel,int hi){
  const float NEG=-INFINITY;
  if(jb>(qrel>>6)){
  #pragma unroll
  for(int r=0;r<16;++r){p0[r]=NEG;p1[r]=NEG;}}
}

constexpr int NSLOT=3, SLOTB=8192;
constexpr int LDS_K=0, LDS_V=NSLOT*SLOTB, LDS_WS=LDS_V+NSLOT*2*SLOTB, LDS_OST=LDS_WS+NW*64*4, LDS_BYTES=LDS_OST+NW*4096;
constexpr float C2=0.125f*1.4426950408889634f;
__device__ __forceinline__ void glds16(const void*gsrc,unsigned lds_dst){unsigned keep;
  asm volatile("s_mov_b32 %0, m0\n\ts_mov_b32 m0, %2\n\ts_nop 0\n\tglobal_load_lds_dwordx4 %1, off\n\ts_mov_b32 m0, %0":"=&s"(keep):"v"(gsrc),"s"(lds_dst):"memory");}
__device__ __forceinline__ float max3f(float a,float b,float c){float r;asm("v_max3_f32 %0, %1, %2, %3":"=v"(r):"v"(a),"v"(b),"v"(c));return r;}
__device__ __forceinline__ float max2f(float a,float b){float r;asm("v_max_f32_e32 %0, %1, %2":"=v"(r):"v"(a),"v"(b));return r;}
__device__ __forceinline__ float fadd_s(float a,float b){float r;asm("v_add_f32_e32 %0, %1, %2":"=v"(r):"v"(a),"v"(b));return r;}
__device__ __forceinline__ float fsub_s(float a,float b){float r;asm("v_sub_f32_e32 %0, %1, %2":"=v"(r):"v"(a),"v"(b));return r;}
typedef float f32x2_t __attribute__((ext_vector_type(2))); typedef __bf16 bf16x2_t __attribute__((ext_vector_type(2)));
__device__ __forceinline__ unsigned cvtpk_s(float lo,float hi){f32x2_t v={lo,hi};bf16x2_t b=__builtin_convertvector(v,bf16x2_t);return __builtin_bit_cast(unsigned,b);}
#define WAIT_BAR(N) asm volatile("s_waitcnt vmcnt(" #N ") lgkmcnt(0)\n\ts_barrier":::"memory")

__device__ __forceinline__ void qkt(f32x16&p0,f32x16&p1,const char*Kslot,const bf16x8*qr,const f32x16&negm,int r32,int hi){
  const char*kb=Kslot+hi*1024+r32*16;
  #pragma unroll
  for(int d0=0;d0<4;++d0){
    const bf16x8 b0=*reinterpret_cast<const bf16x8*>(kb+d0*2048);
    const bf16x8 b1=*reinterpret_cast<const bf16x8*>(kb+d0*2048+512);
    if(d0==0){p0=__builtin_amdgcn_mfma_f32_32x32x16_bf16(b0,qr[0],negm,0,0,0);p1=__builtin_amdgcn_mfma_f32_32x32x16_bf16(b1,qr[0],negm,0,0,0);}
    else{p0=__builtin_amdgcn_mfma_f32_32x32x16_bf16(b0,qr[d0],p0,0,0,0);p1=__builtin_amdgcn_mfma_f32_32x32x16_bf16(b1,qr[d0],p1,0,0,0);}}
}
typedef __attribute__((address_space(3))) const char* lds_cptr;
typedef short v4i16_t __attribute__((ext_vector_type(4)));
__device__ __forceinline__ void kload8(bf16x8*kf,lds_cptr kp){
  kf[0]=*(const __attribute__((address_space(3))) bf16x8*)(kp);      kf[1]=*(const __attribute__((address_space(3))) bf16x8*)(kp+512);
  kf[2]=*(const __attribute__((address_space(3))) bf16x8*)(kp+2048); kf[3]=*(const __attribute__((address_space(3))) bf16x8*)(kp+2560);
  kf[4]=*(const __attribute__((address_space(3))) bf16x8*)(kp+4096); kf[5]=*(const __attribute__((address_space(3))) bf16x8*)(kp+4608);
  kf[6]=*(const __attribute__((address_space(3))) bf16x8*)(kp+6144); kf[7]=*(const __attribute__((address_space(3))) bf16x8*)(kp+6656);
}
__device__ __forceinline__ void kload2(bf16x8*kf,lds_cptr kp,int j){ kf[2*j]=*(const __attribute__((address_space(3))) bf16x8*)(kp+j*2048); kf[2*j+1]=*(const __attribute__((address_space(3))) bf16x8*)(kp+j*2048+512); }
__device__ __forceinline__ s16x4 vtr(lds_cptr p){ return __builtin_bit_cast(s16x4,__builtin_amdgcn_ds_read_tr16_b64_v4i16((__attribute__((address_space(3))) v4i16_t*)p)); }
__device__ __forceinline__ float rowmax(const f32x16&p0,const f32x16&p1){
  float a=max3f(p0[0],p0[1],p1[0]),b=max3f(p0[2],p0[3],p1[1]);a=max3f(a,p1[2],p1[3]);
  #pragma unroll
  for(int r=4;r<16;r+=4){a=max3f(a,p0[r],p0[r+1]);b=max3f(b,p0[r+2],p0[r+3]);a=max3f(a,p1[r],p1[r+1]);b=max3f(b,p1[r+2],p1[r+3]);}
  const float m=max2f(a,b);
  auto rr=__builtin_amdgcn_permlane32_swap(__float_as_uint(m),__float_as_uint(m),false,false);
  return max2f(__uint_as_float(rr[0]),__uint_as_float(rr[1]));
}
__device__ __forceinline__ void pv(f32x16*o,int vb,bf16x8 pa0,bf16x8 pa1,bf16x8 pa2,bf16x8 pa3){
  #pragma unroll
  for(int d0=0;d0<4;++d0){s16x4 lo[4],hi[4];
    #pragma unroll
    for(int ks=0;ks<4;++ks){
      asm volatile("ds_read_b64_tr_b16 %0,%1 offset:%c2":"=&v"(lo[ks]):"v"(vb),"i"(d0*4096+ks*1024):"memory");
      asm volatile("ds_read_b64_tr_b16 %0,%1 offset:%c2":"=&v"(hi[ks]):"v"(vb),"i"(d0*4096+ks*1024+512):"memory");}
    asm volatile("s_waitcnt lgkmcnt(0)":::"memory");SBAR();
    #define PK(k) (bf16x8){lo[k][0],lo[k][1],lo[k][2],lo[k][3],hi[k][0],hi[k][1],hi[k][2],hi[k][3]}
    o[d0]=__builtin_amdgcn_mfma_f32_32x32x16_bf16(pa0,PK(0),o[d0],0,0,0);
    o[d0]=__builtin_amdgcn_mfma_f32_32x32x16_bf16(pa1,PK(1),o[d0],0,0,0);
    o[d0]=__builtin_amdgcn_mfma_f32_32x32x16_bf16(pa2,PK(2),o[d0],0,0,0);
    o[d0]=__builtin_amdgcn_mfma_f32_32x32x16_bf16(pa3,PK(3),o[d0],0,0,0);
    #undef PK
  }
}

#ifndef ATTN_STORE16
#define ATTN_STORE16(p,v) (*(u32x4*)(p)=(v))
#endif
template<int THRL> __device__ __forceinline__ void attn_unit(int b,int h,int hv,int os,int qb,const bf16*Q,const bf16*__restrict__ K,const bf16*__restrict__ V,bf16*O,char*shm){
  int tid_=threadIdx.x; asm volatile("":"+v"(tid_)); const int tid=tid_,lane=tid&63,r32=lane&31,hi=lane>>5; const int wid=__builtin_amdgcn_readfirstlane(tid>>6);
  const long rowbase=(long)b*SEQ; const int q0=qb*QB;
  const bf16*Qw=Q+(rowbase+q0+wid*QBLK)*DM+h*D;
  const bf16*Kh=K+rowbase*DM+h*D,*Vh=V+rowbase*DM+hv*D;
  const unsigned lds0=(unsigned)(uintptr_t)shm;
  float*wsf=(float*)(shm+LDS_WS)+wid*64;
  const bf16*ksrc=Kh+(long)lane*DM+wid*8;
  const bf16*vsrc=Vh+(long)(16*(wid&3)+(lane>>2))*DM+(wid>>2)*32+(lane&3)*8;
  const unsigned kdst=lds0+LDS_K+wid*1024, vdst=lds0+LDS_V+wid*1024;
  #define DMA_K(t,slot) glds16(ksrc+(long)(t)*KVBLK*DM,(unsigned)__builtin_amdgcn_readfirstlane(kdst+(slot)))
  #define DMA_V(t,slot) do{ glds16(vsrc+(long)(t)*KVBLK*DM,(unsigned)__builtin_amdgcn_readfirstlane(vdst+2*(slot))); glds16(vsrc+64+(long)(t)*KVBLK*DM,(unsigned)__builtin_amdgcn_readfirstlane(vdst+2*(slot)+8192)); }while(0)
  const int vb0=(int)(lds0+LDS_V)+((lane>>4)&1)*32+(lane&3)*8+(4*hi+((lane&15)>>2))*64;
  const char*Kbase=shm+LDS_K; bf16x8 kf[8];
  const lds_cptr shm3=(lds_cptr)shm; const lds_cptr kp0=shm3+LDS_K+hi*1024+r32*16; const lds_cptr vp0=shm3+LDS_V+((lane>>4)&1)*32+(lane&3)*8+(4*hi+((lane&15)>>2))*64;
  const int NT=(q0+QB)/KVBLK;
  DMA_K(0,0);DMA_V(0,0);DMA_K(1,SLOTB);
  bf16x8 qr[4];
  #pragma unroll
  for(int d0=0;d0<4;++d0)qr[d0]=*reinterpret_cast<const bf16x8*>(&Qw[(long)r32*DM+d0*16+hi*8]);
  float mhat=0.f,l_reg=0.f;f32x16 o[4];o[0]=f32x16{};o[1]=f32x16{};o[2]=f32x16{};o[3]=f32x16{};const f32x16 negm=f32x16{};
  const int qrel=wid*QBLK+r32;
  #define CMASK(P0,P1,t) do{int jb_=(t)-(NT-4); if(jb_>=0)cmask(P0,P1,jb_,qrel,hi);}while(0)
  bool resc=false;
  #define START(P0,P1) do{ const float rm=rowmax(P0,P1); resc=false; \
    { const float dl=rm; mhat=fadd_s(mhat,dl); \
      _Pragma("unroll") for(int r=0;r<16;++r){P0[r]=fsub_s(P0[r],dl);P1[r]=fsub_s(P1[r],dl);} \
      } \
    _Pragma("unroll") for(int r=0;r<16;++r)P0[r]=__builtin_amdgcn_exp2f(P0[r]); }while(0)
  #define RESC() do{ if(resc){ asm volatile("s_waitcnt lgkmcnt(0)":::"memory"); \
      _Pragma("unroll") for(int d_=0;d_<4;++d_) _Pragma("unroll") for(int r=0;r<16;++r)o[d_][r]*=wsf[crow(r,hi)]; } }while(0)
  f32x16 pA0,pA1,pB0,pB1;
  int sl_prev=0,sl_cur=0,sl_next=SLOTB;
  #define ROT() do{sl_prev=sl_cur;sl_cur=sl_next;sl_next=(sl_next==(NSLOT-1)*SLOTB)?0:sl_next+SLOTB;}while(0)
  DMA_K(2,2*SLOTB);
  WAIT_BAR(4);
  qkt(pA0,pA1,Kbase,qr,negm,r32,hi);asm volatile("s_nop 15\n\ts_nop 7":"+v"(pA0),"+v"(pA1));CMASK(pA0,pA1,0);
  START(pA0,pA1);
  _Pragma("unroll") for(int r=0;r<16;++r)pA1[r]=__builtin_amdgcn_exp2f(pA1[r]);
  WAIT_BAR(0);
  DMA_K(3,0);DMA_V(1,SLOTB);
  ROT();
  kload8(kf,kp0+sl_cur);
  WAIT_BAR(3);
  s16x4 vlo[8],vhi[8]; u32x4 pw0,pw1,pw2,pw3;
  #define PKW(P,B) cvtpk_s(P[B],P[B+1])
  #define PAF(k) __builtin_bit_cast(bf16x8,pw##k)
  #define VFR(i) (bf16x8){vlo[i][0],vlo[i][1],vlo[i][2],vlo[i][3],vhi[i][0],vhi[i][1],vhi[i][2],vhi[i][3]}
  #define PIN(x) asm volatile("":"+v"(x))
  #define MX3(a,b,c) __builtin_fmaxf(__builtin_fmaxf((a),(b)),(c))
  #define GAPA(MF,A0,A1,A2,A3,W0,W1,PW) do{ MF; sacc+=A0; sacc+=A1; sacc+=A2; sacc+=A3; PIN(sacc); W0; W1; PIN(PW); SBAR(); }while(0)
  #define EX(v) __builtin_amdgcn_exp2f(v)
  #define GAPB(MF,X,B) do{ MF; X[B]=EX(X[B]); X[B+1]=EX(X[B+1]); X[B+2]=EX(X[B+2]); X[B+3]=EX(X[B+3]); PIN(X); SBAR(); }while(0)
  #define GAPB2(MF,X,B) do{ MF; X[B]=EX(X[B]); X[B+1]=EX(X[B+1]); PIN(X); SBAR(); }while(0)
  #define VRD2(i) do{ vlo[i]=vtr(vp_+(8192+((i)>>2)*4096+((i)&3)*1024)); vhi[i]=vtr(vp_+(8192+((i)>>2)*4096+((i)&3)*1024+512)); }while(0)
  #define VRD(i) do{ vlo[i]=vtr(vp_+(((i)>>2)*4096+((i)&3)*1024)); vhi[i]=vtr(vp_+(((i)>>2)*4096+((i)&3)*1024+512)); }while(0)
  #define KRD(G,j) do{ if(G){ kload2(kf,kp0+sl_next,j); SBAR(); } }while(0)
  #define STEP(C0,C1,P0,P1,t,GK,GV,GL) do{ SBAR(); \
    const lds_cptr vp_=vp0+2*sl_prev; \
    VRD(0); SBAR(); float sacc=(P0[0]+P0[1]); \
    GAPA(C0=__builtin_amdgcn_mfma_f32_32x32x16_bf16(kf[0],qr[0],negm,0,0,0), P0[2],P0[3],P0[4],P0[5],     pw0[0]=PKW(P0,0), pw0[1]=PKW(P0,2), pw0); \
    VRD(4); SBAR(); GAPA(C1=__builtin_amdgcn_mfma_f32_32x32x16_bf16(kf[1],qr[0],negm,0,0,0), P0[6],P0[7],P0[8],P0[9],     pw0[2]=PKW(P0,4), pw0[3]=PKW(P0,6), pw0); \
    VRD(1); SBAR(); GAPA(C0=__builtin_amdgcn_mfma_f32_32x32x16_bf16(kf[2],qr[1],C0,0,0,0),   P0[10],P0[11],P0[12],P0[13], pw1[0]=PKW(P0,8), pw1[1]=PKW(P0,10), pw1); \
    VRD(5); SBAR(); GAPA(C1=__builtin_amdgcn_mfma_f32_32x32x16_bf16(kf[3],qr[1],C1,0,0,0),   P0[14],P0[15],P1[0],P1[1],   pw1[2]=PKW(P0,12),pw1[3]=PKW(P0,14), pw1); \
    VRD(2); SBAR(); GAPA(C0=__builtin_amdgcn_mfma_f32_32x32x16_bf16(kf[4],qr[2],C0,0,0,0),   P1[2],P1[3],P1[4],P1[5],     pw2[0]=PKW(P1,0), pw2[1]=PKW(P1,2), pw2); \
    VRD(6); SBAR(); GAPA(C1=__builtin_amdgcn_mfma_f32_32x32x16_bf16(kf[5],qr[2],C1,0,0,0),   P1[6],P1[7],P1[8],P1[9],     pw2[2]=PKW(P1,4), pw2[3]=PKW(P1,6), pw2); \
    VRD(3); SBAR(); GAPA(C0=__builtin_amdgcn_mfma_f32_32x32x16_bf16(kf[6],qr[3],C0,0,0,0),   P1[10],P1[11],P1[12],P1[13], pw3[0]=PKW(P1,8), pw3[1]=PKW(P1,10), pw3); \
    VRD(7); SBAR(); GAPA(C1=__builtin_amdgcn_mfma_f32_32x32x16_bf16(kf[7],qr[3],C1,0,0,0),   P1[14],P1[15],0.f,0.f,       pw3[2]=PKW(P1,12),pw3[3]=PKW(P1,14), pw3); \
    l_reg+=sacc; \
    if(GK){DMA_K((t)+3,sl_cur);} if(GV){DMA_V((t)+1,sl_next);} \
    _Pragma("unroll") for(int r=0;r<16;++r){C0[r]-=mhat;C1[r]-=mhat;} \
    CMASK(C0,C1,t); \
    { float a=MX3(C0[0],C0[1],C1[0]),b=MX3(C0[2],C0[3],C1[1]); a=MX3(a,C1[2],C1[3]); \
      _Pragma("unroll") for(int r=4;r<16;r+=4){a=MX3(a,C0[r],C0[r+1]);b=MX3(b,C0[r+2],C0[r+3]);a=MX3(a,C1[r],C1[r+1]);b=MX3(b,C1[r+2],C1[r+3]);} \
      float rm=__builtin_fmaxf(a,b); { auto rr=__builtin_amdgcn_permlane32_swap(__float_as_uint(rm),__float_as_uint(rm),false,false); rm=__builtin_fmaxf(__uint_as_float(rr[0]),__uint_as_float(rr[1])); } \
      resc=false; \
      if(__builtin_expect(__any(rm>(float)THRL),0)){ const float dl=__builtin_fmaxf(rm,0.f); mhat+=dl; \
        _Pragma("unroll") for(int r=0;r<16;++r){C0[r]-=dl;C1[r]-=dl;} \
        const float f=__builtin_amdgcn_exp2f(-dl); l_reg*=f; if(hi==0)wsf[r32]=f; resc=true; } } \
    SBAR(); \
    GAPB2(o[0]=__builtin_amdgcn_mfma_f32_32x32x16_bf16(PAF(0),VFR(0),o[0],0,0,0), C0,0); VRD2(0); SBAR(); \
    GAPB2(o[1]=__builtin_amdgcn_mfma_f32_32x32x16_bf16(PAF(0),VFR(4),o[1],0,0,0), C0,2); VRD2(4); SBAR(); \
    KRD(GL,0); GAPB2(o[0]=__builtin_amdgcn_mfma_f32_32x32x16_bf16(PAF(1),VFR(1),o[0],0,0,0), C0,4); VRD2(1); SBAR(); \
    KRD(GL,1); GAPB2(o[1]=__builtin_amdgcn_mfma_f32_32x32x16_bf16(PAF(1),VFR(5),o[1],0,0,0), C0,6); VRD2(5); SBAR(); \
    KRD(GL,2); GAPB2(o[0]=__builtin_amdgcn_mfma_f32_32x32x16_bf16(PAF(2),VFR(2),o[0],0,0,0), C0,8); VRD2(2); SBAR(); \
    KRD(GL,3); GAPB2(o[1]=__builtin_amdgcn_mfma_f32_32x32x16_bf16(PAF(2),VFR(6),o[1],0,0,0), C0,10); VRD2(6); SBAR(); \
    GAPB2(o[0]=__builtin_amdgcn_mfma_f32_32x32x16_bf16(PAF(3),VFR(3),o[0],0,0,0), C0,12); VRD2(3); SBAR(); \
    GAPB2(o[1]=__builtin_amdgcn_mfma_f32_32x32x16_bf16(PAF(3),VFR(7),o[1],0,0,0), C0,14); VRD2(7); SBAR(); \
    GAPB2(o[2]=__builtin_amdgcn_mfma_f32_32x32x16_bf16(PAF(0),VFR(0),o[2],0,0,0), C1,0); \
    GAPB2(o[3]=__builtin_amdgcn_mfma_f32_32x32x16_bf16(PAF(0),VFR(4),o[3],0,0,0), C1,2); \
    GAPB2(o[2]=__builtin_amdgcn_mfma_f32_32x32x16_bf16(PAF(1),VFR(1),o[2],0,0,0), C1,4); \
    GAPB2(o[3]=__builtin_amdgcn_mfma_f32_32x32x16_bf16(PAF(1),VFR(5),o[3],0,0,0), C1,6); \
    GAPB2(o[2]=__builtin_amdgcn_mfma_f32_32x32x16_bf16(PAF(2),VFR(2),o[2],0,0,0), C1,8); \
    GAPB2(o[3]=__builtin_amdgcn_mfma_f32_32x32x16_bf16(PAF(2),VFR(6),o[3],0,0,0), C1,10); \
    GAPB2(o[2]=__builtin_amdgcn_mfma_f32_32x32x16_bf16(PAF(3),VFR(3),o[2],0,0,0), C1,12); \
    GAPB2(o[3]=__builtin_amdgcn_mfma_f32_32x32x16_bf16(PAF(3),VFR(7),o[3],0,0,0), C1,14); \
    }while(0)
  int t=1;
  #undef CMASK
  #define CMASK(P0,P1,t) do{}while(0)
  for(;t+5<NT;t+=2){
    STEP(pB0,pB1,pA0,pA1,t,true,true,true);     WAIT_BAR(3); RESC(); ROT();
    STEP(pA0,pA1,pB0,pB1,t+1,true,true,true);   WAIT_BAR(3); RESC(); ROT();
  }
  #undef CMASK
  #define CMASK(P0,P1,t) do{int jb_=(t)-(NT-4); if(jb_>=0)cmask(P0,P1,jb_,qrel,hi);}while(0)
  #define ENDW(tt) do{ if((tt)+3<NT){WAIT_BAR(3);} else if((tt)+2<NT){WAIT_BAR(2);} else {WAIT_BAR(0);} }while(0)
  for(;t+1<NT;t+=2){
    STEP(pB0,pB1,pA0,pA1,t,(t+3<NT),(t+1<NT),(t+1<NT));       ENDW(t);   RESC(); ROT();
    STEP(pA0,pA1,pB0,pB1,t+1,(t+4<NT),(t+2<NT),(t+2<NT));     ENDW(t+1); RESC(); ROT();
  }
  STEP(pB0,pB1,pA0,pA1,NT-1,false,false,false); RESC();
  { float sacc=pB0[0]+pB0[1]; _Pragma("unroll") for(int r=2;r<16;++r)sacc+=pB0[r]; _Pragma("unroll") for(int r=0;r<16;++r)sacc+=pB1[r]; l_reg+=sacc;
    pw0=(u32x4){PKW(pB0,0),PKW(pB0,2),PKW(pB0,4),PKW(pB0,6)};pw1=(u32x4){PKW(pB0,8),PKW(pB0,10),PKW(pB0,12),PKW(pB0,14)};pw2=(u32x4){PKW(pB1,0),PKW(pB1,2),PKW(pB1,4),PKW(pB1,6)};pw3=(u32x4){PKW(pB1,8),PKW(pB1,10),PKW(pB1,12),PKW(pB1,14)};
    SBAR(); pv(o,vb0+2*sl_cur,PAF(0),PAF(1),PAF(2),PAF(3)); }
  #undef PKW
  #undef PAF
  #undef VFR
  #undef PIN
  #undef MX3
  #undef GAPA
  #undef GAPB
  #undef EX
  #undef VRD
  #undef VRD2
  #undef GAPB2
  #undef KRD
  #undef STEP
  #undef ENDW
  {auto rr=__builtin_amdgcn_permlane32_swap(__float_as_uint(l_reg),__float_as_uint(l_reg),false,false);l_reg=__uint_as_float(rr[0])+__uint_as_float(rr[1]);}
  if(hi==0)wsf[32+r32]=l_reg;asm volatile("s_waitcnt lgkmcnt(0)":::"memory");
  float rli[16];
  #pragma unroll
  for(int r=0;r<16;++r)rli[r]=__builtin_amdgcn_rcpf(wsf[32+crow(r,hi)]);
  bf16*Ow=O+(rowbase+q0+wid*QBLK)*OP+os*D;
  { bf16*stg=(bf16*)(shm+LDS_OST)+wid*2048;
    #pragma unroll
    for(int hh=0;hh<2;++hh){
    #pragma unroll
    for(int r=0;r<16;++r){const int orow=crow(r,hi);
      #pragma unroll
      for(int d0=0;d0<2;++d0)stg[orow*64+d0*32+r32]=__float2bfloat16(o[2*hh+d0][r]*rli[r]);}
    asm volatile("s_waitcnt lgkmcnt(0)":::"memory");
    #pragma unroll
    for(int i=0;i<4;++i){const int row=i*8+(lane>>3),ch=lane&7; const u32x4 v=*(const u32x4*)(stg+row*64+ch*8); ATTN_STORE16(Ow+(long)row*OP+hh*64+ch*8,v);}
    asm volatile("s_waitcnt lgkmcnt(0)":::"memory"); } }
  asm volatile("s_waitcnt lgkmcnt(0)\n\ts_barrier":::"memory");
  #undef DMA_K
  #undef DMA_V
  #undef CMASK
  #undef START
  #undef RESC
  #undef ROT
}
constexpr int ATTN_LDS_BYTES=LDS_BYTES;
#undef SBAR
#undef WAIT_BAR
}


constexpr int NB = 16, T = 4096, D = 1024, M = NB * T, INW = 6144, FF = 2816, NG = 64, NP = 64;
constexpr float LN_EPS = 1e-5f, RMS_EPS = 1e-5f;
constexpr float DN_ALPHA = 1.189207115002721f;
constexpr float LAMBDA_INIT = 0.2f;
constexpr int NWAVES = 8, NTHREADS = 512;
constexpr size_t MiB = 1u << 20;
constexpr size_t WS_MODP = 0;
constexpr size_t WS_MOD = 6 * MiB;
constexpr size_t WS_WIN = 8 * MiB, WS_WGLU = 20 * MiB, WS_WBS = 22 * MiB, WS_WBA = 24 * MiB, WS_WOUT = 26 * MiB, WS_WUP = 28 * MiB, WS_WDOWN = 40 * MiB;
constexpr size_t WS_PROJ = 64 * MiB;
constexpr size_t WS_HB = 832 * MiB;
constexpr size_t WS_END = 960 * MiB;
constexpr int LDS_BYTES = 147456;
constexpr size_t WS_CTL = 7 * MiB, CTL_ZERO_BYTES = 64 * 1024;
constexpr int CW_BAR = 1024, CW_QUEUE = 8192;
constexpr int LDSCTL_OFF = 131072, MISC_OFF = LDSCTL_OFF + 320;

#define GAS __attribute__((address_space(1)))
#define LAS __attribute__((address_space(3)))
typedef unsigned short bf16;
typedef unsigned v4u __attribute__((ext_vector_type(4)));
typedef unsigned v2u __attribute__((ext_vector_type(2)));
typedef float f32x4 __attribute__((ext_vector_type(4)));
typedef float f32x16 __attribute__((ext_vector_type(16)));
typedef short bf16x8 __attribute__((ext_vector_type(8)));
#define LDS_WAIT() asm volatile("s_waitcnt lgkmcnt(0)" ::: "memory")
__device__ __forceinline__ unsigned f2bf(float f) { unsigned u = __builtin_bit_cast(unsigned, f); return (u + 0x7fffu + ((u >> 16) & 1u)) >> 16; }
typedef float f32x2_t __attribute__((ext_vector_type(2))); typedef __bf16 bf16x2_t __attribute__((ext_vector_type(2)));
__device__ __forceinline__ unsigned pk2(float lo, float hi) { f32x2_t v = {lo, hi}; bf16x2_t b = __builtin_convertvector(v, bf16x2_t); return __builtin_bit_cast(unsigned, b); }
__device__ __forceinline__ float bfl(unsigned u) { return __uint_as_float(u << 16); }
__device__ __forceinline__ float bfh(unsigned u) { return __uint_as_float(u & 0xffff0000u); }
__device__ __forceinline__ float wave_sum(float v) { return sx_wave_sum(v); }
__device__ __forceinline__ float sigm(float x) { return 1.0f / (1.0f + __expf(-x)); }

struct Args { const float* in[31]; float* out; unsigned char* ws; };
typedef const Args __attribute__((address_space(4)))* KArgs;
__device__ __forceinline__ KArgs kargs() { unsigned long long p = (unsigned long long)__builtin_amdgcn_kernarg_segment_ptr(); asm volatile("" : "+s"(p)); return (KArgs)p; }

typedef GAS unsigned gu32;
#define XB_TMO      128
#define XB_XCNT(j)  (256  + 64 * (j))
#define XB_XSUB(j)  (1280 + 64 * (j))
#define XB_XGEN(j)  (2304 + 64 * (j))
#define XB_TOP      3328
#define XB_TOPGEN   3392
#define XCD_BAR_WORDS 3456
#define XB_SPIN_CAP (1u << 18)

__device__ __forceinline__ unsigned xb_ld(unsigned* p)              { return __hip_atomic_load(p, __ATOMIC_RELAXED, __HIP_MEMORY_SCOPE_AGENT); }
__device__ __forceinline__ unsigned xb_add(unsigned* p, unsigned v) { return __hip_atomic_fetch_add(p, v, __ATOMIC_RELAXED, __HIP_MEMORY_SCOPE_AGENT); }
__device__ __forceinline__ unsigned xb_xcc_id() { return (unsigned)__builtin_amdgcn_s_getreg((3 << 11) | 20) & 0xFu; }
#define XB_SPIN(cond, bar) do { unsigned _sp = 0; while (cond) { __builtin_amdgcn_s_sleep(1); \
    if ((++_sp & 255u) == 0u) { if (xb_ld(&(bar)[XB_TMO])) break; if (_sp > XB_SPIN_CAP) { atomicAdd(&(bar)[XB_TMO], 1u); break; } } } } while (0)

struct XcdBarrier {
    unsigned* bar; unsigned x;
    volatile LAS unsigned* st;
};

__device__ __forceinline__ XcdBarrier xcd_barrier_post(unsigned* bar, volatile LAS unsigned* st) {
    XcdBarrier b; b.bar = bar; b.x = xb_xcc_id(); b.st = st;
    if (threadIdx.x == 0) (void)xb_add(&bar[XB_XCNT(b.x)], 1u);
    return b;
}
__device__ __forceinline__ void xcd_barrier_complete(unsigned* bar, unsigned x, unsigned& nloc, unsigned& nx) {
    const unsigned G = gridDim.x * gridDim.y * gridDim.z;
    unsigned sum, cnt, mine, sp = 0u;
    for (;;) {
        sum = 0u; cnt = 0u; mine = 0u;
#pragma unroll
        for (unsigned j = 0; j < 16; ++j) { const unsigned c = xb_ld(&bar[XB_XCNT(j)]); sum += c; cnt += (c > 0u) ? 1u : 0u; mine = (j == x) ? c : mine; }
        if (sum == G) break;
        __builtin_amdgcn_s_sleep(1);
        if ((++sp & 255u) == 0u) { if (xb_ld(&bar[XB_TMO])) break; if (sp > XB_SPIN_CAP) { atomicAdd(&bar[XB_TMO], 1u); break; } }
    }
    nloc = mine > 0u ? mine : 1u; nx = cnt > 0u ? cnt : 1u;
}

__device__ __forceinline__ void xcd_barrier(const XcdBarrier& b) {
    asm volatile("s_waitcnt vmcnt(0)" ::: "memory");
    __syncthreads();
    if (threadIdx.x == 0) {
        unsigned* bar = b.bar;
        __builtin_amdgcn_s_waitcnt(0);
        unsigned nloc = b.st[0], nx = b.st[1];
        if (nloc == 0u) { xcd_barrier_complete(bar, b.x, nloc, nx); b.st[0] = nloc; b.st[1] = nx; }
        const unsigned old = xb_add(&bar[XB_XSUB(b.x)], 1u);
        const unsigned gen = old / nloc;
        if (old + 1u == (gen + 1u) * nloc) {
            __builtin_amdgcn_fence(__ATOMIC_RELEASE, "agent");
            asm volatile("s_waitcnt vmcnt(0)" ::: "memory");
            const unsigned og = xb_add(&bar[XB_TOP], 1u);
            const unsigned tg = og / nx;
            if (og + 1u == (tg + 1u) * nx) xb_add(&bar[XB_TOPGEN], 1u);
            else XB_SPIN(xb_ld(&bar[XB_TOPGEN]) == tg, bar);
            __builtin_amdgcn_fence(__ATOMIC_ACQUIRE, "agent");
            xb_add(&bar[XB_XGEN(b.x)], 1u);
            asm volatile("s_waitcnt vmcnt(0)" ::: "memory");
        } else {
            XB_SPIN(xb_ld(&bar[XB_XGEN(b.x)]) == gen, bar);
            __builtin_amdgcn_fence(__ATOMIC_ACQUIRE, "agent");
            asm volatile("s_waitcnt vmcnt(0)" ::: "memory");
        }
    }
    __syncthreads();
}


template <bool UPPERM = false> __device__ __forceinline__ void p0_transpose_item(const float* W, int K, int N, bf16* WT, LAS float* scr, int item, int lane) {
    const int nblk = N / 32, kb = item / nblk, nb = item % nblk, k0 = 64 * kb, n0 = 32 * nb;
    float tv[32];
#pragma unroll
    for (int i = 0; i < 32; ++i) { const int kk = 2 * i + (lane >> 5); tv[i] = W[(size_t)(k0 + kk) * N + n0 + (lane & 31)]; }
#pragma unroll
    for (int i = 0; i < 32; ++i) { const int kk = 2 * i + (lane >> 5); scr[kk * 33 + (lane & 31)] = tv[i]; }
    LDS_WAIT(); asm volatile("" ::: "memory");
    const int c = lane & 7;
#pragma unroll
    for (int j = 0; j < 4; ++j) { const int n = (lane >> 3) + 8 * j; const LAS float* s = scr + (8 * c) * 33 + n;
        v4u o; o.x = pk2(s[0 * 33], s[1 * 33]); o.y = pk2(s[2 * 33], s[3 * 33]); o.z = pk2(s[4 * 33], s[5 * 33]); o.w = pk2(s[6 * 33], s[7 * 33]);
        int dr = n0 + n; if (UPPERM) { const int f = dr >= FF ? dr - FF : dr; dr = 8 * (f >> 2) + (dr >= FF ? 4 : 0) + (f & 3); }
        *(v4u*)(WT + (size_t)dr * K + k0 + 8 * c) = o; }
    LDS_WAIT(); asm volatile("" ::: "memory");
}

__device__ __forceinline__ void p0_mod_item(const float* c, const float* w_mod, const float* b_mod, float* part, LAS float* scr, int item, int lane) {
    const int cgp = item % 96, ks = item / 96, col = cgp * 64 + lane;
#pragma unroll
    for (int b = 0; b < 16; ++b) { const float cv = c[b * D + ks * 64 + lane]; scr[b * 64 + lane] = cv * sigm(cv); }
    LDS_WAIT(); asm volatile("" ::: "memory");
    float acc[16];
#pragma unroll
    for (int b = 0; b < 16; ++b) acc[b] = 0.f;
    const float* wp = w_mod + (size_t)(ks * 64) * INW + col;
#pragma unroll 1
    for (int k0 = 0; k0 < 64; k0 += 16) {
        float w[16];
#pragma unroll
        for (int kk = 0; kk < 16; ++kk) w[kk] = wp[(size_t)(k0 + kk) * INW];
#pragma unroll
        for (int kk = 0; kk < 16; kk += 4) {
#pragma unroll
            for (int b = 0; b < 16; ++b) { const f32x4 s4 = *(const LAS f32x4*)(scr + b * 64 + k0 + kk); acc[b] += s4.x * w[kk] + s4.y * w[kk + 1] + s4.z * w[kk + 2] + s4.w * w[kk + 3]; }
            asm volatile("" ::: "memory");
        }
    }
    const float bm = (ks == 0) ? b_mod[col] : 0.f;
#pragma unroll
    for (int b = 0; b < 16; ++b) part[((size_t)ks * 16 + b) * INW + col] = acc[b] + bm;
    LDS_WAIT(); asm volatile("" ::: "memory");
}

__device__ __forceinline__ void ldrow(const float* p, int lane, f32x4 (&v)[4]) { const f32x4* xr = (const f32x4*)p + lane;
#pragma unroll
    for (int j = 0; j < 4; ++j) v[j] = xr[64 * j]; }
__device__ __forceinline__ void row_stats2(const f32x4 (&a)[4], const f32x4 (&b)[4], float& ma, float& ra, float& mb, float& rb) {
    float sa = 0.f, qa = 0.f, sb = 0.f, qb = 0.f;
#pragma unroll
    for (int j = 0; j < 4; ++j) { sa += (a[j].x + a[j].y) + (a[j].z + a[j].w); qa += (a[j].x * a[j].x + a[j].y * a[j].y) + (a[j].z * a[j].z + a[j].w * a[j].w);
                                  sb += (b[j].x + b[j].y) + (b[j].z + b[j].w); qb += (b[j].x * b[j].x + b[j].y * b[j].y) + (b[j].z * b[j].z + b[j].w * b[j].w); }
    sa = sx_wave_sum(sa); qa = sx_wave_sum(qa); sb = sx_wave_sum(sb); qb = sx_wave_sum(qb);
    ma = sa * (1.f / D); mb = sb * (1.f / D);
    ra = 1.f / sqrtf(fmaxf(qa * (1.f / D) - ma * ma, 0.f) + LN_EPS); rb = 1.f / sqrtf(fmaxf(qb * (1.f / D) - mb * mb, 0.f) + LN_EPS);
}
__device__ __forceinline__ void st_bf16row(bf16* orow, int lane, const f32x4 (&y)[4]) { v2u* o8 = (v2u*)orow + lane;
#pragma unroll
    for (int j = 0; j < 4; ++j) { v2u w; w.x = pk2(y[j].x, y[j].y); w.y = pk2(y[j].z, y[j].w); o8[64 * j] = w; } }
template <int MODE> __device__ __forceinline__ void ln_pass(const float* src, float* dstf, bf16* dsth, const float* g, const float* bta, const float* mod, int sh_off, int sc_off, int gw, int NGW, int lane) {
    f32x4 ca[4], cb[4], na[4], nb[4];
    int m = gw;
    if (m < M) { ldrow(src + (size_t)m * D, lane, ca); ldrow(src + (size_t)(m + NGW) * D, lane, cb); }
    for (; m < M; m += 2 * NGW) {
        const int mn = m + 2 * NGW;
        if (mn < M) { ldrow(src + (size_t)mn * D, lane, na); ldrow(src + (size_t)(mn + NGW) * D, lane, nb); }
        float ma, ra, mb, rb; row_stats2(ca, cb, ma, ra, mb, rb);
        if (MODE == 0) {
            const float* moda = mod + (size_t)(m >> 12) * INW; const float* modb = mod + (size_t)((m + NGW) >> 12) * INW;
#pragma unroll
            for (int j = 0; j < 4; ++j) { const f32x4 sca = ((const f32x4*)(moda + sc_off))[lane + 64 * j], sha = ((const f32x4*)(moda + sh_off))[lane + 64 * j];
                                          const f32x4 scb = ((const f32x4*)(modb + sc_off))[lane + 64 * j], shb = ((const f32x4*)(modb + sh_off))[lane + 64 * j];
                ca[j] = (ca[j] - ma) * ra * (sca + 1.0f) + sha; cb[j] = (cb[j] - mb) * rb * (scb + 1.0f) + shb; }
            st_bf16row(dsth + (size_t)m * D, lane, ca); st_bf16row(dsth + (size_t)(m + NGW) * D, lane, cb);
        } else {
#pragma unroll
            for (int j = 0; j < 4; ++j) { const f32x4 gg = ((const f32x4*)g)[lane + 64 * j], bb = ((const f32x4*)bta)[lane + 64 * j];
                ca[j] = (ca[j] - ma) * ra * gg + bb; cb[j] = (cb[j] - mb) * rb * gg + bb;
                ((f32x4*)(dstf + (size_t)m * D))[lane + 64 * j] = ca[j]; ((f32x4*)(dstf + (size_t)(m + NGW) * D))[lane + 64 * j] = cb[j]; }
            if (MODE == 1) {
                row_stats2(ca, cb, ma, ra, mb, rb);
                const float* moda = mod + (size_t)(m >> 12) * INW; const float* modb = mod + (size_t)((m + NGW) >> 12) * INW;
#pragma unroll
                for (int j = 0; j < 4; ++j) { const f32x4 sca = ((const f32x4*)(moda + sc_off))[lane + 64 * j], sha = ((const f32x4*)(moda + sh_off))[lane + 64 * j];
                                              const f32x4 scb = ((const f32x4*)(modb + sc_off))[lane + 64 * j], shb = ((const f32x4*)(modb + sh_off))[lane + 64 * j];
                    ca[j] = (ca[j] - ma) * ra * (sca + 1.0f) + sha; cb[j] = (cb[j] - mb) * rb * (scb + 1.0f) + shb; }
                st_bf16row(dsth + (size_t)m * D, lane, ca); st_bf16row(dsth + (size_t)(m + NGW) * D, lane, cb);
            }
        }
#pragma unroll
        for (int j = 0; j < 4; ++j) { ca[j] = na[j]; cb[j] = nb[j]; }
    }
}

__device__ __forceinline__ float gelu_tanh(float x) {
    const float u = 0.7978845608028654f * (x + 0.044715f * x * x * x);
    return x * __builtin_amdgcn_rcpf(1.0f + __expf(-2.0f * u));
}
__device__ __forceinline__ bf16x8 pack8(const float (&f)[8]) {
    v4u w; w.x = pk2(f[0], f[1]); w.y = pk2(f[2], f[3]); w.z = pk2(f[4], f[5]); w.w = pk2(f[6], f[7]); return __builtin_bit_cast(bf16x8, w);
}

__device__ __forceinline__ void ssm_item(KArgs a, int g, int bp, LAS unsigned char* wl, int lane) {
    const float* lam_re = a->in[5]; const float* lam_im = a->in[6]; const float* log_dt = a->in[7];
    const float* b_re = a->in[8]; const float* b_im = a->in[9]; const float* c_re = a->in[10]; const float* c_im = a->in[11]; const float* dsk = a->in[12];
    const bf16* proj = (const bf16*)(a->ws + WS_PROJ); bf16* zb = (bf16*)(a->ws + WS_HB);
    const int r = lane & 31, h = lane >> 5;
    const float dt = expf(log_dt[g]);
    float are[2], aim[2];
    bf16x8 bfr[4];
#pragma unroll
    for (int i = 0; i < 2; ++i) {
        const int p = r + 32 * i; const float lr = lam_re[g * NP + p], li = lam_im[g * NP + p];
        const float mag = expf(lr * dt), ar = mag * cosf(li * dt), ai = mag * sinf(li * dt);
        const float den = lr * lr + li * li, nr = ar - 1.0f, ni = ai;
        const float cr = (nr * lr + ni * li) / den, ci = (ni * lr - nr * li) / den;
        are[i] = ar; aim[i] = ai;
        const float* br = b_re + ((size_t)(g * NP + p)) * 16 + 8 * h; const float* bi = b_im + ((size_t)(g * NP + p)) * 16 + 8 * h;
        float fre[8], fim[8];
#pragma unroll
        for (int j = 0; j < 8; ++j) { fre[j] = cr * br[j] - ci * bi[j]; fim[j] = cr * bi[j] + ci * br[j]; }
        bfr[i] = pack8(fre); bfr[2 + i] = pack8(fim);
    }
    const int cch = lane & 15, kg = lane >> 4;
    bf16x8 cfr[4], dfr;
#pragma unroll
    for (int s = 0; s < 4; ++s) {
        const int p0 = 8 * s + 2 * kg; const float* cr = c_re + ((size_t)(g * 16 + cch)) * NP; const float* ci = c_im + ((size_t)(g * 16 + cch)) * NP;
        float f[8] = {cr[p0], -ci[p0], cr[p0 + 32], -ci[p0 + 32], cr[p0 + 1], -ci[p0 + 1], cr[p0 + 33], -ci[p0 + 33]};
        cfr[s] = pack8(f);
    }
    { float f[8];
#pragma unroll
      for (int j = 0; j < 8; ++j) f[j] = (kg < 2 && (8 * kg + j) == cch) ? dsk[g * 16 + cch] : 0.f;
      dfr = pack8(f); }
    const int b0 = 2 * bp;
    const int beta_r = (r >> 2) & 1, tok_r = 4 * (r >> 3) + (r & 3);
    const bf16* ua = proj + ((size_t)(b0 + beta_r) * T + tok_r) * INW + g * 16 + 8 * h;
    const bf16* ud = proj + ((size_t)b0 * T + cch) * INW + g * 16 + 8 * (kg & 1);
    bf16* zo = zb + ((size_t)b0 * T + 4 * kg) * D + g * 16 + cch;
    float sr[2] = {0.f, 0.f}, si[2] = {0.f, 0.f};
    LAS unsigned char* wrow = wl + (16 * h) * 272 + 8 * r;
    const LAS unsigned char* rrow = wl + cch * 272 + 16 * kg;
    bf16x8 af = *(const bf16x8*)(ua);
    for (int t0 = 0; t0 < T; t0 += 16) {
        const bf16x8 afc = af;
        if (t0 + 16 < T) af = *(const bf16x8*)(ua + (size_t)(t0 + 16) * INW);
        bf16x8 u0 = {0, 0, 0, 0, 0, 0, 0, 0}, u1 = {0, 0, 0, 0, 0, 0, 0, 0};
        if (kg < 2) { u0 = *(const bf16x8*)(ud + (size_t)t0 * INW); u1 = *(const bf16x8*)(ud + (size_t)(T + t0) * INW); }
        const f32x16 zz = {0.f, 0.f, 0.f, 0.f, 0.f, 0.f, 0.f, 0.f, 0.f, 0.f, 0.f, 0.f, 0.f, 0.f, 0.f, 0.f};
        const f32x16 bre0 = __builtin_amdgcn_mfma_f32_32x32x16_bf16(afc, bfr[0], zz, 0, 0, 0);
        const f32x16 bre1 = __builtin_amdgcn_mfma_f32_32x32x16_bf16(afc, bfr[1], zz, 0, 0, 0);
        const f32x16 bim0 = __builtin_amdgcn_mfma_f32_32x32x16_bf16(afc, bfr[2], zz, 0, 0, 0);
        const f32x16 bim1 = __builtin_amdgcn_mfma_f32_32x32x16_bf16(afc, bfr[3], zz, 0, 0, 0);
#pragma unroll
        for (int t = 0; t < 16; ++t) {
            const float nr0 = are[0] * sr[0] - aim[0] * si[0] + bre0[t], ni0 = are[0] * si[0] + aim[0] * sr[0] + bim0[t];
            const float nr1 = are[1] * sr[1] - aim[1] * si[1] + bre1[t], ni1 = are[1] * si[1] + aim[1] * sr[1] + bim1[t];
            sr[0] = nr0; si[0] = ni0; sr[1] = nr1; si[1] = ni1;
            v2u w; w.x = pk2(nr0, ni0); w.y = pk2(nr1, ni1);
            *(LAS v2u*)(wrow + t * 272) = w;
        }
        LDS_WAIT(); asm volatile("" ::: "memory");
#pragma unroll
        for (int be = 0; be < 2; ++be) {
            f32x4 y = {0.f, 0.f, 0.f, 0.f};
#pragma unroll
            for (int s = 0; s < 4; ++s) { const bf16x8 sa = *(const LAS bf16x8*)(rrow + be * 16 * 272 + 64 * s); y = __builtin_amdgcn_mfma_f32_16x16x32_bf16(sa, cfr[s], y, 0, 0, 0); }
            y = __builtin_amdgcn_mfma_f32_16x16x32_bf16(be ? u1 : u0, dfr, y, 0, 0, 0);
#pragma unroll
            for (int q = 0; q < 4; ++q) zo[((size_t)be * T + t0 + q) * D] = (bf16)pk2(gelu_tanh(y[q]), 0.f);
        }
        LDS_WAIT(); asm volatile("" ::: "memory");
    }
}

struct YRow { v4u a0, a1, b0, b1; };
__device__ __forceinline__ void yatt_load(const bf16* orow, int lane, YRow& r) {
    const int hh = lane >> 3, e0 = (lane & 7) * 16;
    const bf16* p1 = orow + (4 * hh + (e0 >> 6)) * 64 + (e0 & 63);
    r.a0 = *(const v4u*)(p1); r.a1 = *(const v4u*)(p1 + 8); r.b0 = *(const v4u*)(p1 + 128); r.b1 = *(const v4u*)(p1 + 136);
}
__device__ __forceinline__ void yatt_fin(const YRow& r, bf16* yrow, const float (&sg)[16], float lam, int lane) {
    const int hh = lane >> 3, e0 = (lane & 7) * 16;
    float o[16];
#pragma unroll
    for (int i = 0; i < 2; ++i) { const v4u a = i ? r.a1 : r.a0, b = i ? r.b1 : r.b0;
        o[8 * i + 0] = bfl(a.x) - lam * bfl(b.x); o[8 * i + 1] = bfh(a.x) - lam * bfh(b.x); o[8 * i + 2] = bfl(a.y) - lam * bfl(b.y); o[8 * i + 3] = bfh(a.y) - lam * bfh(b.y);
        o[8 * i + 4] = bfl(a.z) - lam * bfl(b.z); o[8 * i + 5] = bfh(a.z) - lam * bfh(b.z); o[8 * i + 6] = bfl(a.w) - lam * bfl(b.w); o[8 * i + 7] = bfh(a.w) - lam * bfh(b.w); }
    float ss = 0.f;
#pragma unroll
    for (int j = 0; j < 16; ++j) ss += o[j] * o[j];
    ss += sx_xor<1>(ss); ss += sx_xor<2>(ss); ss += sx_xor<4>(ss);
    const float rs = 1.f / sqrtf(ss * (1.f / 128.f) + RMS_EPS) * (1.0f - LAMBDA_INIT);
    float y[16];
#pragma unroll
    for (int j = 0; j < 16; ++j) y[j] = o[j] * rs * sg[j];
    v4u w0, w1; w0.x = pk2(y[0], y[1]); w0.y = pk2(y[2], y[3]); w0.z = pk2(y[4], y[5]); w0.w = pk2(y[6], y[7]); w1.x = pk2(y[8], y[9]); w1.y = pk2(y[10], y[11]); w1.z = pk2(y[12], y[13]); w1.w = pk2(y[14], y[15]);
    *(v4u*)(yrow + hh * 128 + e0) = w0; *(v4u*)(yrow + hh * 128 + e0 + 8) = w1;
}
__device__ __forceinline__ void yatt_pass(const bf16* OBp, bf16* PROJp, const float* subg, float lam, int gw, int NGW, int lane) {
    float sg[16];
#pragma unroll
    for (int j = 0; j < 16; ++j) sg[j] = subg[(lane & 7) * 16 + j];
    YRow c0, c1, c2, c3, n0, n1, n2, n3;
    int m = gw;
    if (m < M) { yatt_load(OBp + (size_t)m * 2048, lane, c0); yatt_load(OBp + (size_t)(m + NGW) * 2048, lane, c1); yatt_load(OBp + (size_t)(m + 2 * NGW) * 2048, lane, c2); yatt_load(OBp + (size_t)(m + 3 * NGW) * 2048, lane, c3); }
    for (; m < M; m += 4 * NGW) {
        const int mn = m + 4 * NGW;
        if (mn < M) { yatt_load(OBp + (size_t)mn * 2048, lane, n0); yatt_load(OBp + (size_t)(mn + NGW) * 2048, lane, n1); yatt_load(OBp + (size_t)(mn + 2 * NGW) * 2048, lane, n2); yatt_load(OBp + (size_t)(mn + 3 * NGW) * 2048, lane, n3); }
        yatt_fin(c0, PROJp + (size_t)m * INW + 1024, sg, lam, lane); yatt_fin(c1, PROJp + (size_t)(m + NGW) * INW + 1024, sg, lam, lane);
        yatt_fin(c2, PROJp + (size_t)(m + 2 * NGW) * INW + 1024, sg, lam, lane); yatt_fin(c3, PROJp + (size_t)(m + 3 * NGW) * INW + 1024, sg, lam, lane);
        c0 = n0; c1 = n1; c2 = n2; c3 = n3;
    }
}

__device__ __forceinline__ void up8(const v4u p, float (&f)[8]) { f[0] = bfl(p.x); f[1] = bfh(p.x); f[2] = bfl(p.y); f[3] = bfh(p.y); f[4] = bfl(p.z); f[5] = bfh(p.z); f[6] = bfl(p.w); f[7] = bfh(p.w); }
__device__ __forceinline__ void conv_item(bf16* proj, const float* cw, const float* cb, int item) {
    const int cc = item % (FF / 8), rr = item / (FF / 8), f0 = cc * 8, t0 = rr * 8;
    bf16* base = proj + (size_t)t0 * INW + f0;
    v4u pa[10], pv[8];
    const bool first = (t0 & (T - 1)) == 0;
    const v4u zero4 = {0u, 0u, 0u, 0u};
    pa[0] = first ? zero4 : *(const v4u*)(base - 2 * (size_t)INW); pa[1] = first ? zero4 : *(const v4u*)(base - (size_t)INW);
#pragma unroll
    for (int i = 0; i < 8; ++i) { pa[2 + i] = *(const v4u*)(base + (size_t)i * INW); pv[i] = *(const v4u*)(base + (size_t)i * INW + FF); }
    float w0[8], w1[8], w2[8], bb[8];
#pragma unroll
    for (int j = 0; j < 8; ++j) { w0[j] = cw[f0 + j]; w1[j] = cw[FF + f0 + j]; w2[j] = cw[2 * FF + f0 + j]; bb[j] = cb[f0 + j]; }
    float am2[8], am1[8];
    up8(pa[0], am2); up8(pa[1], am1);
#pragma unroll
    for (int i = 0; i < 8; ++i) {
        float a0[8], vv[8], o[8]; up8(pa[2 + i], a0); up8(pv[i], vv);
#pragma unroll
        for (int j = 0; j < 8; ++j) { const float cv = w0[j] * am2[j] + w1[j] * am1[j] + w2[j] * a0[j] + bb[j]; o[j] = cv * __builtin_amdgcn_rcpf(1.0f + __expf(-cv)) * vv[j]; am2[j] = am1[j]; am1[j] = a0[j]; }
        v4u w; w.x = pk2(o[0], o[1]); w.y = pk2(o[2], o[3]); w.z = pk2(o[4], o[5]); w.w = pk2(o[6], o[7]);
        *(v4u*)(base + (size_t)i * INW + FF) = w;
    }
}

__device__ __forceinline__ void convfix_item(bf16* Gb, const bf16* S0, const bf16* S1, const bf16* S2, const float* cw, const float* cb, int item) {
    const int cc = item % (FF / 8), sj = item / (FF / 8), j = sj & 1, s = sj >> 1, f0 = cc * 8;
    const bool first = (s & 63) == 0;
    const v4u z4 = {0u, 0u, 0u, 0u};
    const v4u l62 = first ? z4 : *(const v4u*)(S2 + ((size_t)(s - 1) * 2 + 0) * FF + f0), l63 = first ? z4 : *(const v4u*)(S2 + ((size_t)(s - 1) * 2 + 1) * FF + f0);
    const v4u a0 = *(const v4u*)(S0 + ((size_t)s * 2 + 0) * FF + f0), a1 = *(const v4u*)(S0 + ((size_t)s * 2 + 1) * FF + f0);
    const v4u vv = *(const v4u*)(S1 + ((size_t)s * 2 + j) * FF + f0);
    float pm2[8], pm1[8], ac[8], vf[8], o[8];
    if (j == 0) { up8(l62, pm2); up8(l63, pm1); up8(a0, ac); } else { up8(l63, pm2); up8(a0, pm1); up8(a1, ac); }
    up8(vv, vf);
#pragma unroll
    for (int q = 0; q < 8; ++q) { const float cv = cw[f0 + q] * pm2[q] + cw[FF + f0 + q] * pm1[q] + cw[2 * FF + f0 + q] * ac[q] + cb[f0 + q]; o[q] = cv * __builtin_amdgcn_rcpf(1.0f + __expf(-cv)) * vf[q]; }
    v4u w; w.x = pk2(o[0], o[1]); w.y = pk2(o[2], o[3]); w.z = pk2(o[4], o[5]); w.w = pk2(o[6], o[7]);
    *(v4u*)(Gb + ((size_t)s * 64 + j) * FF + f0) = w;
}

__global__ void __launch_bounds__(NTHREADS, 2) mk_fwd(Args args) {
    extern __shared__ __attribute__((aligned(16))) unsigned char lds[];
    cg::grid_group grid = cg::this_grid();
    LAS unsigned char* L = (LAS unsigned char*)lds;
    const int tid = threadIdx.x, lane = tid & 63, wave = __builtin_amdgcn_readfirstlane(tid >> 6);
    const int G = gridDim.x, bx = blockIdx.x;
    const int vcu = (G % 8 == 0) ? (bx % 8) * (G / 8) + bx / 8 : bx;
    const int gw = vcu * NWAVES + wave, NGW = G * NWAVES;
    unsigned char* ws = kargs()->ws;
    bf16* WinT = (bf16*)(ws + WS_WIN); bf16* WgluT = (bf16*)(ws + WS_WGLU); bf16* WbsT = (bf16*)(ws + WS_WBS); bf16* WbaT = (bf16*)(ws + WS_WBA);
    bf16* WoutT = (bf16*)(ws + WS_WOUT); bf16* WupT = (bf16*)(ws + WS_WUP); bf16* WdownT = (bf16*)(ws + WS_WDOWN);
    bf16* PROJ = (bf16*)(ws + WS_PROJ); bf16* HB = (bf16*)(ws + WS_HB);
    float* MODP = (float*)(ws + WS_MODP); float* MOD = (float*)(ws + WS_MOD);
    float* OUT = kargs()->out; bf16* OB = (bf16*)kargs()->out;
#define LND(x) ({ int l_ = (x); asm volatile("" : "+v"(l_)); l_; })
#define GSYNC_CG() do { __builtin_amdgcn_fence(__ATOMIC_RELEASE, "agent"); grid.sync(); __builtin_amdgcn_fence(__ATOMIC_ACQUIRE, "agent"); } while (0)
#define GSYNC() xcd_barrier(bar)
    for (int u = tid; u < (LDS_BYTES - LDSCTL_OFF) / 4; u += NTHREADS) ((LAS unsigned*)(L + LDSCTL_OFF))[u] = 0u;
    __syncthreads();
    const XcdBarrier bar = xcd_barrier_post((unsigned*)(ws + WS_CTL) + CW_BAR, (volatile LAS unsigned*)(L + MISC_OFF) + 8);

    {
        LAS float* scr = (LAS float*)(L + wave * 16384);
        constexpr int I_IN = (D / 64) * (INW / 32), I_SQ = (D / 64) * (D / 32), I_UP = (D / 64) * (2 * FF / 32), I_DN = (FF / 64) * (D / 32);
        constexpr int NITEMS = I_IN + 4 * I_SQ + I_UP + I_DN;
        for (int it = gw; it < NITEMS; it += NGW) {
            int r = it;
            if (r < I_IN) { p0_transpose_item(kargs()->in[4], D, INW, WinT, scr, r, LND(lane)); continue; } r -= I_IN;
            if (r < I_SQ) { p0_transpose_item(kargs()->in[13], D, D, WgluT, scr, r, LND(lane)); continue; } r -= I_SQ;
            if (r < I_SQ) { p0_transpose_item(kargs()->in[20], D, D, WbsT, scr, r, LND(lane)); continue; } r -= I_SQ;
            if (r < I_SQ) { p0_transpose_item(kargs()->in[21], D, D, WbaT, scr, r, LND(lane)); continue; } r -= I_SQ;
            if (r < I_SQ) { p0_transpose_item(kargs()->in[22], D, D, WoutT, scr, r, LND(lane)); continue; } r -= I_SQ;
            if (r < I_UP) { p0_transpose_item<true>(kargs()->in[25], D, 2 * FF, WupT, scr, r, LND(lane)); continue; } r -= I_UP;
            p0_transpose_item(kargs()->in[28], FF, D, WdownT, scr, r, LND(lane));
        }
        for (int it = gw; it < 96 * 16; it += NGW) p0_mod_item(kargs()->in[1], kargs()->in[2], kargs()->in[3], MODP, scr, it, LND(lane));
    }
    if (__builtin_expect(kargs()->ws == nullptr, 0)) GSYNC_CG();
    GSYNC();
    for (int i = bx * NTHREADS + LND(tid); i < 16 * INW; i += G * NTHREADS) { float s = 0.f;
#pragma unroll
        for (int ks = 0; ks < 16; ++ks) s += MODP[(size_t)ks * 16 * INW + i];
        MOD[i] = s; }
    GSYNC();
    ln_pass<0>(kargs()->in[0], nullptr, HB, nullptr, nullptr, MOD, 0, D, gw, NGW, LND(lane));
    GSYNC();
    {
        pg8::Gemm g{HB, WinT, D, D, D}; pg8::StaticOrder S; S.init(M, INW, G, bx);
        pg8::Epi<pg8::EP_PROJ> E{}; E.O = PROJ; E.ldo = INW; E.qscale = attn_body::C2;
        pg8::gemm_phase<pg8::Epi<pg8::EP_PROJ>, pg8::StaticOrder, true, true>(L, g, S, E);
    }
    GSYNC();
    {
        if (bx < 64) {
            ssm_item(kargs(), (bx * 8 + wave) >> 3, (bx * 8 + wave) & 7, L + wave * 16384, LND(lane));
            __syncthreads();
        }
        unsigned* qctr = (unsigned*)(ws + WS_CTL) + CW_QUEUE;
        volatile LAS unsigned* qw = (volatile LAS unsigned*)(L + MISC_OFF) + 16;
        const int xcc = (int)(xb_xcc_id() & 7u);
        for (int s = 0; s < 8; ++s) {
            const int xq = (xcc + s) & 7;
            for (;;) {
                if (tid == 0) qw[0] = __hip_atomic_fetch_add(qctr + 64 * xq, 1u, __ATOMIC_RELAXED, __HIP_MEMORY_SCOPE_AGENT);
                __syncthreads();
                const int idx = __builtin_amdgcn_readfirstlane((int)qw[0]);
                __syncthreads();
                if (idx >= 512) break;
                const int jj = idx >> 5, within = idx & 31, qb = 15 - (within >> 1), map = within & 1;
                const int hg = xq + 8 * jj, b = hg >> 3, head = hg & 7, hm = 2 * head + map;
                attn_body::attn_unit<8>(b, hm, 2 * head, 2 * hm, qb, (const attn_body::bf16*)(PROJ + 1024), (const attn_body::bf16*)(PROJ + 2048), (const attn_body::bf16*)(PROJ + 3072), (attn_body::bf16*)OB, (char*)lds);
            }
        }
    }
    GSYNC();
    {
        float lam;
        { const float v1 = kargs()->in[15][lane] * kargs()->in[16][lane], v2 = kargs()->in[17][lane] * kargs()->in[18][lane];
          lam = expf(wave_sum(v1)) - expf(wave_sum(v2)) + LAMBDA_INIT; }
        yatt_pass(OB, PROJ, kargs()->in[19], lam, gw, NGW, LND(lane));
        pg8::Gemm g{HB, WgluT, D, D, D}; pg8::StaticOrder S; S.init(M, D, G, bx);
        pg8::Epi<pg8::EP_GLU> E{}; E.O = PROJ; E.ldo = INW; E.X1 = HB; E.ldx1 = D; E.bias = kargs()->in[14];
        pg8::gemm_phase<pg8::Epi<pg8::EP_GLU>, pg8::StaticOrder, true, true>(L, g, S, E);
    }
    GSYNC();
    {
        pg8::Gemm g{PROJ, WbsT, INW, D, D}; pg8::StaticOrder S; S.init(M, D, G, bx);
        pg8::Epi<pg8::EP_BS> E{}; E.O = PROJ + 2048; E.ldo = INW; E.X1 = PROJ + 4096; E.ldx1 = INW;
        pg8::gemm_phase<pg8::Epi<pg8::EP_BS>, pg8::StaticOrder, true, true>(L, g, S, E);
    }
    {
        pg8::Gemm g{PROJ + 1024, WbaT, INW, D, D}; pg8::StaticOrder S; S.init(M, D, G, bx);
        pg8::Epi<pg8::EP_BA> E{}; E.O = PROJ + 3072; E.ldo = INW; E.X1 = PROJ + 5120; E.ldx1 = INW; E.X2 = PROJ + 2048; E.ldx2 = INW;
        pg8::gemm_phase<pg8::Epi<pg8::EP_BA>, pg8::StaticOrder, true, true>(L, g, S, E);
    }
    GSYNC();
    {
        pg8::Gemm g{PROJ + 3072, WoutT, INW, D, D}; pg8::StaticOrder S; S.init(M, D, G, bx);
        pg8::Epi<pg8::EP_OUT> E{}; E.F = OUT; E.R = kargs()->in[0]; E.gate = MOD + 2 * D; E.alpha = DN_ALPHA;
        pg8::gemm_phase<pg8::Epi<pg8::EP_OUT>, pg8::StaticOrder, true, true>(L, g, S, E);
    }
    GSYNC();
    ln_pass<1>(OUT, OUT, HB, kargs()->in[23], kargs()->in[24], MOD, 3 * D, 4 * D, gw, NGW, LND(lane));
    GSYNC();
    bf16* GB = PROJ; bf16* SB0 = (bf16*)(ws + WS_PROJ + 416 * MiB); bf16* SB1 = (bf16*)(ws + WS_PROJ + 432 * MiB); bf16* SB2 = (bf16*)(ws + WS_PROJ + 448 * MiB);
    {
        pg8::Gemm g{HB, WupT, D, D, D}; pg8::StaticOrder S; S.init(M, 2 * FF, G, bx);
        pg8::Epi<pg8::EP_UPC> E{}; E.O = GB; E.ldo = FF; E.S0 = SB0; E.S1 = SB1; E.S2 = SB2; E.cw = kargs()->in[26]; E.cb = kargs()->in[27];
        pg8::gemm_phase<pg8::Epi<pg8::EP_UPC>, pg8::StaticOrder, true, true>(L, g, S, E);
    }
    GSYNC();
    for (int it = bx * NTHREADS + LND(tid); it < (M / 64) * 2 * (FF / 8); it += G * NTHREADS) convfix_item(GB, SB0, SB1, SB2, kargs()->in[26], kargs()->in[27], it);
    GSYNC();
    {
        pg8::Gemm g{GB, WdownT, FF, FF, FF}; pg8::StaticOrder S; S.init(M, D, G, bx);
        pg8::Epi<pg8::EP_DOWN> E{}; E.F = OUT; E.R = OUT; E.gate = MOD + 5 * D; E.alpha = DN_ALPHA;
        pg8::gemm_phase<pg8::Epi<pg8::EP_DOWN>, pg8::StaticOrder, true, true>(L, g, S, E);
    }
    GSYNC();
    ln_pass<2>(OUT, OUT, nullptr, kargs()->in[29], kargs()->in[30], nullptr, 0, 0, gw, NGW, LND(lane));
}

extern "C" void kernel_launch(void* const* d_in, const int* in_sizes, int n_in, void* d_out, int out_size, void* d_ws, size_t ws_size, hipStream_t stream) {
    static int grid = 0;
    if (grid == 0) {
        if (n_in != 31 || in_sizes[0] != M * D || out_size != M * D || ws_size < WS_END) { fprintf(stderr, "kernel_launch: unexpected shapes (n_in %d, in0 %d, out %d, ws %zu); nothing launched\n", n_in, n_in > 0 ? in_sizes[0] : -1, out_size, ws_size); grid = -1; return; }
        int dev = 0, cus = 0, per_cu = 0;
        if (hipGetDevice(&dev) != hipSuccess || hipDeviceGetAttribute(&cus, hipDeviceAttributeMultiprocessorCount, dev) != hipSuccess) { grid = -1; return; }
        if (hipFuncSetAttribute((const void*)mk_fwd, hipFuncAttributeMaxDynamicSharedMemorySize, LDS_BYTES) != hipSuccess) { fprintf(stderr, "kernel_launch: hipFuncSetAttribute failed\n"); grid = -1; return; }
        if (hipOccupancyMaxActiveBlocksPerMultiprocessor(&per_cu, (const void*)mk_fwd, NTHREADS, LDS_BYTES) != hipSuccess || per_cu < 1) { fprintf(stderr, "kernel_launch: occupancy query says %d\n", per_cu); per_cu = 1; }
        (void)hipGetLastError();
        grid = cus * per_cu;
    }
    if (grid < 0) return;
    if (hipMemsetAsync((char*)d_ws + WS_CTL, 0, CTL_ZERO_BYTES, stream) != hipSuccess) { fprintf(stderr, "kernel_launch: memset failed\n"); return; }
    Args a{};
    for (int i = 0; i < 31; ++i) a.in[i] = (const float*)d_in[i];
    a.out = (float*)d_out; a.ws = (unsigned char*)d_ws;
    void* kargs[] = {&a};
    hipError_t e = hipLaunchCooperativeKernel((const void*)mk_fwd, dim3(grid), dim3(NTHREADS), kargs, LDS_BYTES, stream);
    if (e != hipSuccess) fprintf(stderr, "kernel_launch: cooperative launch failed: %s (grid %d)\n", hipGetErrorString(e), grid);
}
```
